# Optimizing an MI355X kernel written in HIP

```python
import math
import jax, jax.numpy as jnp
from jax import lax
import numpy as np

D_MODEL = 1024
BATCH = 2
SEQ = 8192
DEPTH = 4
DEC_BATCH = 128
DEC_SEQ = 4
PAST_LEN = 8192
PAGE_SIZE = 128

N_MIXERS = 2
N_HEADS = 16
N_KV_HEADS = 4
HEAD_DIM = D_MODEL // N_HEADS
GROUP = N_HEADS // N_KV_HEADS
QKV_DIM = (N_HEADS + 2 * N_KV_HEADS) * HEAD_DIM
WINDOW = 128
CONV_WIDTH = 3
CONV_DIM = D_MODEL
N_MEM = 256
MEM_HEADS = 4
MEM_HEAD_DIM = D_MODEL // MEM_HEADS
PEER_HEADS = 8
N_KEYS = 128
N_EXPERTS = N_KEYS * N_KEYS
PEER_TOPK = 16
PEER_QDIM = 256
PEER_HALF = PEER_QDIM // 2
PEER_BLOCK = 128
N_ATTN_LAYERS = (DEPTH + 1) // 2
N_CONV_LAYERS = DEPTH // 2
DN_ALPHA = (2.0 * DEPTH) ** 0.25
DN_BETA = (8.0 * DEPTH) ** -0.25
LN_EPS = 1e-5
NEG = -1e30

kernel_name = "hybrid_swa_sink_shortconv_peer_decoder_step"


def layer_norm(x, g, b):
    xf = x.astype(jnp.float32)
    mu = jnp.mean(xf, -1, keepdims=True)
    var = jnp.mean(jnp.square(xf - mu), -1, keepdims=True)
    return ((xf - mu) * lax.rsqrt(var + LN_EPS) * g.astype(jnp.float32) + b.astype(jnp.float32)).astype(x.dtype)


def deepnorm(x, fx, g, b):
    return layer_norm(DN_ALPHA * x + fx, g, b)


def split_qkv(x, w_qkv):
    B, L, _ = x.shape
    qkv = x @ w_qkv
    nq = N_HEADS * HEAD_DIM
    nk = N_KV_HEADS * HEAD_DIM
    q = qkv[..., :nq].reshape(B, L, N_KV_HEADS, GROUP, HEAD_DIM)
    k = qkv[..., nq:nq + nk].reshape(B, L, N_KV_HEADS, HEAD_DIM)
    v = qkv[..., nq + nk:].reshape(B, L, N_KV_HEADS, HEAD_DIM)
    return q, k, v


def sink_attention(q, k, v, mask, sinks):
    s = jnp.einsum("...qkgd,...skd->...kgqs", q, k).astype(jnp.float32) * (HEAD_DIM ** -0.5)
    s = jnp.where(mask, s, NEG)
    sk = sinks.astype(jnp.float32).reshape(N_KV_HEADS, GROUP)[:, :, None, None]
    m = jnp.maximum(jnp.max(s, -1, keepdims=True), sk)
    p = jnp.exp(s - m)
    p = (p / (jnp.sum(p, -1, keepdims=True) + jnp.exp(sk - m))).astype(v.dtype)
    return jnp.einsum("...kgqs,...skd->...qkgd", p, v)


def window_attn_prompt(x, w_qkv, sinks, w_o):
    B, L, _ = x.shape
    nb = L // WINDOW
    q, k, v = split_qkv(x, w_qkv)
    qb = q.reshape(B, nb, WINDOW, N_KV_HEADS, GROUP, HEAD_DIM)
    kb = k.reshape(B, nb, WINDOW, N_KV_HEADS, HEAD_DIM)
    vb = v.reshape(B, nb, WINDOW, N_KV_HEADS, HEAD_DIM)
    pad = ((0, 0), (1, 0), (0, 0), (0, 0), (0, 0))
    kw = jnp.concatenate([jnp.pad(kb, pad)[:, :-1], kb], axis=2)
    vw = jnp.concatenate([jnp.pad(vb, pad)[:, :-1], vb], axis=2)
    blk = jnp.arange(nb)[:, None] * WINDOW
    qpos = blk + jnp.arange(WINDOW)[None]
    kpos = blk - WINDOW + jnp.arange(2 * WINDOW)[None]
    d = qpos[:, :, None] - kpos[:, None, :]
    mask = (d >= 0) & (d <= WINDOW) & (kpos[:, None, :] >= 0)
    o = sink_attention(qb, kw, vw, mask[:, None, None], sinks)
    y = o.reshape(B, L, N_HEADS * HEAD_DIM) @ w_o
    wc = min(WINDOW, L)
    return y, k[:, L - wc:], v[:, L - wc:]


def window_attn_sample(x, ck, cv, w_qkv, sinks, w_o):
    B, L, _ = x.shape
    P = ck.shape[1]
    q, k, v = split_qkv(x, w_qkv)
    kk = jnp.concatenate([ck, k.astype(ck.dtype)], axis=1)
    vv = jnp.concatenate([cv, v.astype(cv.dtype)], axis=1)
    qpos = PAST_LEN + jnp.arange(L)
    kpos = PAST_LEN - P + jnp.arange(P + L)
    d = qpos[:, None] - kpos[None, :]
    mask = (d >= 0) & (d <= WINDOW)
    o = sink_attention(q, kk, vv, mask, sinks)
    y = o.reshape(B, L, N_HEADS * HEAD_DIM) @ w_o
    return y, kk[:, L:], vv[:, L:]


def short_conv(x, state, w_in, w_conv, w_out):
    L = x.shape[1]
    gb, gc, h = jnp.split(x @ w_in, 3, axis=-1)
    u = gc * h
    up = jnp.concatenate([state.astype(u.dtype), u], axis=1)
    z = w_conv[0] * up[:, 0:L]
    for j in range(1, CONV_WIDTH):
        z = z + w_conv[j] * up[:, j:j + L]
    return (gb * z) @ w_out, up[:, L:]


def mem_kv(mem, w_kv):
    B, M, _ = mem.shape
    k, v = jnp.split(mem @ w_kv, 2, axis=-1)
    return k.reshape(B, M, MEM_HEADS, MEM_HEAD_DIM), v.reshape(B, M, MEM_HEADS, MEM_HEAD_DIM)


def mem_attn(x, mk, mv, w_q, w_o):
    B, L, _ = x.shape
    q = (x @ w_q).reshape(B, L, MEM_HEADS, MEM_HEAD_DIM)
    s = jnp.einsum("blhd,bmhd->bhlm", q, mk.astype(q.dtype)).astype(jnp.float32) * (MEM_HEAD_DIM ** -0.5)
    p = jax.nn.softmax(s, axis=-1).astype(x.dtype)
    o = jnp.einsum("bhlm,bmhd->blhd", p, mv.astype(x.dtype))
    return o.reshape(B, L, D_MODEL) @ w_o


def peer_block(xb, w_q, sub_keys, u_tab, v_tab):
    T = xb.shape[0]
    q = (xb @ w_q).reshape(T, PEER_HEADS, 2, PEER_HALF)
    s = jnp.einsum("thcd,cnd->thcn", q, sub_keys).astype(jnp.float32)
    sv, si = lax.top_k(s, PEER_TOPK)
    comb = (sv[:, :, 0, :, None] + sv[:, :, 1, None, :]).reshape(T, PEER_HEADS, PEER_TOPK * PEER_TOPK)
    cs, ci = lax.top_k(comb, PEER_TOPK)
    i1 = jnp.take_along_axis(si[:, :, 0], ci // PEER_TOPK, axis=-1)
    i2 = jnp.take_along_axis(si[:, :, 1], ci % PEER_TOPK, axis=-1)
    eid = i1 * N_KEYS + i2
    g = jax.nn.softmax(cs, axis=-1)
    u = u_tab[eid]
    v = v_tab[eid]
    a = jax.nn.gelu(jnp.einsum("td,thkd->thk", xb, u).astype(jnp.float32), approximate=False)
    return jnp.einsum("thk,thkd->td", (g * a).astype(v.dtype), v)


def peer(x, w_q, sub_keys, u_tab, v_tab):
    B, L, D = x.shape
    T = B * L
    nblk = -(-T // PEER_BLOCK)
    xf = jnp.pad(x.reshape(T, D), ((0, nblk * PEER_BLOCK - T), (0, 0)))
    yb = lax.map(lambda xb: peer_block(xb, w_q, sub_keys, u_tab, v_tab), xf.reshape(nblk, PEER_BLOCK, D))
    return yb.reshape(nblk * PEER_BLOCK, D)[:T].reshape(B, L, D)


def setup_inputs(seed: int = 0) -> dict:
    key = jax.random.key(seed)
    ks = jax.random.split(key, 24)

    def nrm(k, shape, scale):
        return jax.random.normal(k, shape, jnp.float32) * scale

    wc = min(WINDOW, PAST_LEN)
    dm = D_MODEL ** -0.5
    return {
        "x_prompt": nrm(ks[0], (BATCH, SEQ, D_MODEL), 1.0),
        "x_sample": nrm(ks[1], (DEC_BATCH, DEC_SEQ, D_MODEL), 1.0),
        "cache_win_k": nrm(ks[2], (N_ATTN_LAYERS, DEC_BATCH, wc, N_KV_HEADS, HEAD_DIM), 1.0),
        "cache_win_v": nrm(ks[3], (N_ATTN_LAYERS, DEC_BATCH, wc, N_KV_HEADS, HEAD_DIM), 1.0),
        "state_conv": nrm(ks[4], (N_CONV_LAYERS, DEC_BATCH, CONV_WIDTH - 1, CONV_DIM), 1.0),
        "cache_mem_k": nrm(ks[5], (DEPTH, DEC_BATCH, N_MEM, MEM_HEADS, MEM_HEAD_DIM), 1.0),
        "cache_mem_v": nrm(ks[6], (DEPTH, DEC_BATCH, N_MEM, MEM_HEADS, MEM_HEAD_DIM), 1.0),
        "mem_prompt": nrm(ks[7], (BATCH, N_MEM, D_MODEL), 1.0),
        "attn_w_qkv": nrm(ks[8], (N_ATTN_LAYERS, D_MODEL, QKV_DIM), dm),
        "attn_sinks": nrm(ks[9], (N_ATTN_LAYERS, N_HEADS), 0.5),
        "attn_w_o": nrm(ks[10], (N_ATTN_LAYERS, N_HEADS * HEAD_DIM, D_MODEL), (N_HEADS * HEAD_DIM) ** -0.5 * DN_BETA),
        "conv_w_in": nrm(ks[11], (N_CONV_LAYERS, D_MODEL, 3 * CONV_DIM), dm),
        "conv_w": nrm(ks[12], (N_CONV_LAYERS, CONV_WIDTH, CONV_DIM), CONV_WIDTH ** -0.5),
        "conv_w_out": nrm(ks[13], (N_CONV_LAYERS, CONV_DIM, D_MODEL), CONV_DIM ** -0.5 * DN_BETA),
        "mem_w_q": nrm(ks[14], (DEPTH, D_MODEL, D_MODEL), dm),
        "mem_w_kv": nrm(ks[15], (DEPTH, D_MODEL, 2 * D_MODEL), dm),
        "mem_w_o": nrm(ks[16], (DEPTH, D_MODEL, D_MODEL), dm * DN_BETA),
        "peer_w_q": nrm(ks[17], (DEPTH, D_MODEL, PEER_HEADS * PEER_QDIM), dm),
        "peer_sub_keys": nrm(ks[18], (DEPTH, 2, N_KEYS, PEER_HALF), PEER_HALF ** -0.5),
        "peer_u": nrm(ks[19], (DEPTH, N_EXPERTS, D_MODEL), dm),
        "peer_v": nrm(ks[20], (DEPTH, N_EXPERTS, D_MODEL), DN_BETA * PEER_HEADS ** -0.5),
        "ln_g": 1.0 + nrm(ks[21], (DEPTH, 3, D_MODEL), 0.02),
        "ln_b": nrm(ks[22], (DEPTH, 3, D_MODEL), 0.02),
    }


def reference(x_prompt, x_sample, cache_win_k, cache_win_v, state_conv, cache_mem_k, cache_mem_v, mem_prompt,
              attn_w_qkv, attn_sinks, attn_w_o, conv_w_in, conv_w, conv_w_out, mem_w_q, mem_w_kv, mem_w_o,
              peer_w_q, peer_sub_keys, peer_u, peer_v, ln_g, ln_b):
    xp, xs = x_prompt, x_sample
    wk_p, wv_p, cv_p, mk_p_all, mv_p_all = [], [], [], [], []
    wk_s, wv_s, cv_s = [], [], []
    for i in range(DEPTH):
        j = i // N_MIXERS
        if i % N_MIXERS == 0:
            fp, kp, vp = window_attn_prompt(xp, attn_w_qkv[j], attn_sinks[j], attn_w_o[j])
            fs, ks_, vs_ = window_attn_sample(xs, cache_win_k[j], cache_win_v[j], attn_w_qkv[j], attn_sinks[j], attn_w_o[j])
            wk_p.append(kp); wv_p.append(vp); wk_s.append(ks_); wv_s.append(vs_)
        else:
            zero_state = jnp.zeros((xp.shape[0], CONV_WIDTH - 1, CONV_DIM), xp.dtype)
            fp, sp = short_conv(xp, zero_state, conv_w_in[j], conv_w[j], conv_w_out[j])
            fs, ss = short_conv(xs, state_conv[j], conv_w_in[j], conv_w[j], conv_w_out[j])
            cv_p.append(sp); cv_s.append(ss)
        xp = deepnorm(xp, fp, ln_g[i, 0], ln_b[i, 0])
        xs = deepnorm(xs, fs, ln_g[i, 0], ln_b[i, 0])
        mk, mv = mem_kv(mem_prompt, mem_w_kv[i])
        mk_p_all.append(mk); mv_p_all.append(mv)
        xp = deepnorm(xp, mem_attn(xp, mk, mv, mem_w_q[i], mem_w_o[i]), ln_g[i, 1], ln_b[i, 1])
        xs = deepnorm(xs, mem_attn(xs, cache_mem_k[i], cache_mem_v[i], mem_w_q[i], mem_w_o[i]), ln_g[i, 1], ln_b[i, 1])
        xp = deepnorm(xp, peer(xp, peer_w_q[i], peer_sub_keys[i], peer_u[i], peer_v[i]), ln_g[i, 2], ln_b[i, 2])
        xs = deepnorm(xs, peer(xs, peer_w_q[i], peer_sub_keys[i], peer_u[i], peer_v[i]), ln_g[i, 2], ln_b[i, 2])
    return (xp, xs,
            jnp.stack(wk_p), jnp.stack(wv_p), jnp.stack(cv_p), jnp.stack(mk_p_all), jnp.stack(mv_p_all),
            jnp.stack(wk_s), jnp.stack(wv_s), jnp.stack(cv_s))
```

```cpp
#include <hip/hip_runtime.h>
#include <cstdio>
#include <cstdint>

#ifndef MK_DEBUG
#define MK_DEBUG 0
#endif
#if MK_DEBUG
#define MK_PER_PHASE 1
#endif
#ifndef MK_PER_PHASE
#define MK_PER_PHASE 0
#endif

#define LAS __attribute__((address_space(3)))
#define GAS __attribute__((address_space(1)))
typedef unsigned short bf16_t;
typedef short bf16x8 __attribute__((ext_vector_type(8)));
typedef float f32x4 __attribute__((ext_vector_type(4)));
typedef float f32x2 __attribute__((ext_vector_type(2)));
typedef float f32x16 __attribute__((ext_vector_type(16)));
typedef unsigned u32x4 __attribute__((ext_vector_type(4)));
typedef unsigned u32x2 __attribute__((ext_vector_type(2)));

constexpr int D = 1024, SEQ = 8192, NBATCH = 2, TP = NBATCH * SEQ, DBATCH = 128, DSEQ = 4, TS = DBATCH * DSEQ, T = TP + TS;
constexpr int QKVW = 1536, NEXP = 16384, NLAYER = 4;
constexpr float DN_ALPHA = 1.6817928305074292f;
constexpr float LN_EPS = 1e-5f;
constexpr float LOG2E = 1.4426950408889634f;
constexpr float U_SCALE = 64.f, V_SCALE = 16.f;

constexpr size_t O_YP = 0, O_YS = 16777216, O_WKP = O_YS + 524288, O_WVP = O_WKP + 131072, O_CVP = O_WVP + 131072, O_MKP = O_CVP + 8192,
                 O_MVP = O_MKP + 2097152, O_WKS = O_MVP + 2097152, O_WVS = O_WKS + 8388608, O_CVS = O_WVS + 8388608, O_END = O_CVS + 524288;

constexpr size_t MiB = 1u << 20;
constexpr size_t WS_CTL = 0, CTL_ZERO_BYTES = 1 * MiB;
constexpr size_t WS_WQKV = 2 * MiB, WS_WO = 8 * MiB, WS_WIN = 12 * MiB, WS_WOUT = 24 * MiB, WS_WMQ = 28 * MiB, WS_WMKV = 36 * MiB, WS_WMO = 52 * MiB, WS_WPQ = 60 * MiB;
constexpr size_t WS_SUBK = 76 * MiB, WS_MEMB = 77 * MiB, WS_MK = 78 * MiB, WS_MVT = 82 * MiB, WS_PU8 = 86 * MiB, WS_PV8 = 150 * MiB;
constexpr size_t WS_X = 214 * MiB, WS_XB = 280 * MiB, WS_BIG = 313 * MiB, WS_OB = 412 * MiB, WS_F = 445 * MiB, WS_SP = 511 * MiB;
constexpr size_t WS_EID = 543 * MiB, WS_GW = 552 * MiB, WS_AW = 561 * MiB, WS_X8 = 570 * MiB, WS_END = 587 * MiB;
constexpr int CW_BAR = 4096;

constexpr int LDS_SCRATCH = 153600;
constexpr int MISC_OFF = LDS_SCRATCH;
constexpr int LDS_BYTES = 155648;

__device__ __forceinline__ unsigned f2bf(float f) { unsigned u = __builtin_bit_cast(unsigned, f); return (u + 0x7fffu + ((u >> 16) & 1u)) >> 16; }
__device__ __forceinline__ unsigned pk2(float lo, float hi) { return f2bf(lo) | (f2bf(hi) << 16); }
__device__ __forceinline__ float bf2f(unsigned b) { return __builtin_bit_cast(float, b << 16); }
__device__ __forceinline__ float bflo(unsigned w) { return __builtin_bit_cast(float, w << 16); }
__device__ __forceinline__ float bfhi(unsigned w) { return __builtin_bit_cast(float, w & 0xffff0000u); }
__device__ __forceinline__ unsigned cvt_pk_bf16(float lo, float hi) { unsigned r; asm volatile("v_cvt_pk_bf16_f32 %0, %1, %2" : "=v"(r) : "v"(lo), "v"(hi)); return r; }
__device__ __forceinline__ float wave_sum(float v) {
#pragma unroll
    for (int o = 1; o < 64; o <<= 1) v += __shfl_xor(v, o);
    return v;
}
__device__ __forceinline__ float wave_max(float v) {
#pragma unroll
    for (int o = 1; o < 64; o <<= 1) v = fmaxf(v, __shfl_xor(v, o));
    return v;
}
#define LDS_WAIT() asm volatile("s_waitcnt lgkmcnt(0)" ::: "memory")
#define VM_WAIT() asm volatile("s_waitcnt vmcnt(0)" ::: "memory")
#define WG_BAR() do { asm volatile("s_waitcnt vmcnt(0) lgkmcnt(0)" ::: "memory"); __builtin_amdgcn_s_barrier(); asm volatile("" ::: "memory"); } while (0)

#define XB_TMO      128
#define XB_XCNT(j)  (256  + 64 * (j))
#define XB_XSUB(j)  (1280 + 64 * (j))
#define XB_XGEN(j)  (2304 + 64 * (j))
#define XB_TOP      3328
#define XB_TOPGEN   3392
#define XCD_BAR_WORDS 3456
#define XB_SPIN_CAP (1u << 21)

__device__ __forceinline__ unsigned xb_ld(unsigned* p)              { return __hip_atomic_load(p, __ATOMIC_RELAXED, __HIP_MEMORY_SCOPE_AGENT); }
__device__ __forceinline__ unsigned xb_add(unsigned* p, unsigned v) { return __hip_atomic_fetch_add(p, v, __ATOMIC_RELAXED, __HIP_MEMORY_SCOPE_AGENT); }
__device__ __forceinline__ unsigned xb_xcc_id() { return (unsigned)__builtin_amdgcn_s_getreg((3 << 11) | 20) & 0xFu; }
#define XB_SPIN(cond, bar) do { unsigned _sp = 0; while (cond) { __builtin_amdgcn_s_sleep(1); \
    if ((++_sp & 255u) == 0u) { if (xb_ld(&(bar)[XB_TMO])) break; if (_sp > XB_SPIN_CAP) { atomicAdd(&(bar)[XB_TMO], 1u); break; } } } } while (0)

struct XcdBarrier { unsigned* bar; unsigned x; volatile LAS unsigned* st; };

__device__ __forceinline__ XcdBarrier xcd_barrier_post(unsigned* bar, volatile LAS unsigned* st) {
    XcdBarrier b; b.bar = bar; b.x = xb_xcc_id(); b.st = st;
    if (threadIdx.x == 0) (void)xb_add(&bar[XB_XCNT(b.x)], 1u);
    return b;
}
__device__ __forceinline__ void xcd_barrier_complete(unsigned* bar, unsigned x, unsigned& nloc, unsigned& nx) {
    const unsigned G = gridDim.x * gridDim.y * gridDim.z;
    unsigned sum, cnt, mine, sp = 0u;
    for (;;) {
        sum = 0u; cnt = 0u; mine = 0u;
#pragma unroll
        for (unsigned j = 0; j < 16; ++j) { const unsigned c = xb_ld(&bar[XB_XCNT(j)]); sum += c; cnt += (c > 0u) ? 1u : 0u; mine = (j == x) ? c : mine; }
        if (sum == G) break;
        __builtin_amdgcn_s_sleep(1);
        if ((++sp & 255u) == 0u) { if (xb_ld(&bar[XB_TMO])) break; if (sp > XB_SPIN_CAP) { atomicAdd(&bar[XB_TMO], 1u); break; } }
    }
    nloc = mine > 0u ? mine : 1u; nx = cnt > 0u ? cnt : 1u;
}
__device__ __forceinline__ void xcd_barrier(const XcdBarrier& b) {
    asm volatile("s_waitcnt vmcnt(0)" ::: "memory");
    __syncthreads();
    if (threadIdx.x == 0) {
        unsigned* bar = b.bar;
        __builtin_amdgcn_s_waitcnt(0);
        unsigned nloc = b.st[0], nx = b.st[1];
        if (nloc == 0u) { xcd_barrier_complete(bar, b.x, nloc, nx); b.st[0] = nloc; b.st[1] = nx; }
        const unsigned old = xb_add(&bar[XB_XSUB(b.x)], 1u);
        const unsigned gen = old / nloc;
        if (old + 1u == (gen + 1u) * nloc) {
            __builtin_amdgcn_fence(__ATOMIC_RELEASE, "agent");
            asm volatile("s_waitcnt vmcnt(0)" ::: "memory");
            const unsigned og = xb_add(&bar[XB_TOP], 1u);
            const unsigned tg = og / nx;
            if (og + 1u == (tg + 1u) * nx) xb_add(&bar[XB_TOPGEN], 1u);
            else XB_SPIN(xb_ld(&bar[XB_TOPGEN]) == tg, bar);
            __builtin_amdgcn_fence(__ATOMIC_ACQUIRE, "agent");
            xb_add(&bar[XB_XGEN(b.x)], 1u);
            asm volatile("s_waitcnt vmcnt(0)" ::: "memory");
        } else {
            XB_SPIN(xb_ld(&bar[XB_XGEN(b.x)]) == gen, bar);
            __builtin_amdgcn_fence(__ATOMIC_ACQUIRE, "agent");
            asm volatile("s_waitcnt vmcnt(0)" ::: "memory");
        }
    }
    __syncthreads();
}

namespace pg8 {
constexpr int BM = 256, BK = 64, HALF = 128, HTB = HALF * BK * 2, STAGE_BYTES = 8 * HTB, NXCD = 8, WGM = 8;
__host__ __device__ __forceinline__ int lds_byte(int r, int c) { const int st = (r >> 4) * 2 + (c >> 5), rr = r & 15, cc = c & 31, ob = rr * 64 + cc * 2; return st * 1024 + (ob ^ (((ob >> 9) & 1) << 5)); }
__host__ __device__ __forceinline__ void stage_rc(int b, int& R, int& C) { const int st = b / 1024, sb = b % 1024, swz = sb ^ (((sb >> 9) & 1) << 5); R = (st >> 1) * 16 + swz / 64; C = (st & 1) * 32 + (swz % 64) / 2; }
__host__ __device__ __forceinline__ int perm32(int rho) { const int n = rho >> 4, i = rho & 15; return 8 * (i >> 2) + 4 * n + (i & 3); }

struct Unit { unsigned aoff, boff; int crow, ccol, z; };
struct Gemm { const bf16_t* A; const bf16_t* Bt; int lda, ldb, K; };

template <class Epi, class Sched, bool ALIGN_EPI>
__device__ __forceinline__ void gemm_phase(LAS unsigned char* lds, const int tid, const Gemm g, const Sched& S, const Epi& E) {
    const int wid = __builtin_amdgcn_readfirstlane(tid >> 6), lane = tid & 63, wr = wid >> 2, wc = wid & 3, fr = lane & 15, fq = lane >> 4;
    const int nt = g.K / BK;
    unsigned voffA[2], voffB[2];
#pragma unroll
    for (int i = 0; i < 2; ++i) { int R, C; stage_rc(tid * 16 + i * 8192, R, C); const int Rb = Epi::PERM ? ((R & ~31) + perm32(R & 31)) : R;
        voffA[i] = (unsigned)(R * g.lda + C) * 2u; voffB[i] = (unsigned)(Rb * g.ldb + C) * 2u; }
    const size_t kstep = (size_t)(BK * 2);
    const size_t hstepA = (size_t)HALF * g.lda * 2, hstepB = (size_t)HALF * g.ldb * 2;
    const unsigned ldsw = (unsigned)wid * 1024u;
    const int aoff = lds_byte(wr * 64 + fr, fq * 8), boff = lds_byte(wc * 32 + fr, fq * 8);
#define PG8_SA(b, h) (((b) * 2 + (h)) * HTB)
#define PG8_SB(b, h) ((4 + (b) * 2 + (h)) * HTB)
#define PG8_STAGE(bufoff, gbase, voff) do { _Pragma("unroll") for (int _i = 0; _i < 2; ++_i) \
        __builtin_amdgcn_global_load_lds((const unsigned*)((const char*)(gbase) + (voff)[_i]), (LAS unsigned*)(lds + (bufoff) + ldsw + _i * 8192), 16, 0, 0); } while (0)
#define PG8_LDA(dst, b, h) do { _Pragma("unroll") for (int m = 0; m < 4; ++m) _Pragma("unroll") for (int k = 0; k < 2; ++k) dst[m][k] = *(const LAS bf16x8*)(lds + PG8_SA(b, h) + aoff + m * 2048 + k * 1024); } while (0)
#define PG8_LDB(dst, b, h) do { _Pragma("unroll") for (int n = 0; n < 2; ++n) _Pragma("unroll") for (int k = 0; k < 2; ++k) dst[n][k] = *(const LAS bf16x8*)(lds + PG8_SB(b, h) + boff + n * 2048 + k * 1024); } while (0)
#define PG8_MMA(ai, bj, At, Bt) do { __builtin_amdgcn_s_setprio(1); _Pragma("unroll") for (int m = 0; m < 4; ++m) _Pragma("unroll") for (int n = 0; n < 2; ++n) _Pragma("unroll") for (int k = 0; k < 2; ++k) \
        acc[ai][bj][m][n] = __builtin_amdgcn_mfma_f32_16x16x32_bf16(Bt[n][k], At[m][k], acc[ai][bj][m][n], 0, 0, 0); __builtin_amdgcn_s_setprio(0); } while (0)
#define PG8_WAIT_V(n) asm volatile("s_waitcnt vmcnt(" #n ")" ::: "memory")
#define PG8_WAIT_L(n) asm volatile("s_waitcnt lgkmcnt(" #n ")" ::: "memory")
#define PG8_BAR __builtin_amdgcn_s_barrier()
#define PG8_SCHED __builtin_amdgcn_sched_barrier(0)
    Unit cur, nxt; int ui = 0;
    if (!S.next(0, cur)) return;
    f32x4 acc[2][2][4][2];
#pragma unroll
    for (int a = 0; a < 2; ++a)
#pragma unroll
        for (int b = 0; b < 2; ++b)
#pragma unroll
            for (int m = 0; m < 4; ++m)
#pragma unroll
                for (int n = 0; n < 2; ++n) acc[a][b][m][n] = (f32x4){0.f, 0.f, 0.f, 0.f};
    bf16x8 At[4][2], B0[2][2], B1[2][2];
    const char* cA = (const char*)g.A + (size_t)cur.aoff * 2; const char* cB = (const char*)g.Bt + (size_t)cur.boff * 2;
    PG8_STAGE(PG8_SB(0, 0), cB, voffB); PG8_STAGE(PG8_SB(0, 1), cB + hstepB, voffB); PG8_STAGE(PG8_SA(0, 0), cA, voffA); PG8_STAGE(PG8_SA(0, 1), cA + hstepA, voffA);
    if (wr == 1) PG8_BAR;
    PG8_WAIT_V(2); PG8_BAR;
    PG8_STAGE(PG8_SB(1, 0), cB + kstep, voffB); PG8_STAGE(PG8_SA(1, 0), cA + kstep, voffA); PG8_STAGE(PG8_SB(1, 1), cB + hstepB + kstep, voffB);
    PG8_WAIT_V(6); PG8_BAR;
    for (;;) {
        const bool has_next = S.next(ui + 1, nxt);
        const char* nA = has_next ? (const char*)g.A + (size_t)nxt.aoff * 2 : cA; const char* nB = has_next ? (const char*)g.Bt + (size_t)nxt.boff * 2 : cB;
        for (int t = 0; t < nt; t += 2) {
            const bool last = (t == nt - 2);
            const char* a1 = cA + (size_t)(t + 1) * kstep;
            const char* a2 = last ? nA : cA + (size_t)(t + 2) * kstep; const char* b2 = last ? nB : cB + (size_t)(t + 2) * kstep;
            const char* a3 = a2 + kstep; const char* b3 = b2 + kstep;
            PG8_LDB(B0, 0, 0); PG8_LDB(B1, 0, 1); PG8_SCHED; PG8_LDA(At, 0, 0); PG8_STAGE(PG8_SA(1, 1), a1 + hstepA, voffA);
            PG8_WAIT_V(8); PG8_WAIT_L(0); PG8_BAR; PG8_MMA(0, 0, At, B0); PG8_MMA(0, 1, At, B1); PG8_BAR; PG8_SCHED;
            PG8_LDA(At, 0, 1); PG8_STAGE(PG8_SB(0, 0), b2, voffB); PG8_STAGE(PG8_SB(0, 1), b2 + hstepB, voffB); PG8_STAGE(PG8_SA(0, 0), a2, voffA);
            PG8_WAIT_V(8); PG8_WAIT_L(0); PG8_BAR; PG8_MMA(1, 0, At, B0); PG8_MMA(1, 1, At, B1); PG8_BAR; PG8_SCHED;
            PG8_LDB(B0, 1, 0); PG8_LDB(B1, 1, 1); PG8_SCHED; PG8_LDA(At, 1, 0); PG8_STAGE(PG8_SA(0, 1), a2 + hstepA, voffA);
            PG8_WAIT_V(8); PG8_WAIT_L(0); PG8_BAR; PG8_MMA(0, 0, At, B0); PG8_MMA(0, 1, At, B1); PG8_BAR; PG8_SCHED;
            PG8_LDA(At, 1, 1); PG8_STAGE(PG8_SB(1, 0), b3, voffB); PG8_STAGE(PG8_SB(1, 1), b3 + hstepB, voffB); PG8_STAGE(PG8_SA(1, 0), a3, voffA);
            PG8_WAIT_V(8); PG8_WAIT_L(0); PG8_BAR; PG8_MMA(1, 0, At, B0); PG8_MMA(1, 1, At, B1); PG8_BAR; PG8_SCHED;
        }
        if constexpr (ALIGN_EPI) { if (wr == 0) PG8_BAR; }
        if constexpr (!Epi::AFTER_DRAIN) { E(acc, cur, wr, wc, fr, fq); }
        if (!has_next) break;
#pragma unroll
        for (int a = 0; a < 2; ++a)
#pragma unroll
            for (int b = 0; b < 2; ++b)
#pragma unroll
                for (int m = 0; m < 4; ++m)
#pragma unroll
                    for (int n = 0; n < 2; ++n) acc[a][b][m][n] = (f32x4){0.f, 0.f, 0.f, 0.f};
        cur = nxt; cA = nA; cB = nB; ++ui;
        if constexpr (ALIGN_EPI) { if (wr == 1) PG8_BAR; }
    }
    PG8_WAIT_V(0);
    if constexpr (!ALIGN_EPI) { if (wr == 0) PG8_BAR; }
    PG8_BAR;
    if constexpr (Epi::AFTER_DRAIN) { E.fused(acc, cur, wr, wc, fr, fq, lds, wid, lane); }
#undef PG8_SA
#undef PG8_SB
#undef PG8_STAGE
#undef PG8_LDA
#undef PG8_LDB
#undef PG8_MMA
#undef PG8_WAIT_V
#undef PG8_WAIT_L
#undef PG8_BAR
#undef PG8_SCHED
}

struct PlainSched {
    int nM, nN, nwg, G, c; unsigned am, bn;
    __device__ __forceinline__ void init(int M, int N, int lda, int ldb, int G_, int c_) { nM = M / BM; nN = N / BM; nwg = nM * nN; G = G_; c = c_; am = (unsigned)(BM * lda); bn = (unsigned)(BM * ldb); }
    __device__ __forceinline__ bool next(int i, Unit& u) const {
        const long L = (long)i * G + c; if (L >= nwg) return false;
        int wgid = (int)L; { const int q = nwg / NXCD, r = nwg % NXCD, xcd = wgid % NXCD, off = wgid / NXCD; wgid = (xcd < r ? xcd * (q + 1) : r * (q + 1) + (xcd - r) * q) + off; }
        const int nig = WGM * nN, gid = wgid / nig, fm = gid * WGM, gsz = (nM - fm) < WGM ? (nM - fm) : WGM;
        const int pm = fm + ((wgid % nig) % gsz), pn = (wgid % nig) / gsz;
        u.aoff = (unsigned)pm * am; u.boff = (unsigned)pn * bn; u.crow = pm * BM; u.ccol = pn * BM; u.z = 0; return true;
    }
};
struct MemKVSched {
    int c, first;
    __device__ __forceinline__ bool next(int i, Unit& u) const {
        const int L = c - first; if (i != 0 || L < 0 || L >= 64) return false;
        const int z = L >> 4, pm = (L >> 3) & 1, pn = L & 7;
        u.aoff = (unsigned)(pm * 256 * 1024); u.boff = (unsigned)((z * 2048 + pn * 256) * 1024); u.crow = pm * 256; u.ccol = pn * 256; u.z = z; return true;
    }
};
struct MemSSched {
    int c, layer;
    __device__ __forceinline__ bool next(int i, Unit& u) const {
        if (i != 0 || c >= 256) return false;
        const int b = c >> 7, h = (c >> 5) & 3, pm = c & 31;
        u.aoff = (unsigned)((b * SEQ + pm * 256) * 1024 + h * 256); u.boff = (unsigned)((layer * 512 + b * 256) * 1024 + h * 256);
        u.crow = b * SEQ + pm * 256; u.ccol = h * 256; u.z = 0; return true;
    }
};
struct MemPVSched {
    int c, layer;
    __device__ __forceinline__ bool next(int i, Unit& u) const {
        if (i != 0 || c >= 256) return false;
        const int b = c >> 7, h = (c >> 5) & 3, pm = c & 31;
        u.aoff = (unsigned)((b * SEQ + pm * 256) * 1024 + h * 256); u.boff = (unsigned)((layer * 1024 + h * 256) * 512 + b * 256);
        u.crow = b * SEQ + pm * 256; u.ccol = h * 256; u.z = 0; return true;
    }
};

struct EpiBf16 {
    static constexpr bool PERM = true, AFTER_DRAIN = false;
    bf16_t* O; int ldc;
    __device__ __forceinline__ void operator()(const f32x4 (&acc)[2][2][4][2], const Unit& u, int wr, int wc, int fr, int fq) const {
        const int row0 = u.crow + wr * 64 + fr, col0 = u.ccol + wc * 32 + 8 * fq;
#pragma unroll
        for (int ai = 0; ai < 2; ++ai)
#pragma unroll
            for (int m = 0; m < 4; ++m) { bf16_t* rowp = O + (size_t)(row0 + ai * HALF + m * 16) * ldc + col0;
#pragma unroll
                for (int bj = 0; bj < 2; ++bj) { const f32x4 v0 = acc[ai][bj][m][0], v1 = acc[ai][bj][m][1];
                    u32x4 w; w.x = cvt_pk_bf16(v0[0], v0[1]); w.y = cvt_pk_bf16(v0[2], v0[3]); w.z = cvt_pk_bf16(v1[0], v1[1]); w.w = cvt_pk_bf16(v1[2], v1[3]);
                    *(u32x4*)(rowp + bj * HALF) = w; } }
    }
};
struct EpiF32 {
    static constexpr bool PERM = false, AFTER_DRAIN = false;
    float* C; int ldc;
    __device__ __forceinline__ void operator()(const f32x4 (&acc)[2][2][4][2], const Unit& u, int wr, int wc, int fr, int fq) const {
        const int row0 = u.crow + wr * 64 + fr, col0 = u.ccol + wc * 32 + 4 * fq;
#pragma unroll
        for (int ai = 0; ai < 2; ++ai)
#pragma unroll
            for (int m = 0; m < 4; ++m) { float* rowp = C + (size_t)(row0 + ai * HALF + m * 16) * ldc + col0;
#pragma unroll
                for (int bj = 0; bj < 2; ++bj)
#pragma unroll
                    for (int n = 0; n < 2; ++n) *(f32x4*)(rowp + bj * HALF + n * 16) = acc[ai][bj][m][n]; }
    }
};
struct EpiMemKV {
    static constexpr bool PERM = false, AFTER_DRAIN = false;
    float* outK; float* outV; bf16_t* MK; bf16_t* MVT;
    __device__ __forceinline__ void operator()(const f32x4 (&acc)[2][2][4][2], const Unit& u, int wr, int wc, int fr, int fq) const {
        const int row0 = u.crow + wr * 64 + fr; const bool isV = u.ccol >= 1024; const int col0 = (isV ? u.ccol - 1024 : u.ccol) + wc * 32 + 4 * fq;
        float* C = (isV ? outV : outK) + (size_t)u.z * 512 * 1024;
#pragma unroll
        for (int ai = 0; ai < 2; ++ai)
#pragma unroll
            for (int m = 0; m < 4; ++m) { const int row = row0 + ai * HALF + m * 16;
#pragma unroll
                for (int bj = 0; bj < 2; ++bj)
#pragma unroll
                    for (int n = 0; n < 2; ++n) { const f32x4 v = acc[ai][bj][m][n]; const int col = col0 + bj * HALF + n * 16;
                        *(f32x4*)(C + (size_t)row * 1024 + col) = v;
                        if (!isV) { u32x2 w; w.x = cvt_pk_bf16(v[0], v[1]); w.y = cvt_pk_bf16(v[2], v[3]); *(u32x2*)(MK + ((size_t)u.z * 512 + row) * 1024 + col) = w; }
                        else {
#pragma unroll
                            for (int e = 0; e < 4; ++e) MVT[((size_t)u.z * 1024 + col + e) * 512 + row] = (bf16_t)f2bf(v[e]); } } }
    }
};
struct EpiSoftmax {
    static constexpr bool PERM = true, AFTER_DRAIN = true;
    bf16_t* P; int ldc; float scale_l2;
    __device__ __forceinline__ void fused(f32x4 (&acc)[2][2][4][2], const Unit& u, int wr, int wc, int fr, int fq, LAS unsigned char* lds, int wid, int lane) const {
        LAS f32x2* TAB = (LAS f32x2*)lds;
        float mw[2][4];
#pragma unroll
        for (int ai = 0; ai < 2; ++ai)
#pragma unroll
            for (int m = 0; m < 4; ++m) {
                float mx = -3.0e38f;
#pragma unroll
                for (int bj = 0; bj < 2; ++bj)
#pragma unroll
                    for (int n = 0; n < 2; ++n) { f32x4 x = acc[ai][bj][m][n] * scale_l2; acc[ai][bj][m][n] = x; mx = fmaxf(mx, fmaxf(fmaxf(x[0], x[1]), fmaxf(x[2], x[3]))); }
                mx = fmaxf(mx, __shfl_xor(mx, 16)); mx = fmaxf(mx, __shfl_xor(mx, 32));
                float s = 0.f;
#pragma unroll
                for (int bj = 0; bj < 2; ++bj)
#pragma unroll
                    for (int n = 0; n < 2; ++n) { f32x4 x = acc[ai][bj][m][n]; x[0] = __builtin_amdgcn_exp2f(x[0] - mx); x[1] = __builtin_amdgcn_exp2f(x[1] - mx); x[2] = __builtin_amdgcn_exp2f(x[2] - mx); x[3] = __builtin_amdgcn_exp2f(x[3] - mx);
                        acc[ai][bj][m][n] = x; s += (x[0] + x[1]) + (x[2] + x[3]); }
                s += __shfl_xor(s, 16); s += __shfl_xor(s, 32);
                mw[ai][m] = mx;
                if (fq == 0) TAB[(ai * HALF + wr * 64 + m * 16 + fr) * 4 + wc] = (f32x2){mx, s};
            }
        asm volatile("s_waitcnt lgkmcnt(0)" ::: "memory"); __builtin_amdgcn_s_barrier(); asm volatile("" ::: "memory");
        const int row0 = u.crow + wr * 64 + fr, col0 = u.ccol + wc * 32 + 8 * fq;
#pragma unroll
        for (int ai = 0; ai < 2; ++ai)
#pragma unroll
            for (int m = 0; m < 4; ++m) {
                const int r = ai * HALF + wr * 64 + m * 16 + fr;
                const f32x2 t0 = TAB[r * 4 + 0], t1 = TAB[r * 4 + 1], t2 = TAB[r * 4 + 2], t3 = TAB[r * 4 + 3];
                const float M = fmaxf(fmaxf(t0.x, t1.x), fmaxf(t2.x, t3.x));
                const float L = t0.y * __builtin_amdgcn_exp2f(t0.x - M) + t1.y * __builtin_amdgcn_exp2f(t1.x - M) + t2.y * __builtin_amdgcn_exp2f(t2.x - M) + t3.y * __builtin_amdgcn_exp2f(t3.x - M);
                const float f = __builtin_amdgcn_exp2f(mw[ai][m] - M) / L;
                bf16_t* rowp = P + (size_t)(row0 + ai * HALF + m * 16) * ldc + col0;
#pragma unroll
                for (int bj = 0; bj < 2; ++bj) { const f32x4 v0 = acc[ai][bj][m][0] * f, v1 = acc[ai][bj][m][1] * f;
                    u32x4 w; w.x = cvt_pk_bf16(v0[0], v0[1]); w.y = cvt_pk_bf16(v0[2], v0[3]); w.z = cvt_pk_bf16(v1[0], v1[1]); w.w = cvt_pk_bf16(v1[2], v1[3]);
                    *(u32x4*)(rowp + bj * HALF) = w; }
            }
        asm volatile("s_waitcnt lgkmcnt(0)" ::: "memory"); __builtin_amdgcn_s_barrier(); asm volatile("" ::: "memory");
    }
};
}

constexpr int NWAVES = 8, NTHREADS = 512;
struct Args { const float* in[23]; float* out; unsigned char* ws; int ph_lo, ph_hi; };
struct Frame { LAS unsigned char* lds; int tid, lane, wave, G, bid; };

__device__ __forceinline__ void p0_transpose_item(const float* W, int K, int N, bf16_t* WT, LAS float* scr, int item, int lane) {
    const int nblk = N / 32, kb = item / nblk, nb = item % nblk, k0 = 64 * kb, n0 = 32 * nb;
#pragma unroll 8
    for (int i = 0; i < 32; ++i) { const int kk = 2 * i + (lane >> 5); scr[kk * 33 + (lane & 31)] = W[(size_t)(k0 + kk) * N + n0 + (lane & 31)]; }
    LDS_WAIT(); asm volatile("" ::: "memory");
    const int c = lane & 7;
#pragma unroll
    for (int j = 0; j < 4; ++j) { const int n = (lane >> 3) + 8 * j; const LAS float* s = scr + (8 * c) * 33 + n;
        u32x4 o; o.x = pk2(s[0 * 33], s[1 * 33]); o.y = pk2(s[2 * 33], s[3 * 33]); o.z = pk2(s[4 * 33], s[5 * 33]); o.w = pk2(s[6 * 33], s[7 * 33]);
        *(u32x4*)(WT + (size_t)(n0 + n) * K + k0 + 8 * c) = o; }
    LDS_WAIT(); asm volatile("" ::: "memory");
}
__device__ __forceinline__ void cvt_bf16_range(const float* src, bf16_t* dst, size_t n, size_t gtid, size_t nthr) {
    for (size_t i = gtid * 8; i < n; i += nthr * 8) { const f32x4 a = *(const f32x4*)(src + i), b = *(const f32x4*)(src + i + 4);
        u32x4 o; o.x = pk2(a[0], a[1]); o.y = pk2(a[2], a[3]); o.z = pk2(b[0], b[1]); o.w = pk2(b[2], b[3]); *(u32x4*)(dst + i) = o; }
}
__device__ __forceinline__ unsigned pack_fp8x4(f32x4 a, float sc) {
    int p = __builtin_amdgcn_cvt_pk_fp8_f32(a[0] * sc, a[1] * sc, 0, false);
    p = __builtin_amdgcn_cvt_pk_fp8_f32(a[2] * sc, a[3] * sc, p, true);
    return (unsigned)p;
}
__device__ __forceinline__ void cvt_fp8_range(const float* src, unsigned char* dst, size_t n, float sc, size_t gtid, size_t nthr) {
    for (size_t i = gtid * 16; i < n; i += nthr * 16) {
        const f32x4 a = __builtin_nontemporal_load((const f32x4*)(src + i)), b = __builtin_nontemporal_load((const f32x4*)(src + i + 4)),
                    c = __builtin_nontemporal_load((const f32x4*)(src + i + 8)), d = __builtin_nontemporal_load((const f32x4*)(src + i + 12));
        u32x4 o; o.x = pack_fp8x4(a, sc); o.y = pack_fp8x4(b, sc); o.z = pack_fp8x4(c, sc); o.w = pack_fp8x4(d, sc); *(u32x4*)(dst + i) = o; }
}
__device__ __forceinline__ void p0_prologue(const Frame& F, const Args& A) {
    unsigned char* ws = A.ws;
    LAS float* scr = (LAS float*)(F.lds + F.wave * 16384);
    const int gw = F.bid * NWAVES + F.wave, NGW = F.G * NWAVES;
    constexpr int NITEMS = 2 * 768 + 2 * 512 + 2 * 1536 + 2 * 512 + 4 * 512 + 4 * 1024 + 4 * 512 + 4 * 1024;
#define TR_GROUP(SRC, DSTOFF, NL, NN) { constexpr int IT = 16 * ((NN) / 32); if (r < (NL) * IT) { const int l = r / IT, it2 = r % IT; \
        p0_transpose_item((SRC) + (size_t)l * 1024 * (NN), 1024, (NN), (bf16_t*)(ws + (DSTOFF)) + (size_t)l * (NN) * 1024, scr, it2, F.lane); continue; } r -= (NL) * IT; }
    for (int it = gw; it < NITEMS; it += NGW) {
        int r = it;
        TR_GROUP(A.in[8], WS_WQKV, 2, 1536)
        TR_GROUP(A.in[10], WS_WO, 2, 1024)
        TR_GROUP(A.in[11], WS_WIN, 2, 3072)
        TR_GROUP(A.in[13], WS_WOUT, 2, 1024)
        TR_GROUP(A.in[14], WS_WMQ, 4, 1024)
        TR_GROUP(A.in[15], WS_WMKV, 4, 2048)
        TR_GROUP(A.in[16], WS_WMO, 4, 1024)
        TR_GROUP(A.in[17], WS_WPQ, 4, 2048)
    }
#undef TR_GROUP
    const size_t gtid = (size_t)F.bid * NTHREADS + F.tid, nthr = (size_t)F.G * NTHREADS;
    cvt_bf16_range(A.in[18], (bf16_t*)(ws + WS_SUBK), (size_t)NLAYER * 2 * 128 * 128, gtid, nthr);
    cvt_bf16_range(A.in[7], (bf16_t*)(ws + WS_MEMB), (size_t)512 * 1024, gtid, nthr);
    cvt_bf16_range(A.in[0], (bf16_t*)(ws + WS_XB), (size_t)TP * D, gtid, nthr);
    cvt_bf16_range(A.in[1], (bf16_t*)(ws + WS_XB) + (size_t)TP * D, (size_t)TS * D, gtid, nthr);
    cvt_fp8_range(A.in[19], ws + WS_PU8, (size_t)NLAYER * NEXP * D, U_SCALE, gtid, nthr);
    cvt_fp8_range(A.in[20], ws + WS_PV8, (size_t)NLAYER * NEXP * D, V_SCALE, gtid, nthr);
}

__device__ __forceinline__ void ln_phase(const Frame& F, const float* xa, const float* xb, const float* Fb, const float* gam, const float* bet,
                                         float* X, bf16_t* XB, unsigned char* X8  ) {
    const int gw = F.bid * NWAVES + F.wave, NGW = F.G * NWAVES, lane = F.lane;
    f32x4 gv[4], bv[4];
#pragma unroll
    for (int j = 0; j < 4; ++j) { gv[j] = *(const f32x4*)(gam + 4 * lane + 256 * j); bv[j] = *(const f32x4*)(bet + 4 * lane + 256 * j); }
    for (int r = gw; r < T; r += NGW) {
        const float* xr = (r < TP) ? xa + (size_t)r * D : xb + (size_t)(r - TP) * D;
        const float* fr = Fb + (size_t)r * D;
        f32x4 v[4]; float s = 0.f;
#pragma unroll
        for (int j = 0; j < 4; ++j) { const f32x4 x = *(const f32x4*)(xr + 4 * lane + 256 * j), f = *(const f32x4*)(fr + 4 * lane + 256 * j); v[j] = x * DN_ALPHA + f; s += (v[j][0] + v[j][1]) + (v[j][2] + v[j][3]); }
        const float mean = wave_sum(s) * (1.f / D); float s2 = 0.f;
#pragma unroll
        for (int j = 0; j < 4; ++j) { v[j] = v[j] - mean; s2 += (v[j][0] * v[j][0] + v[j][1] * v[j][1]) + (v[j][2] * v[j][2] + v[j][3] * v[j][3]); }
        const float rstd = 1.f / sqrtf(wave_sum(s2) * (1.f / D) + LN_EPS);
#pragma unroll
        for (int j = 0; j < 4; ++j) { const f32x4 y = v[j] * rstd * gv[j] + bv[j];
            *(f32x4*)(X + (size_t)r * D + 4 * lane + 256 * j) = y;
            u32x2 w; w.x = pk2(y[0], y[1]); w.y = pk2(y[2], y[3]); *(u32x2*)(XB + (size_t)r * D + 4 * lane + 256 * j) = w;
            if (X8) *(unsigned*)(X8 + (size_t)r * D + 4 * lane + 256 * j) = pack_fp8x4(y, 1.0f); }
    }
}

__device__ __forceinline__ void load_u8(const bf16_t* BIG, int row, int c0, float (&u)[8]) {
    const u32x4 gc = *(const u32x4*)(BIG + (size_t)row * 3072 + 1024 + c0), h = *(const u32x4*)(BIG + (size_t)row * 3072 + 2048 + c0);
#pragma unroll
    for (int e = 0; e < 4; ++e) { u[2 * e] = bflo(gc[e]) * bflo(h[e]); u[2 * e + 1] = bfhi(gc[e]) * bfhi(h[e]); }
}
__device__ __forceinline__ void conv_phase(const Frame& F, const bf16_t* BIG, bf16_t* OB, const float* cw  , const float* state  , float* cvp  , float* cvs  ) {
    const size_t gtid = (size_t)F.bid * NTHREADS + F.tid, nthr = (size_t)F.G * NTHREADS;
    for (size_t idx = gtid; idx < (size_t)T * 128; idx += nthr) {
        const int r = (int)(idx >> 7), c0 = (int)(idx & 127) * 8;
        float u0[8], um1[8], um2[8];
        load_u8(BIG, r, c0, u0);
        if (r < TP) {
            const int t = r & (SEQ - 1), b = r >> 13;
            if (t >= 1) load_u8(BIG, r - 1, c0, um1); else {
#pragma unroll
                for (int e = 0; e < 8; ++e) um1[e] = 0.f; }
            if (t >= 2) load_u8(BIG, r - 2, c0, um2); else {
#pragma unroll
                for (int e = 0; e < 8; ++e) um2[e] = 0.f; }
            if (t >= SEQ - 2) { float* o = cvp + ((size_t)b * 2 + (t - (SEQ - 2))) * D + c0; *(f32x4*)o = (f32x4){u0[0], u0[1], u0[2], u0[3]}; *(f32x4*)(o + 4) = (f32x4){u0[4], u0[5], u0[6], u0[7]}; }
        } else {
            const int rr = r - TP, b = rr >> 2, l = rr & 3;
            const float* st = state + (size_t)b * 2 * D + c0;
            if (l >= 1) load_u8(BIG, r - 1, c0, um1); else { const f32x4 a = *(const f32x4*)(st + D), c = *(const f32x4*)(st + D + 4);
#pragma unroll
                for (int e = 0; e < 4; ++e) { um1[e] = a[e]; um1[4 + e] = c[e]; } }
            if (l >= 2) load_u8(BIG, r - 2, c0, um2); else { const f32x4 a = *(const f32x4*)(st + (size_t)l * D), c = *(const f32x4*)(st + (size_t)l * D + 4);
#pragma unroll
                for (int e = 0; e < 4; ++e) { um2[e] = a[e]; um2[4 + e] = c[e]; } }
            if (l >= 2) { float* o = cvs + ((size_t)b * 2 + (l - 2)) * D + c0; *(f32x4*)o = (f32x4){u0[0], u0[1], u0[2], u0[3]}; *(f32x4*)(o + 4) = (f32x4){u0[4], u0[5], u0[6], u0[7]}; }
        }
        const u32x4 gb = *(const u32x4*)(BIG + (size_t)r * 3072 + c0);
        float w0[8], w1[8], w2[8];
#pragma unroll
        for (int e = 0; e < 2; ++e) { const f32x4 a = *(const f32x4*)(cw + c0 + 4 * e), b2 = *(const f32x4*)(cw + D + c0 + 4 * e), c = *(const f32x4*)(cw + 2 * D + c0 + 4 * e);
#pragma unroll
            for (int q = 0; q < 4; ++q) { w0[4 * e + q] = a[q]; w1[4 * e + q] = b2[q]; w2[4 * e + q] = c[q]; } }
        float y[8];
#pragma unroll
        for (int e = 0; e < 8; ++e) { const float z = w0[e] * um2[e] + w1[e] * um1[e] + w2[e] * u0[e]; const float g = (e & 1) ? bfhi(gb[e >> 1]) : bflo(gb[e >> 1]); y[e] = g * z; }
        u32x4 o; o.x = pk2(y[0], y[1]); o.y = pk2(y[2], y[3]); o.z = pk2(y[4], y[5]); o.w = pk2(y[6], y[7]);
        *(u32x4*)(OB + (size_t)r * D + c0) = o;
    }
}

constexpr int AT_KP = 72, AT_VP = 264;
__device__ __forceinline__ void attn_prompt_unit(const Frame& F, const bf16_t* BIG, bf16_t* OB, const float* sinks, float* wkp, float* wvp, int unit) {
    const int kvh = unit & 3, qb = (unit >> 2) & 63, b = unit >> 8;
    const int tid = F.tid, lane = F.lane, wave = F.wave;
    LAS bf16_t* Ks = (LAS bf16_t*)F.lds;
    LAS bf16_t* Vt = (LAS bf16_t*)(F.lds + 256 * AT_KP * 2);
#pragma unroll
    for (int it = 0; it < 4; ++it) {
        const int id = tid + 512 * it, row = id >> 3, c16 = id & 7, kpos = qb * 128 - 128 + row;
        u32x4 kv = (u32x4){0u, 0u, 0u, 0u}, vv = (u32x4){0u, 0u, 0u, 0u};
        if (kpos >= 0) { const bf16_t* src = BIG + (size_t)(b * SEQ + kpos) * QKVW + 1024 + kvh * 64 + c16 * 8; kv = *(const u32x4*)src; vv = *(const u32x4*)(src + 256); }
        *(LAS u32x4*)(Ks + row * AT_KP + c16 * 8) = kv;
#pragma unroll
        for (int e = 0; e < 4; ++e) { Vt[(c16 * 8 + 2 * e) * AT_VP + row] = (bf16_t)(vv[e] & 0xffffu); Vt[(c16 * 8 + 2 * e + 1) * AT_VP + row] = (bf16_t)(vv[e] >> 16); }
    }
    WG_BAR();
    const int g = wave >> 1, half = wave & 1, head = kvh * 4 + g, qi = lane & 15, q4 = lane >> 4;
    const float sinkl = sinks[head] * LOG2E;
    constexpr float SC = 0.125f * LOG2E;
#pragma unroll 1
    for (int qt = 0; qt < 4; ++qt) {
        const int i0 = half * 64 + qt * 16, i = i0 + qi;
        const bf16_t* qp = BIG + (size_t)(b * SEQ + qb * 128 + i) * QKVW + head * 64 + q4 * 8;
        const bf16x8 qf0 = *(const bf16x8*)qp, qf1 = *(const bf16x8*)(qp + 32);
        const int t0 = i0 >> 4, t0p = t0 < 6 ? t0 : 6, kt0 = 16 * t0p;
        f32x4 acc[10];
#pragma unroll
        for (int t = 0; t < 10; ++t) {
            const LAS bf16_t* kr = Ks + (kt0 + 16 * t + qi) * AT_KP + q4 * 8;
            const bf16x8 kf0 = *(const LAS bf16x8*)kr, kf1 = *(const LAS bf16x8*)(kr + 32);
            f32x4 a = (f32x4){0.f, 0.f, 0.f, 0.f};
            a = __builtin_amdgcn_mfma_f32_16x16x32_bf16(kf0, qf0, a, 0, 0, 0);
            a = __builtin_amdgcn_mfma_f32_16x16x32_bf16(kf1, qf1, a, 0, 0, 0);
            acc[t] = a;
        }
        float mx = -1.0e30f;
#pragma unroll
        for (int t = 0; t < 10; ++t)
#pragma unroll
            for (int r = 0; r < 4; ++r) { const int kk = kt0 + 16 * t + 4 * q4 + r; const bool ok = (kk >= i) && (kk <= i + 128) && (qb > 0 || kk >= 128);
                const float s = ok ? acc[t][r] * SC : -1.0e30f; acc[t][r] = s; mx = fmaxf(mx, s); }
        mx = fmaxf(mx, __shfl_xor(mx, 16)); mx = fmaxf(mx, __shfl_xor(mx, 32)); mx = fmaxf(mx, sinkl);
        float sum = 0.f;
#pragma unroll
        for (int t = 0; t < 10; ++t)
#pragma unroll
            for (int r = 0; r < 4; ++r) { const float p = __builtin_amdgcn_exp2f(acc[t][r] - mx); acc[t][r] = p; sum += p; }
        sum += __shfl_xor(sum, 16); sum += __shfl_xor(sum, 32);
        const float inv = 1.f / (sum + __builtin_amdgcn_exp2f(sinkl - mx));
        f32x4 o[4];
#pragma unroll
        for (int dt = 0; dt < 4; ++dt) o[dt] = (f32x4){0.f, 0.f, 0.f, 0.f};
#pragma unroll
        for (int s2 = 0; s2 < 5; ++s2) {
            u32x4 pw; pw.x = cvt_pk_bf16(acc[2 * s2][0], acc[2 * s2][1]); pw.y = cvt_pk_bf16(acc[2 * s2][2], acc[2 * s2][3]);
            pw.z = cvt_pk_bf16(acc[2 * s2 + 1][0], acc[2 * s2 + 1][1]); pw.w = cvt_pk_bf16(acc[2 * s2 + 1][2], acc[2 * s2 + 1][3]);
            const bf16x8 pf = __builtin_bit_cast(bf16x8, pw);
#pragma unroll
            for (int dt = 0; dt < 4; ++dt) {
                const LAS bf16_t* vr = Vt + (16 * dt + qi) * AT_VP + kt0 + 32 * s2 + 4 * q4;
                const u32x2 lo = *(const LAS u32x2*)vr, hi = *(const LAS u32x2*)(vr + 16);
                u32x4 vw; vw.x = lo.x; vw.y = lo.y; vw.z = hi.x; vw.w = hi.y;
                o[dt] = __builtin_amdgcn_mfma_f32_16x16x32_bf16(__builtin_bit_cast(bf16x8, vw), pf, o[dt], 0, 0, 0);
            }
        }
        bf16_t* op = OB + (size_t)(b * SEQ + qb * 128 + i) * D + head * 64 + 4 * q4;
#pragma unroll
        for (int dt = 0; dt < 4; ++dt) { u32x2 w; w.x = pk2(o[dt][0] * inv, o[dt][1] * inv); w.y = pk2(o[dt][2] * inv, o[dt][3] * inv); *(u32x2*)(op + 16 * dt) = w; }
    }
    if (qb == 63) {
        for (int e = tid; e < 128 * 64; e += NTHREADS) { const int i = e >> 6, d = e & 63;
            wkp[((size_t)(b * 128 + i) * 4 + kvh) * 64 + d] = bf2f(Ks[(128 + i) * AT_KP + d]);
            wvp[((size_t)(b * 128 + i) * 4 + kvh) * 64 + d] = bf2f(Vt[d * AT_VP + 128 + i]); }
    }
    WG_BAR();
}

constexpr int AS_P = 65;
__device__ __forceinline__ void attn_sample_unit(const Frame& F, const bf16_t* BIG, bf16_t* OB, const float* sinks, const float* cwk, const float* cwv  ,
                                                 float* wks, float* wvs, int unit) {
    const int kvh = unit & 3, b = unit >> 2, tid = F.tid, lane = F.lane, wave = F.wave;
    LAS float* Kc = (LAS float*)F.lds;
    LAS float* Vc = Kc + 132 * AS_P;
    LAS float* Ps = Vc + 132 * AS_P;
    LAS float* Qs = Ps + 16 * 136;
#pragma unroll
    for (int it = 0; it < 4; ++it) { const int id = tid + 512 * it, row = id >> 4, c4 = id & 15;
        const size_t so = (((size_t)b * 128 + row) * 4 + kvh) * 64 + c4 * 4;
        const f32x4 k = *(const f32x4*)(cwk + so), v = *(const f32x4*)(cwv + so);
#pragma unroll
        for (int e = 0; e < 4; ++e) { Kc[row * AS_P + c4 * 4 + e] = k[e]; Vc[row * AS_P + c4 * 4 + e] = v[e]; } }
    if (tid < 256) { const int l = tid >> 6, d = tid & 63; const bf16_t* src = BIG + (size_t)(TP + b * 4 + l) * QKVW + 1024 + kvh * 64 + d;
        Kc[(128 + l) * AS_P + d] = bf2f(src[0]); Vc[(128 + l) * AS_P + d] = bf2f(src[256]); }
#pragma unroll
    for (int e = 0; e < 2; ++e) { const int idx = tid + 512 * e, qrow = idx >> 6, d = idx & 63, g = qrow >> 2, l = qrow & 3;
        Qs[qrow * 64 + d] = bf2f(BIG[(size_t)(TP + b * 4 + l) * QKVW + (kvh * 4 + g) * 64 + d]); }
    WG_BAR();
    constexpr float SC = 0.125f * LOG2E;
    {
        float s[2][3];
#pragma unroll
        for (int p = 0; p < 3; ++p) { s[0][p] = 0.f; s[1][p] = 0.f; }
        const int kc2 = (lane + 128 < 132) ? lane + 128 : 131;
#pragma unroll 1
        for (int d = 0; d < 64; d += 4) {
            const f32x4 q0 = *(const LAS f32x4*)(Qs + (2 * wave) * 64 + d), q1 = *(const LAS f32x4*)(Qs + (2 * wave + 1) * 64 + d);
#pragma unroll
            for (int p = 0; p < 3; ++p) { const int key = (p < 2) ? lane + 64 * p : kc2;
#pragma unroll
                for (int e = 0; e < 4; ++e) { const float kd = Kc[key * AS_P + d + e]; s[0][p] += q0[e] * kd; s[1][p] += q1[e] * kd; } }
        }
#pragma unroll
        for (int rr = 0; rr < 2; ++rr) { const int qrow = 2 * wave + rr, l = qrow & 3, g = qrow >> 2; const float sinkl = sinks[kvh * 4 + g] * LOG2E;
            float mx = -1.0e30f;
#pragma unroll
            for (int p = 0; p < 3; ++p) { const int key = lane + 64 * p; const bool ok = key < 128 ? (key >= l) : (key < 132 && (key - 128) <= l);
                s[rr][p] = ok ? s[rr][p] * SC : -1.0e30f; mx = fmaxf(mx, s[rr][p]); }
            mx = fmaxf(wave_max(mx), sinkl);
            float sum = 0.f;
#pragma unroll
            for (int p = 0; p < 3; ++p) { s[rr][p] = __builtin_amdgcn_exp2f(s[rr][p] - mx); sum += s[rr][p]; }
            sum = wave_sum(sum);
            const float inv = 1.f / (sum + __builtin_amdgcn_exp2f(sinkl - mx));
#pragma unroll
            for (int p = 0; p < 3; ++p) { const int key = lane + 64 * p; if (key < 132) Ps[qrow * 136 + key] = s[rr][p] * inv; } }
    }
    WG_BAR();
    {
        float o0 = 0.f, o1 = 0.f;
#pragma unroll 4
        for (int key = 0; key < 132; ++key) { const float v = Vc[key * AS_P + lane]; o0 += Ps[(2 * wave) * 136 + key] * v; o1 += Ps[(2 * wave + 1) * 136 + key] * v; }
#pragma unroll
        for (int rr = 0; rr < 2; ++rr) { const int qrow = 2 * wave + rr, l = qrow & 3, g = qrow >> 2;
            OB[(size_t)(TP + b * 4 + l) * D + (kvh * 4 + g) * 64 + lane] = (bf16_t)f2bf(rr ? o1 : o0); }
    }
    for (int e = tid; e < 128 * 64; e += NTHREADS) { const int i = e >> 6, d = e & 63; const size_t oo = (((size_t)b * 128 + i) * 4 + kvh) * 64 + d;
        wks[oo] = Kc[(i + 4) * AS_P + d]; wvs[oo] = Vc[(i + 4) * AS_P + d]; }
    WG_BAR();
}

__device__ __forceinline__ void mem_sample_unit(const Frame& F, const bf16_t* QM, bf16_t* OB, const float* ck, const float* cv  , int unit) {
    const int h = unit & 3, b = unit >> 2, tid = F.tid, lane = F.lane, wave = F.wave;
    LAS float* Sc = (LAS float*)F.lds;
    LAS float* PT = Sc + 1024;
    LAS float* Red = PT + 1024;
    f32x4 q[4];
#pragma unroll
    for (int l = 0; l < 4; ++l) { const u32x2 w = *(const u32x2*)(QM + (size_t)(TP + b * 4 + l) * D + h * 256 + 4 * lane); q[l] = (f32x4){bflo(w.x), bfhi(w.x), bflo(w.y), bfhi(w.y)}; }
    const float* kb = ck + ((size_t)b * 256 * 4 + h) * 256 + 4 * lane;
    const float* vb = cv + ((size_t)b * 256 * 4 + h) * 256 + 4 * lane;
#pragma unroll 1
    for (int m0 = 0; m0 < 32; m0 += 8) {
        f32x4 kr[8];
#pragma unroll
        for (int j = 0; j < 8; ++j) kr[j] = __builtin_nontemporal_load((const f32x4*)(kb + (size_t)(wave * 32 + m0 + j) * 1024));
#pragma unroll
        for (int j = 0; j < 8; ++j) {
            float d[4];
#pragma unroll
            for (int l = 0; l < 4; ++l) d[l] = wave_sum((q[l][0] * kr[j][0] + q[l][1] * kr[j][1]) + (q[l][2] * kr[j][2] + q[l][3] * kr[j][3]));
            if (lane < 4) Sc[lane * 256 + wave * 32 + m0 + j] = (lane == 0 ? d[0] : lane == 1 ? d[1] : lane == 2 ? d[2] : d[3]);
        }
    }
    WG_BAR();
    if (wave < 4) {
        constexpr float SC = 0.0625f * LOG2E;
        float s[4]; float mx = -3.0e38f;
#pragma unroll
        for (int j = 0; j < 4; ++j) { s[j] = Sc[wave * 256 + lane + 64 * j] * SC; mx = fmaxf(mx, s[j]); }
        mx = wave_max(mx); float sum = 0.f;
#pragma unroll
        for (int j = 0; j < 4; ++j) { s[j] = __builtin_amdgcn_exp2f(s[j] - mx); sum += s[j]; }
        const float inv = 1.f / wave_sum(sum);
#pragma unroll
        for (int j = 0; j < 4; ++j) PT[(lane + 64 * j) * 4 + wave] = s[j] * inv;
    }
    WG_BAR();
    f32x4 o[4];
#pragma unroll
    for (int l = 0; l < 4; ++l) o[l] = (f32x4){0.f, 0.f, 0.f, 0.f};
#pragma unroll 1
    for (int m0 = 0; m0 < 32; m0 += 8) {
        f32x4 vr[8];
#pragma unroll
        for (int j = 0; j < 8; ++j) vr[j] = __builtin_nontemporal_load((const f32x4*)(vb + (size_t)(wave * 32 + m0 + j) * 1024));
#pragma unroll
        for (int j = 0; j < 8; ++j) { const f32x4 p = *(const LAS f32x4*)(PT + (wave * 32 + m0 + j) * 4);
#pragma unroll
            for (int l = 0; l < 4; ++l) o[l] += vr[j] * p[l]; }
    }
#pragma unroll
    for (int l = 0; l < 4; ++l) *(LAS f32x4*)(Red + (wave * 4 + l) * 256 + 4 * lane) = o[l];
    WG_BAR();
#pragma unroll
    for (int e = 0; e < 2; ++e) { const int idx = tid + 512 * e, l = idx >> 8, d = idx & 255; float a = 0.f;
#pragma unroll
        for (int w = 0; w < 8; ++w) a += Red[(w * 4 + l) * 256 + d];
        OB[(size_t)(TP + b * 4 + l) * D + h * 256 + d] = (bf16_t)f2bf(a); }
    WG_BAR();
}

#define CE_DESC(a, b) { const float _hi = fmaxf(a, b), _lo = fminf(a, b); a = _hi; b = _lo; }
#define CE_ASC(a, b)  { const float _hi = fmaxf(a, b), _lo = fminf(a, b); a = _lo; b = _hi; }
template <int OFF> __device__ __forceinline__ void sort16_desc(float (&v)[64]) {
#pragma unroll
    for (int kk = 0; kk < 4; ++kk)
#pragma unroll
        for (int jj = kk; jj >= 0; --jj)
#pragma unroll
            for (int i = 0; i < 16; ++i) { const int k = 2 << kk, j = 1 << jj, l = i ^ j; if (l > i) { if ((i & k) == 0) CE_DESC(v[OFF + i], v[OFF + l]) else CE_ASC(v[OFF + i], v[OFF + l]) } }
}
__device__ __forceinline__ void merge_top16(float (&a)[16], const float (&b)[16]) {
#pragma unroll
    for (int i = 0; i < 16; ++i) a[i] = fmaxf(a[i], b[15 - i]);
#pragma unroll
    for (int jj = 3; jj >= 0; --jj)
#pragma unroll
        for (int i = 0; i < 16; ++i) { const int j = 1 << jj, l = i ^ j; if (l > i) CE_DESC(a[i], a[l]) }
}
__device__ __forceinline__ void top16_of_64(float (&v)[64], float (&out)[16]) {
    sort16_desc<0>(v); sort16_desc<16>(v); sort16_desc<32>(v); sort16_desc<48>(v);
    float b[16], c[16];
#pragma unroll
    for (int i = 0; i < 16; ++i) { out[i] = v[i]; b[i] = v[16 + i]; }
    merge_top16(out, b);
#pragma unroll
    for (int i = 0; i < 16; ++i) { c[i] = v[32 + i]; b[i] = v[48 + i]; }
    merge_top16(c, b);
    merge_top16(out, c);
}
__host__ __device__ constexpr int cand_cnt(int i) { return 16 / (i + 1); }
__host__ __device__ constexpr int cand_off(int i) { int o = 0; for (int k = 0; k < i; ++k) o += cand_cnt(k); return o; }
static_assert(cand_off(16) == 50, "50 admissible (i, j) pairs");

constexpr int RT_SKP = 136;
constexpr int RT_TBL_OFF = 2 * 128 * RT_SKP * 2;
__device__ __forceinline__ void router_phase(const Frame& F, const bf16_t* BIG, const bf16_t* SUBK  , int* EID, float* GW) {
    const int tid = F.tid, lane = F.lane, wave = F.wave;
    LAS bf16_t* SK = (LAS bf16_t*)F.lds;
    LAS unsigned char* TBL = F.lds + RT_TBL_OFF + (wave * 64 + lane) * 36;
#pragma unroll
    for (int it = 0; it < 8; ++it) { const int id = tid + 512 * it, c = id >> 11, n = (id >> 4) & 127, k16 = id & 15;
        *(LAS u32x4*)(SK + (c * 128 + n) * RT_SKP + k16 * 8) = *(const u32x4*)(SUBK + (size_t)(c * 128 + n) * 128 + k16 * 8); }
    WG_BAR();
    const int gw = F.bid * NWAVES + wave, NGW = F.G * NWAVES, r31 = lane & 31, hh = lane >> 5;
#pragma unroll 1
    for (int unit = gw; unit < (T / 32) * 4; unit += NGW) {
        const int tg = unit >> 2, hp = unit & 3, tok = tg * 32 + r31;
        float keepA[2][16], a[16], b[16];
#pragma unroll 1
        for (int p = 0; p < 4; ++p) {
            const int head = 2 * hp + (p >> 1), c = p & 1;
            const bf16_t* qp = BIG + (size_t)tok * 2048 + head * 256 + c * 128 + 8 * hh;
            bf16x8 qf[8];
#pragma unroll
            for (int s = 0; s < 8; ++s) qf[s] = *(const bf16x8*)(qp + 16 * s);
            float v[64];
#pragma unroll
            for (int kt = 0; kt < 4; ++kt) {
                f32x16 acc;
#pragma unroll
                for (int e = 0; e < 16; ++e) acc[e] = 0.f;
                const LAS bf16_t* kr = SK + (c * 128 + kt * 32 + r31) * RT_SKP + 8 * hh;
#pragma unroll
                for (int s = 0; s < 8; ++s) acc = __builtin_amdgcn_mfma_f32_32x32x16_bf16(*(const LAS bf16x8*)(kr + 16 * s), qf[s], acc, 0, 0, 0);
#pragma unroll
                for (int e = 0; e < 16; ++e) { const unsigned key = (unsigned)(32 * kt + (e & 3) + 8 * (e >> 2)) + 4u * (unsigned)hh;
                    float x_ = acc[e]; asm volatile("" : "+v"(x_));
                    v[kt * 16 + e] = __builtin_bit_cast(float, (__builtin_bit_cast(unsigned, x_) & ~127u) | key); }
            }
            float f[16], o[16];
            top16_of_64(v, f);
#pragma unroll
            for (int i = 0; i < 16; ++i) o[i] = __shfl_xor(f[i], 32);
            merge_top16(f, o);
            if (p < 2) {
#pragma unroll
                for (int i = 0; i < 16; ++i) { if (c == 0) keepA[0][i] = f[i]; else keepA[1][i] = f[i]; }
            } else {
#pragma unroll
                for (int i = 0; i < 16; ++i) { if (c == 0) a[i] = hh ? f[i] : keepA[0][i]; else b[i] = hh ? f[i] : keepA[1][i]; }
            }
        }
        const int head = 2 * hp + hh;
        float cv[64];
#pragma unroll
        for (int i = 0; i < 16; ++i)
#pragma unroll
            for (int j = 0; j < 16; ++j) if (j < cand_cnt(i)) {
                const float s = __builtin_bit_cast(float, __builtin_bit_cast(unsigned, a[i]) & ~127u) + __builtin_bit_cast(float, __builtin_bit_cast(unsigned, b[j]) & ~127u);
                cv[cand_off(i) + j] = __builtin_bit_cast(float, (__builtin_bit_cast(unsigned, s) & ~255u) | (unsigned)(i * 16 + j)); }
#pragma unroll
        for (int n = 50; n < 64; ++n) cv[n] = -3.0e38f;
        float top[16];
        top16_of_64(cv, top);
#pragma unroll
        for (int w = 0; w < 4; ++w) {
            const unsigned wa = (__builtin_bit_cast(unsigned, a[4 * w]) & 127u) | ((__builtin_bit_cast(unsigned, a[4 * w + 1]) & 127u) << 8) | ((__builtin_bit_cast(unsigned, a[4 * w + 2]) & 127u) << 16) | ((__builtin_bit_cast(unsigned, a[4 * w + 3]) & 127u) << 24);
            const unsigned wb = (__builtin_bit_cast(unsigned, b[4 * w]) & 127u) | ((__builtin_bit_cast(unsigned, b[4 * w + 1]) & 127u) << 8) | ((__builtin_bit_cast(unsigned, b[4 * w + 2]) & 127u) << 16) | ((__builtin_bit_cast(unsigned, b[4 * w + 3]) & 127u) << 24);
            *(LAS unsigned*)(TBL + 4 * w) = wa; *(LAS unsigned*)(TBL + 16 + 4 * w) = wb; }
        LDS_WAIT();
        const float c0 = __builtin_bit_cast(float, __builtin_bit_cast(unsigned, top[0]) & ~255u);
        float e[16]; float es = 0.f; int id[16];
#pragma unroll
        for (int k = 0; k < 16; ++k) { const unsigned bits = __builtin_bit_cast(unsigned, top[k]); const float cs = __builtin_bit_cast(float, bits & ~255u);
            e[k] = __builtin_amdgcn_exp2f((cs - c0) * LOG2E); es += e[k];
            const int i1 = TBL[(bits >> 4) & 15u], i2 = TBL[16 + (bits & 15u)]; id[k] = i1 * 128 + i2; }
        const float inv = 1.f / es;
#if MK_DEBUG
        { float* dp = (float*)((unsigned char*)EID - WS_EID + WS_SP) + ((size_t)tok * 8 + head) * 48;
#pragma unroll
          for (int i = 0; i < 16; ++i) { dp[i] = a[i]; dp[16 + i] = b[i]; dp[32 + i] = top[i]; } }
#endif
        int* ep = EID + ((size_t)tok * 8 + head) * 16; float* gp = GW + ((size_t)tok * 8 + head) * 16;
#pragma unroll
        for (int k = 0; k < 16; k += 4) { *(int4*)(ep + k) = make_int4(id[k], id[k + 1], id[k + 2], id[k + 3]); *(f32x4*)(gp + k) = (f32x4){e[k] * inv, e[k + 1] * inv, e[k + 2] * inv, e[k + 3] * inv}; }
        LDS_WAIT();
    }
    WG_BAR();
}

__device__ __forceinline__ float gelu_as(float v) {
    const float av = fabsf(v), d = av * 0.2316418882f + 1.0f, t = __builtin_amdgcn_rcpf(d);
    float q = t * 0.5307027145f + (-0.7265760135f); q = q * t + 0.7107068705f; q = q * t + (-0.142248368f); q = q * t + 0.127414796f; q = q * t;
    const float e = __builtin_amdgcn_exp2f(v * v * (-0.72134752044f)), m = v * (q * e);
    return v < 0.f ? m : v - m;
}
constexpr int EX_PITCH = 1040, EX_WBYTES = 16 * EX_PITCH + 512;
__device__ __forceinline__ void expert_phase(const Frame& F, const unsigned char* PU, const unsigned char* PV  , const unsigned char* X8, const int* EID, const float* GW,
                                             const float* Xin, float* Xout, bf16_t* XB, const float* gam, const float* bet) {
    const int lane = F.lane, wave = F.wave, r15 = lane & 15, q4 = lane >> 4;
    LAS unsigned char* buf = F.lds + wave * EX_WBYTES;
    LAS float* Aw = (LAS float*)(buf + 16 * EX_PITCH);
    const int gw = F.bid * NWAVES + wave, NGW = F.G * NWAVES;
    f32x4 gv[4], bv[4];
#pragma unroll
    for (int j = 0; j < 4; ++j) { gv[j] = *(const f32x4*)(gam + 16 * lane + 4 * j); bv[j] = *(const f32x4*)(bet + 16 * lane + 4 * j); }
#pragma unroll 1
    for (int t = gw; t < T; t += NGW) {
        const int e0 = EID[(size_t)t * 128 + lane], e1 = EID[(size_t)t * 128 + 64 + lane];
        {
            u32x4 xq[16];
#pragma unroll
            for (int s = 0; s < 16; ++s) xq[s] = *(const u32x4*)(X8 + (size_t)t * D + 64 * s + 16 * q4);
#pragma unroll 1
            for (int m = 0; m < 8; ++m) {
                const int ev = (m < 4) ? e0 : e1;
#pragma unroll
                for (int r = 0; r < 16; ++r) { const int j = __builtin_amdgcn_readlane(ev, ((m & 3) << 4) + r);
                    __builtin_amdgcn_global_load_lds((const unsigned*)(PU + (size_t)j * D + 16 * lane), (LAS unsigned*)(buf + r * EX_PITCH), 16, 0, 0); }
                const f32x4 gq = *(const f32x4*)(GW + (size_t)t * 128 + 16 * m + 4 * q4);
                VM_WAIT();
                f32x4 acc = (f32x4){0.f, 0.f, 0.f, 0.f};
#pragma unroll
                for (int s = 0; s < 16; ++s) { const u32x4 av = *(const LAS u32x4*)(buf + r15 * EX_PITCH + 64 * s + 16 * q4);
                    const long alo = (long)(((unsigned long long)av.y << 32) | av.x), ahi = (long)(((unsigned long long)av.w << 32) | av.z);
                    const long xlo = (long)(((unsigned long long)xq[s].y << 32) | xq[s].x), xhi = (long)(((unsigned long long)xq[s].w << 32) | xq[s].z);
                    acc = __builtin_amdgcn_mfma_f32_16x16x32_fp8_fp8(alo, xlo, acc, 0, 0, 0);
                    acc = __builtin_amdgcn_mfma_f32_16x16x32_fp8_fp8(ahi, xhi, acc, 0, 0, 0); }
                f32x4 av4;
#pragma unroll
                for (int r = 0; r < 4; ++r) av4[r] = gelu_as(acc[r] * (1.f / U_SCALE)) * gq[r] * (1.f / V_SCALE);
                if (r15 == 0) *(LAS f32x4*)(Aw + 16 * m + 4 * q4) = av4;
                LDS_WAIT();
            }
        }
        float f[16];
#pragma unroll
        for (int i = 0; i < 16; ++i) f[i] = 0.f;
#pragma unroll 1
        for (int j0 = 0; j0 < 128; j0 += 8) {
            const int ev = (j0 < 64) ? e0 : e1;
            u32x4 vr[8];
#pragma unroll
            for (int jj = 0; jj < 8; ++jj) { const int j = __builtin_amdgcn_readlane(ev, (j0 & 63) + jj); vr[jj] = *(const u32x4*)(PV + (size_t)j * D + 16 * lane); }
            const f32x4 a0 = *(const LAS f32x4*)(Aw + j0), a1 = *(const LAS f32x4*)(Aw + j0 + 4);
#pragma unroll
            for (int jj = 0; jj < 8; ++jj) { const float aj = jj < 4 ? a0[jj] : a1[jj - 4];
#pragma unroll
                for (int w = 0; w < 4; ++w) { const f32x2 lo = __builtin_amdgcn_cvt_pk_f32_fp8((int)vr[jj][w], false), hi = __builtin_amdgcn_cvt_pk_f32_fp8((int)vr[jj][w], true);
                    f[4 * w] += aj * lo.x; f[4 * w + 1] += aj * lo.y; f[4 * w + 2] += aj * hi.x; f[4 * w + 3] += aj * hi.y; } }
        }
        f32x4 v[4]; float s = 0.f;
#pragma unroll
        for (int j = 0; j < 4; ++j) { const f32x4 x = *(const f32x4*)(Xin + (size_t)t * D + 16 * lane + 4 * j); v[j] = x * DN_ALPHA + (f32x4){f[4 * j], f[4 * j + 1], f[4 * j + 2], f[4 * j + 3]}; s += (v[j][0] + v[j][1]) + (v[j][2] + v[j][3]); }
        const float mean = wave_sum(s) * (1.f / D); float s2 = 0.f;
#pragma unroll
        for (int j = 0; j < 4; ++j) { v[j] = v[j] - mean; s2 += (v[j][0] * v[j][0] + v[j][1] * v[j][1]) + (v[j][2] * v[j][2] + v[j][3] * v[j][3]); }
        const float rstd = 1.f / sqrtf(wave_sum(s2) * (1.f / D) + LN_EPS);
        u32x4 w0, w1;
#pragma unroll
        for (int j = 0; j < 4; ++j) { const f32x4 y = v[j] * rstd * gv[j] + bv[j]; *(f32x4*)(Xout + (size_t)t * D + 16 * lane + 4 * j) = y;
            const unsigned p0 = pk2(y[0], y[1]), p1 = pk2(y[2], y[3]);
            if (j == 0) { w0.x = p0; w0.y = p1; } else if (j == 1) { w0.z = p0; w0.w = p1; } else if (j == 2) { w1.x = p0; w1.y = p1; } else { w1.z = p0; w1.w = p1; } }
        *(u32x4*)(XB + (size_t)t * D + 16 * lane) = w0; *(u32x4*)(XB + (size_t)t * D + 16 * lane + 8) = w1;
        LDS_WAIT();
    }
}

constexpr int PH_PER_LAYER = 14, N_PHASES = 1 + NLAYER * PH_PER_LAYER;
__global__ void __launch_bounds__(NTHREADS, 2) mega_fwd(Args args) {
    extern __shared__ __attribute__((aligned(16))) unsigned char lds_raw[];
    Frame F; F.lds = (LAS unsigned char*)lds_raw; F.tid = threadIdx.x; F.lane = F.tid & 63; F.wave = __builtin_amdgcn_readfirstlane(F.tid >> 6); F.G = gridDim.x; F.bid = blockIdx.x;
    int wave_s = __builtin_amdgcn_readfirstlane((int)threadIdx.x >> 6); asm volatile("" : "+s"(wave_s));
#define FRESH() do { int t_ = wave_s * 64 + (int)__builtin_amdgcn_mbcnt_hi(~0u, __builtin_amdgcn_mbcnt_lo(~0u, 0u)); asm volatile("" : "+v"(t_)); F.tid = t_; F.lane = t_ & 63; F.wave = __builtin_amdgcn_readfirstlane(t_ >> 6); ws = args.ws; asm volatile("" : "+s"(ws)); } while (0)
    unsigned char* ws = args.ws;
    volatile LAS unsigned* MISC = (volatile LAS unsigned*)(F.lds + MISC_OFF);
    for (int u = F.tid; u < (LDS_BYTES - MISC_OFF) / 4; u += NTHREADS) MISC[u] = 0u;
    __syncthreads();
    unsigned* ctl = (unsigned*)(args.ws + WS_CTL);
    XcdBarrier bar; bar.bar = ctl + CW_BAR; bar.x = 0; bar.st = nullptr;
    if (!MK_PER_PHASE) bar = xcd_barrier_post(ctl + CW_BAR, MISC + 8);
    const int lo = args.ph_lo, hi = args.ph_hi;
#define IN(k) (lo <= (k) && (k) < hi)
#define SEAM(k) do { if (IN(k) && IN((k) + 1)) { XcdBarrier b_ = bar; asm volatile("" : "+s"(b_.bar), "+s"(b_.x)); xcd_barrier(b_); } } while (0)
#define XB ((bf16_t*)(ws + WS_XB))
#define BIG ((bf16_t*)(ws + WS_BIG))
#define OB ((bf16_t*)(ws + WS_OB))
#define SP ((bf16_t*)(ws + WS_SP))
#define X ((float*)(ws + WS_X))
#define FB ((float*)(ws + WS_F))
#define MK ((bf16_t*)(ws + WS_MK))
#define MVT ((bf16_t*)(ws + WS_MVT))
#define EID ((int*)(ws + WS_EID))
#define GW ((float*)(ws + WS_GW))
#define X8 (ws + WS_X8)
    float* out = args.out;
    const float* ln_g = args.in[21]; const float* ln_b = args.in[22];

    if (IN(0)) { FRESH(); p0_prologue(F, args); }
    SEAM(0);

#pragma unroll 1
    for (int layer = 0; layer < NLAYER; ++layer) {
        const int pb = 1 + layer * PH_PER_LAYER, jj = layer >> 1;
        const bool first = (layer == 0);
        if ((layer & 1) == 0) {
            if (IN(pb + 0)) { FRESH();
                if (first) {
                    pg8::Gemm g{(const bf16_t*)(ws + WS_MEMB), (const bf16_t*)(ws + WS_WMKV), 1024, 1024, 1024}; pg8::MemKVSched S{F.bid, 192};
                    pg8::EpiMemKV E{out + O_MKP, out + O_MVP, MK, MVT};
                    pg8::gemm_phase<pg8::EpiMemKV, pg8::MemKVSched, true>(F.lds, F.tid, g, S, E);
                }
                pg8::Gemm g{XB, (const bf16_t*)(ws + WS_WQKV) + (size_t)jj * QKVW * D, 1024, 1024, 1024}; pg8::PlainSched S; S.init(T, QKVW, 1024, 1024, F.G, F.bid);
                pg8::EpiBf16 E{BIG, QKVW};
                pg8::gemm_phase<pg8::EpiBf16, pg8::PlainSched, true>(F.lds, F.tid, g, S, E);
            }
            SEAM(pb + 0);
            if (IN(pb + 1)) { FRESH();
                const float* sinks = args.in[9] + jj * 16;
                for (int u = F.bid; u < 512; u += F.G) attn_prompt_unit(F, BIG, OB, sinks, out + O_WKP + (size_t)jj * 65536, out + O_WVP + (size_t)jj * 65536, u);
                for (int u = F.bid; u < 512; u += F.G) attn_sample_unit(F, BIG, OB, sinks, args.in[2] + (size_t)jj * 4194304, args.in[3] + (size_t)jj * 4194304,
                                                                        out + O_WKS + (size_t)jj * 4194304, out + O_WVS + (size_t)jj * 4194304, u);
            }
            SEAM(pb + 1);
            if (IN(pb + 2)) { FRESH();
                pg8::Gemm g{OB, (const bf16_t*)(ws + WS_WO) + (size_t)jj * D * D, 1024, 1024, 1024}; pg8::PlainSched S; S.init(T, D, 1024, 1024, F.G, F.bid);
                pg8::EpiF32 E{FB, D};
                pg8::gemm_phase<pg8::EpiF32, pg8::PlainSched, true>(F.lds, F.tid, g, S, E);
            }
            SEAM(pb + 2);
        } else {
            if (IN(pb + 0)) { FRESH();
                pg8::Gemm g{XB, (const bf16_t*)(ws + WS_WIN) + (size_t)jj * 3072 * D, 1024, 1024, 1024}; pg8::PlainSched S; S.init(T, 3072, 1024, 1024, F.G, F.bid);
                pg8::EpiBf16 E{BIG, 3072};
                pg8::gemm_phase<pg8::EpiBf16, pg8::PlainSched, true>(F.lds, F.tid, g, S, E);
            }
            SEAM(pb + 0);
            if (IN(pb + 1)) FRESH(); if (IN(pb + 1)) conv_phase(F, BIG, OB, args.in[12] + (size_t)jj * 3 * D, args.in[4] + (size_t)jj * DBATCH * 2 * D, out + O_CVP + (size_t)jj * 4096, out + O_CVS + (size_t)jj * DBATCH * 2 * D);
            SEAM(pb + 1);
            if (IN(pb + 2)) { FRESH();
                pg8::Gemm g{OB, (const bf16_t*)(ws + WS_WOUT) + (size_t)jj * D * D, 1024, 1024, 1024}; pg8::PlainSched S; S.init(T, D, 1024, 1024, F.G, F.bid);
                pg8::EpiF32 E{FB, D};
                pg8::gemm_phase<pg8::EpiF32, pg8::PlainSched, true>(F.lds, F.tid, g, S, E);
            }
            SEAM(pb + 2);
        }
        if (IN(pb + 3)) FRESH(); if (IN(pb + 3)) ln_phase(F, first ? args.in[0] : X, first ? args.in[1] : X + (size_t)TP * D, FB, ln_g + (size_t)(layer * 3 + 0) * D, ln_b + (size_t)(layer * 3 + 0) * D, X, XB, nullptr);
        SEAM(pb + 3);
        if (IN(pb + 4)) { FRESH();
            pg8::Gemm g{XB, (const bf16_t*)(ws + WS_WMQ) + (size_t)layer * D * D, 1024, 1024, 1024}; pg8::PlainSched S; S.init(T, D, 1024, 1024, F.G, F.bid);
            pg8::EpiBf16 E{BIG, D};
            pg8::gemm_phase<pg8::EpiBf16, pg8::PlainSched, true>(F.lds, F.tid, g, S, E);
        }
        SEAM(pb + 4);
        if (IN(pb + 5)) { FRESH();
            {
                pg8::Gemm g{BIG, MK, 1024, 1024, 256}; pg8::MemSSched S{F.bid, layer};
                pg8::EpiSoftmax E{SP, D, 0.0625f * LOG2E};
                pg8::gemm_phase<pg8::EpiSoftmax, pg8::MemSSched, true>(F.lds, F.tid, g, S, E);
            }
            WG_BAR();
            for (int u = F.bid; u < 512; u += F.G) mem_sample_unit(F, BIG, OB, args.in[5] + (size_t)layer * 33554432, args.in[6] + (size_t)layer * 33554432, u);
        }
        SEAM(pb + 5);
        if (IN(pb + 6)) { FRESH();
            pg8::Gemm g{SP, MVT, 1024, 512, 256}; pg8::MemPVSched S{F.bid, layer};
            pg8::EpiBf16 E{OB, D};
            pg8::gemm_phase<pg8::EpiBf16, pg8::MemPVSched, true>(F.lds, F.tid, g, S, E);
        }
        SEAM(pb + 6);
        if (IN(pb + 7)) { FRESH();
            pg8::Gemm g{OB, (const bf16_t*)(ws + WS_WMO) + (size_t)layer * D * D, 1024, 1024, 1024}; pg8::PlainSched S; S.init(T, D, 1024, 1024, F.G, F.bid);
            pg8::EpiF32 E{FB, D};
            pg8::gemm_phase<pg8::EpiF32, pg8::PlainSched, true>(F.lds, F.tid, g, S, E);
        }
        SEAM(pb + 7);
        if (IN(pb + 8)) FRESH(); if (IN(pb + 8)) ln_phase(F, X, X + (size_t)TP * D, FB, ln_g + (size_t)(layer * 3 + 1) * D, ln_b + (size_t)(layer * 3 + 1) * D, X, XB, X8);
        SEAM(pb + 8);
        if (IN(pb + 9)) { FRESH();
            pg8::Gemm g{XB, (const bf16_t*)(ws + WS_WPQ) + (size_t)layer * 2048 * D, 1024, 1024, 1024}; pg8::PlainSched S; S.init(T, 2048, 1024, 1024, F.G, F.bid);
            pg8::EpiBf16 E{BIG, 2048};
            pg8::gemm_phase<pg8::EpiBf16, pg8::PlainSched, true>(F.lds, F.tid, g, S, E);
        }
        SEAM(pb + 9);
        if (IN(pb + 10)) FRESH(); if (IN(pb + 10)) router_phase(F, BIG, (const bf16_t*)(ws + WS_SUBK) + (size_t)layer * 2 * 128 * 128, EID, GW);
        SEAM(pb + 10);
        if (IN(pb + 11)) FRESH(); if (IN(pb + 11)) expert_phase(F, ws + WS_PU8 + (size_t)layer * NEXP * D, ws + WS_PV8 + (size_t)layer * NEXP * D, X8, EID, GW, X, (layer == NLAYER - 1) ? out : X, XB,
                                      ln_g + (size_t)(layer * 3 + 2) * D, ln_b + (size_t)(layer * 3 + 2) * D);
        SEAM(pb + 11);
    }
#undef IN
#undef SEAM
#undef XB
#undef BIG
#undef OB
#undef SP
#undef X
#undef FB
#undef MK
#undef MVT
#undef EID
#undef GW
#undef X8
}


#if MK_DEBUG
__device__ __forceinline__ void dbg_fail(unsigned* ew, unsigned code) { atomicMax(ew, 100u - code); }
__device__ __forceinline__ bool dbg_close(float got, float ref, float rtol, float atol) { return (got == got) && fabsf(got - ref) <= atol + rtol * fabsf(ref); }
__device__ __forceinline__ unsigned dbg_hash(unsigned x) { x ^= x >> 16; x *= 0x7feb352du; x ^= x >> 15; x *= 0x846ca68bu; x ^= x >> 16; return x; }
__device__ __forceinline__ float dbg_fp8(const unsigned char* p, size_t i) { const unsigned w = (unsigned)p[i]; return __builtin_amdgcn_cvt_f32_fp8((int)w, 0); }

__global__ void chk_gemm(const bf16_t* A, int lda, const bf16_t* Bt, int ldb, int K, int M, int N, const void* outp, int ldc, int f32out, unsigned* ew, unsigned code) {
    const unsigned id = blockIdx.x * 256 + threadIdx.x; const unsigned h1 = dbg_hash(id * 2u + 1u), h2 = dbg_hash(id * 2u + 7777u);
    int r = (int)(h1 % (unsigned)M), c = (int)(h2 % (unsigned)N);
    if ((id & 7) == 0) r = M - 1 - (int)(h1 % 300u) % M; if ((id & 7) == 1) r = (int)(h1 % 5u); if ((id & 15) == 2) c = N - 1 - (int)(h2 % 9u);
    float s = 0.f; for (int k = 0; k < K; ++k) s += bf2f(A[(size_t)r * lda + k]) * bf2f(Bt[(size_t)c * ldb + k]);
    const float got = f32out ? ((const float*)outp)[(size_t)r * ldc + c] : bf2f(((const bf16_t*)outp)[(size_t)r * ldc + c]);
    if (!dbg_close(got, s, 0.02f, 0.03f)) dbg_fail(ew, code);
}
__global__ void chk_transposed(const float* W, int N, const bf16_t* WT, unsigned* ew, unsigned code) {
    const unsigned id = blockIdx.x * 256 + threadIdx.x; const int k = (int)(dbg_hash(id) % 1024u), n = (int)(dbg_hash(id + 99991u) % (unsigned)N);
    if (!dbg_close(bf2f(WT[(size_t)n * 1024 + k]), W[(size_t)k * N + n], 0.01f, 1e-6f)) dbg_fail(ew, code);
}
__global__ void chk_fp8(const float* src, const unsigned char* dst, size_t n, float sc, unsigned* ew, unsigned code) {
    const unsigned id = blockIdx.x * 256 + threadIdx.x; const size_t i = ((size_t)dbg_hash(id) * 16777u + dbg_hash(id + 5u)) % n;
    if (!dbg_close(dbg_fp8(dst, i), src[i] * sc, 0.07f, 0.003f)) dbg_fail(ew, code);
}
__global__ void chk_attn_prompt(const bf16_t* BIG, const bf16_t* OB, const float* sinks, unsigned* ew, unsigned code) {
    const unsigned id = blockIdx.x * 256 + threadIdx.x, h1 = dbg_hash(id + 31u);
    const int b = id & 1, head = (id >> 1) & 15, d = (int)(h1 % 64u); int pos = (int)(dbg_hash(id + 77u) % 8192u);
    { const int q = (id >> 7) & 7; const int spv = q == 0 ? 0 : q == 1 ? 1 : q == 2 ? 127 : q == 3 ? 128 : q == 4 ? 129 : q == 5 ? 8191 : q == 6 ? 8064 : 255; if ((id >> 5) % 3 == 0) pos = spv; }
    const int kvh = head >> 2; const bf16_t* q = BIG + (size_t)(b * SEQ + pos) * QKVW + head * 64;
    const int k0 = pos - 128 < 0 ? 0 : pos - 128; float m = sinks[head];
    for (int kp = k0; kp <= pos; ++kp) { const bf16_t* kr = BIG + (size_t)(b * SEQ + kp) * QKVW + 1024 + kvh * 64; float s = 0.f; for (int e = 0; e < 64; ++e) s += bf2f(q[e]) * bf2f(kr[e]); s *= 0.125f; m = fmaxf(m, s); }
    float den = expf(sinks[head] - m), o = 0.f;
    for (int kp = k0; kp <= pos; ++kp) { const bf16_t* kr = BIG + (size_t)(b * SEQ + kp) * QKVW + 1024 + kvh * 64; float s = 0.f; for (int e = 0; e < 64; ++e) s += bf2f(q[e]) * bf2f(kr[e]); s *= 0.125f;
        const float p = expf(s - m); den += p; o += p * bf2f(kr[256 + d]); }
    if (!dbg_close(bf2f(OB[(size_t)(b * SEQ + pos) * D + head * 64 + d]), o / den, 0.03f, 0.01f)) dbg_fail(ew, code);
}
__global__ void chk_attn_sample(const bf16_t* BIG, const bf16_t* OB, const float* sinks, const float* cwk, const float* cwv, const float* wks, const float* wvs, unsigned* ew, unsigned code) {
    const unsigned id = blockIdx.x * 256 + threadIdx.x, h1 = dbg_hash(id + 31u);
    const int b = (int)(h1 % 128u), l = id & 3, head = (id >> 2) & 15, d = (int)((h1 >> 8) % 64u), kvh = head >> 2;
    const bf16_t* q = BIG + (size_t)(TP + b * 4 + l) * QKVW + head * 64;
    float m = sinks[head];
    for (int pass = 0; pass < 2; ++pass) { float den = expf(sinks[head] - m), o = 0.f;
        for (int key = 0; key < 132; ++key) { const bool ok = key < 128 ? key >= l : (key - 128) <= l; if (!ok) continue; float s = 0.f;
            for (int e = 0; e < 64; ++e) { const float kd = key < 128 ? cwk[(((size_t)b * 128 + key) * 4 + kvh) * 64 + e] : bf2f(BIG[(size_t)(TP + b * 4 + key - 128) * QKVW + 1024 + kvh * 64 + e]); s += bf2f(q[e]) * kd; }
            s *= 0.125f; if (pass == 0) m = fmaxf(m, s); else { const float p = expf(s - m); den += p;
                o += p * (key < 128 ? cwv[(((size_t)b * 128 + key) * 4 + kvh) * 64 + d] : bf2f(BIG[(size_t)(TP + b * 4 + key - 128) * QKVW + 1280 + kvh * 64 + d])); } }
        if (pass == 1 && !dbg_close(bf2f(OB[(size_t)(TP + b * 4 + l) * D + head * 64 + d]), o / den, 0.03f, 0.01f)) dbg_fail(ew, code); }
    const int i = (int)((h1 >> 16) % 128u); const size_t oo = (((size_t)b * 128 + i) * 4 + kvh) * 64 + d;
    const float rk = i < 124 ? cwk[(((size_t)b * 128 + i + 4) * 4 + kvh) * 64 + d] : bf2f(BIG[(size_t)(TP + b * 4 + i - 124) * QKVW + 1024 + kvh * 64 + d]);
    const float rv = i < 124 ? cwv[(((size_t)b * 128 + i + 4) * 4 + kvh) * 64 + d] : bf2f(BIG[(size_t)(TP + b * 4 + i - 124) * QKVW + 1280 + kvh * 64 + d]);
    if (!dbg_close(wks[oo], rk, 1e-3f, 1e-5f) || !dbg_close(wvs[oo], rv, 1e-3f, 1e-5f)) dbg_fail(ew, code + 0u);
}
__global__ void chk_winp(const bf16_t* BIG, const float* wkp, const float* wvp, unsigned* ew, unsigned code) {
    const unsigned id = blockIdx.x * 256 + threadIdx.x, h1 = dbg_hash(id + 3u); const int b = id & 1, i = (int)(h1 % 128u), c = (int)((h1 >> 8) % 256u);
    const float rk = bf2f(BIG[(size_t)(b * SEQ + SEQ - 128 + i) * QKVW + 1024 + c]), rv = bf2f(BIG[(size_t)(b * SEQ + SEQ - 128 + i) * QKVW + 1280 + c]);
    if (!dbg_close(wkp[((size_t)b * 128 + i) * 256 + c], rk, 1e-3f, 1e-5f) || !dbg_close(wvp[((size_t)b * 128 + i) * 256 + c], rv, 1e-3f, 1e-5f)) dbg_fail(ew, code);
}
__global__ void chk_conv(const bf16_t* BIG, const bf16_t* OB, const float* cw, const float* state, const float* cvp, const float* cvs, unsigned* ew, unsigned code) {
    const unsigned id = blockIdx.x * 256 + threadIdx.x, h1 = dbg_hash(id + 3u); int r = (int)(h1 % (unsigned)T); const int c = (int)((h1 >> 12) % 1024u);
    { const int q = (id >> 2) & 7; const int spv = q == 0 ? 0 : q == 1 ? 1 : q == 2 ? 2 : q == 3 ? 8191 : q == 4 ? 8192 : q == 5 ? 8193 : q == 6 ? TP : T - 1; if ((id & 3) == 0) r = spv; } if ((id & 3) == 1) r = TP + (int)(h1 % 512u);
    auto U = [&](int row) { return bf2f(BIG[(size_t)row * 3072 + 1024 + c]) * bf2f(BIG[(size_t)row * 3072 + 2048 + c]); };
    float um1, um2; const float u0 = U(r);
    if (r < TP) { const int t = r % SEQ; um1 = t >= 1 ? U(r - 1) : 0.f; um2 = t >= 2 ? U(r - 2) : 0.f;
        if (t >= SEQ - 2 && !dbg_close(cvp[((size_t)(r / SEQ) * 2 + (t - (SEQ - 2))) * D + c], u0, 1e-3f, 1e-5f)) dbg_fail(ew, code); }
    else { const int rr = r - TP, b = rr >> 2, l = rr & 3; const float s0 = state[((size_t)b * 2 + 0) * D + c], s1 = state[((size_t)b * 2 + 1) * D + c];
        um1 = l >= 1 ? U(r - 1) : s1; um2 = l >= 2 ? U(r - 2) : (l == 1 ? s1 : s0);
        if (l >= 2 && !dbg_close(cvs[((size_t)b * 2 + (l - 2)) * D + c], u0, 1e-3f, 1e-5f)) dbg_fail(ew, code); }
    const float z = cw[c] * um2 + cw[D + c] * um1 + cw[2 * D + c] * u0, y = bf2f(BIG[(size_t)r * 3072 + c]) * z;
    if (!dbg_close(bf2f(OB[(size_t)r * D + c]), y, 0.01f, 0.01f)) dbg_fail(ew, code);
}
__global__ void chk_ln(const float* xa, const float* xb, const float* Fb, const float* gam, const float* bet, const float* Xo, const bf16_t* XBo, unsigned* ew, unsigned code) {
    __shared__ float red[256]; const int tid = threadIdx.x; const unsigned h1 = dbg_hash(blockIdx.x + 17u);
    int r = (int)(h1 % (unsigned)T); if (blockIdx.x == 0) r = 0; if (blockIdx.x == 1) r = T - 1; if (blockIdx.x == 2) r = TP;
    const float* xr = r < TP ? xa + (size_t)r * D : xb + (size_t)(r - TP) * D; float v[4], s = 0.f;
    for (int j = 0; j < 4; ++j) { v[j] = DN_ALPHA * xr[tid + 256 * j] + Fb[(size_t)r * D + tid + 256 * j]; s += v[j]; }
    red[tid] = s; __syncthreads(); for (int o = 128; o > 0; o >>= 1) { if (tid < o) red[tid] += red[tid + o]; __syncthreads(); } const float mean = red[0] / D; __syncthreads();
    s = 0.f; for (int j = 0; j < 4; ++j) s += (v[j] - mean) * (v[j] - mean);
    red[tid] = s; __syncthreads(); for (int o = 128; o > 0; o >>= 1) { if (tid < o) red[tid] += red[tid + o]; __syncthreads(); } const float rstd = 1.f / sqrtf(red[0] / D + LN_EPS);
    for (int j = 0; j < 4; ++j) { const int c = tid + 256 * j; const float y = (v[j] - mean) * rstd * gam[c] + bet[c];
        if (!dbg_close(Xo[(size_t)r * D + c], y, 1e-3f, 1e-3f) || !dbg_close(bf2f(XBo[(size_t)r * D + c]), y, 0.01f, 0.01f)) dbg_fail(ew, code); }
}
__global__ void chk_mem_prompt(const bf16_t* QM, const bf16_t* MKl, const bf16_t* MVTl, const bf16_t* OB, unsigned* ew, unsigned code) {
    const unsigned id = blockIdx.x * 256 + threadIdx.x, h1 = dbg_hash(id + 3u); const int b = id & 1, h = (id >> 1) & 3, d = (int)(h1 % 256u); int pos = (int)((h1 >> 8) % 8192u);
    if ((id & 31) == 0) pos = 8191; if ((id & 31) == 8) pos = 0;
    const bf16_t* q = QM + (size_t)(b * SEQ + pos) * D + h * 256; float m = -1e30f;
    for (int pass = 0; pass < 2; ++pass) { float den = 0.f, o = 0.f;
        for (int mm = 0; mm < 256; ++mm) { const bf16_t* kr = MKl + (size_t)(b * 256 + mm) * 1024 + h * 256; float s = 0.f; for (int e = 0; e < 256; ++e) s += bf2f(q[e]) * bf2f(kr[e]); s *= 0.0625f;
            if (pass == 0) m = fmaxf(m, s); else { const float p = expf(s - m); den += p; o += p * bf2f(MVTl[(size_t)(h * 256 + d) * 512 + b * 256 + mm]); } }
        if (pass == 1 && !dbg_close(bf2f(OB[(size_t)(b * SEQ + pos) * D + h * 256 + d]), o / den, 0.03f, 0.005f)) dbg_fail(ew, code); }
}
__global__ void chk_mem_sample(const bf16_t* QM, const float* ck, const float* cv, const bf16_t* OB, unsigned* ew, unsigned code) {
    const unsigned id = blockIdx.x * 256 + threadIdx.x, h1 = dbg_hash(id + 3u); const int b = (int)(h1 % 128u), l = id & 3, h = (id >> 2) & 3, d = (int)((h1 >> 8) % 256u);
    const bf16_t* q = QM + (size_t)(TP + b * 4 + l) * D + h * 256; float m = -1e30f;
    for (int pass = 0; pass < 2; ++pass) { float den = 0.f, o = 0.f;
        for (int mm = 0; mm < 256; ++mm) { const float* kr = ck + (((size_t)b * 256 + mm) * 4 + h) * 256; float s = 0.f; for (int e = 0; e < 256; ++e) s += bf2f(q[e]) * kr[e]; s *= 0.0625f;
            if (pass == 0) m = fmaxf(m, s); else { const float p = expf(s - m); den += p; o += p * cv[(((size_t)b * 256 + mm) * 4 + h) * 256 + d]; } }
        if (pass == 1 && !dbg_close(bf2f(OB[(size_t)(TP + b * 4 + l) * D + h * 256 + d]), o / den, 0.03f, 0.005f)) dbg_fail(ew, code); }
}
__global__ void chk_router(const bf16_t* BIG, const bf16_t* SUBK, const int* EID, const float* GW, unsigned* ew, unsigned code) {
    __shared__ float sc[256]; __shared__ float sv[2][16]; __shared__ int si[2][16]; __shared__ float cs[16]; __shared__ int ce[16]; __shared__ float comb[256];
    const int tid = threadIdx.x; const unsigned h1 = dbg_hash(blockIdx.x + 5u); int tok = (int)(h1 % (unsigned)T); const int head = blockIdx.x & 7;
    if (blockIdx.x < 8) tok = T - 1; else if (blockIdx.x < 16) tok = 0;
    { const int c = tid >> 7, n = tid & 127; float s = 0.f; for (int e = 0; e < 128; ++e) s += bf2f(BIG[(size_t)tok * 2048 + head * 256 + c * 128 + e]) * bf2f(SUBK[(size_t)(c * 128 + n) * 128 + e]); sc[tid] = s; }
    __syncthreads();
    if (tid < 2) { for (int k = 0; k < 16; ++k) { int bi = 0; float bv = -1e30f; for (int n = 0; n < 128; ++n) if (sc[tid * 128 + n] > bv) { bv = sc[tid * 128 + n]; bi = n; } sv[tid][k] = bv; si[tid][k] = bi; sc[tid * 128 + bi] = -2e30f; } }
    __syncthreads();
    comb[tid] = sv[0][tid >> 4] + sv[1][tid & 15];
    __syncthreads();
    if (tid == 0) { float mx = -1e30f; for (int k = 0; k < 16; ++k) { int bi = 0; float bv = -1e30f; for (int n = 0; n < 256; ++n) if (comb[n] > bv) { bv = comb[n]; bi = n; } cs[k] = bv; ce[k] = si[0][bi >> 4] * 128 + si[1][bi & 15]; comb[bi] = -2e30f; mx = fmaxf(mx, bv); }
        float den = 0.f; for (int k = 0; k < 16; ++k) den += expf(cs[k] - cs[0]);
        int nbad = 0;
        for (int k = 0; k < 16; ++k) { const int e = EID[((size_t)tok * 8 + head) * 16 + k]; const float g = GW[((size_t)tok * 8 + head) * 16 + k]; bool found = false;
            for (int j = 0; j < 16; ++j) if (ce[j] == e) { found = true; if (!dbg_close(g, expf(cs[j] - cs[0]) / den, 0.05f, 0.003f)) nbad += 4; }
            if (!found) nbad += 1; }
        if (nbad > 2) dbg_fail(ew, code);
        { int nmiss = 0, ng = 0;
          for (int k = 0; k < 16; ++k) { const int e = EID[((size_t)tok * 8 + head) * 16 + k]; const float g = GW[((size_t)tok * 8 + head) * 16 + k]; bool found = false;
            for (int j = 0; j < 16; ++j) if (ce[j] == e) { found = true; if (!dbg_close(g, expf(cs[j] - cs[0]) / den, 0.05f, 0.003f)) ++ng; }
            if (!found) ++nmiss; }
          unsigned mask = 0; (void)ng; (void)nmiss;
          const float* dp = (const float*)((const unsigned char*)EID - WS_EID + WS_SP) + ((size_t)tok * 8 + head) * 48;
          for (int c2 = 0; c2 < 2; ++c2) for (int i = 0; i < 16; ++i) { const unsigned bits = __builtin_bit_cast(unsigned, dp[16 * c2 + i]); const float val = __builtin_bit_cast(float, bits & ~127u);
              if (!dbg_close(val, sv[c2][i], 1e-3f, 1e-4f)) mask |= 1u; else if ((int)(bits & 127u) != si[c2][i]) mask |= 2u; }
          for (int n = 0; n < 256; ++n) comb[n] = __builtin_bit_cast(float, __builtin_bit_cast(unsigned, dp[n >> 4]) & ~127u) + __builtin_bit_cast(float, __builtin_bit_cast(unsigned, dp[16 + (n & 15)]) & ~127u);
          float den2 = 0.f, c00 = 0.f;
          for (int k = 0; k < 16; ++k) { int bi = 0; float bv = -1e30f; for (int n = 0; n < 256; ++n) if (comb[n] > bv) { bv = comb[n]; bi = n; } comb[bi] = -2e30f;
              const unsigned tb = __builtin_bit_cast(unsigned, dp[32 + k]); const float tv = __builtin_bit_cast(float, tb & ~255u);
              if (!dbg_close(tv, bv, 1e-3f, 1e-4f)) mask |= 4u;
              const int ci = (tb >> 4) & 15, cj = tb & 15; const int want = (int)(__builtin_bit_cast(unsigned, dp[ci]) & 127u) * 128 + (int)(__builtin_bit_cast(unsigned, dp[16 + cj]) & 127u);
              if (EID[((size_t)tok * 8 + head) * 16 + k] != want) mask |= 8u;
              if (k == 0) c00 = tv; den2 += expf(tv - c00); cs[k] = tv; }
          for (int k = 0; k < 16; ++k) if (!dbg_close(GW[((size_t)tok * 8 + head) * 16 + k], expf(cs[k] - c00) / den2, 0.02f, 1e-3f)) mask |= 16u;
          if (mask) atomicOr(ew + 1, mask); } }
}
__global__ void chk_expert(const unsigned char* PU, const unsigned char* PV, const unsigned char* X8p, const int* EID, const float* GW, const float* Xin, const float* Yo, const float* gam, const float* bet, unsigned* ew, unsigned code) {
    __shared__ float aw[128]; __shared__ float red[256]; const int tid = threadIdx.x; const unsigned h1 = dbg_hash(blockIdx.x + 9u);
    int t = (int)(h1 % (unsigned)T); if (blockIdx.x == 0) t = 0; if (blockIdx.x == 1) t = T - 1; if (blockIdx.x == 2) t = TP;
    if (tid < 128) { const int e = EID[(size_t)t * 128 + tid]; float hs = 0.f; for (int k = 0; k < 1024; ++k) hs += dbg_fp8(X8p, (size_t)t * D + k) * dbg_fp8(PU, (size_t)e * D + k);
        hs *= (1.f / U_SCALE); aw[tid] = 0.5f * hs * (1.f + erff(hs * 0.70710678f)) * GW[(size_t)t * 128 + tid]; }
    __syncthreads();
    float v[4], s = 0.f;
    for (int j = 0; j < 4; ++j) { const int c = tid + 256 * j; float f = 0.f; for (int k = 0; k < 128; ++k) f += aw[k] * dbg_fp8(PV, (size_t)EID[(size_t)t * 128 + k] * D + c); f *= (1.f / V_SCALE);
        v[j] = DN_ALPHA * Xin[(size_t)t * D + c] + f; s += v[j]; }
    red[tid] = s; __syncthreads(); for (int o = 128; o > 0; o >>= 1) { if (tid < o) red[tid] += red[tid + o]; __syncthreads(); } const float mean = red[0] / D; __syncthreads();
    s = 0.f; for (int j = 0; j < 4; ++j) s += (v[j] - mean) * (v[j] - mean);
    red[tid] = s; __syncthreads(); for (int o = 128; o > 0; o >>= 1) { if (tid < o) red[tid] += red[tid + o]; __syncthreads(); } const float rstd = 1.f / sqrtf(red[0] / D + LN_EPS);
    for (int j = 0; j < 4; ++j) { const int c = tid + 256 * j; const float y = (v[j] - mean) * rstd * gam[c] + bet[c]; if (!dbg_close(Yo[(size_t)t * D + c], y, 2e-3f, 2e-3f)) dbg_fail(ew, code); }
}
__global__ void dbg_final(const unsigned* ew, float* outp) { if (ew[1]) outp[0] = 1000.f * (float)(10u + ew[1]); else if (*ew) outp[0] = 1000.f * (float)(100u - *ew); }
#endif
extern "C" void kernel_launch(void* const* d_in, const int* in_sizes, int n_in, void* d_out, int out_size, void* d_ws, size_t ws_size, hipStream_t stream) {
    static int grid = 0;
    if (grid == 0) {
        if (n_in != 23 || (size_t)out_size != O_END || ws_size < WS_END) { fprintf(stderr, "kernel_launch: unexpected shapes (n_in %d out %d ws %zu); nothing launched\n", n_in, out_size, ws_size); grid = -1; return; }
        int dev = 0, cus = 0, per_cu = 0;
        if (hipGetDevice(&dev) != hipSuccess || hipDeviceGetAttribute(&cus, hipDeviceAttributeMultiprocessorCount, dev) != hipSuccess) { grid = -1; return; }
        if (hipFuncSetAttribute((const void*)mega_fwd, hipFuncAttributeMaxDynamicSharedMemorySize, LDS_BYTES) != hipSuccess) { fprintf(stderr, "kernel_launch: hipFuncSetAttribute failed\n"); grid = -1; return; }
        if (hipOccupancyMaxActiveBlocksPerMultiprocessor(&per_cu, (const void*)mega_fwd, NTHREADS, LDS_BYTES) != hipSuccess || per_cu < 1)
            fprintf(stderr, "kernel_launch: note: occupancy query reports %d workgroups per CU\n", per_cu);
        (void)hipGetLastError();
        grid = cus;
        if (grid != 256) fprintf(stderr, "kernel_launch: %d CUs; the memory-attention phases expect 256\n", grid);
    }
    if (grid < 0) return;
    if (hipMemsetAsync((char*)d_ws + WS_CTL, 0, CTL_ZERO_BYTES, stream) != hipSuccess) return;
    Args a{};
    for (int i = 0; i < 23; ++i) a.in[i] = (const float*)d_in[i];
    a.out = (float*)d_out; a.ws = (unsigned char*)d_ws;
#if MK_PER_PHASE
    for (int p = 0; p < N_PHASES; ++p) { a.ph_lo = p; a.ph_hi = p + 1; hipLaunchKernelGGL(mega_fwd, dim3(grid), dim3(NTHREADS), LDS_BYTES, stream, a);
#if MK_DEBUG
        unsigned char* ws = (unsigned char*)d_ws; float* out = (float*)d_out; unsigned* ew = (unsigned*)(ws + WS_CTL) + 16384;
        bf16_t* XBp = (bf16_t*)(ws + WS_XB); bf16_t* BIGp = (bf16_t*)(ws + WS_BIG); bf16_t* OBp = (bf16_t*)(ws + WS_OB); float* Xp = (float*)(ws + WS_X); float* FBp = (float*)(ws + WS_F);
#define CK(kern, ...) hipLaunchKernelGGL(kern, dim3(4), dim3(256), 0, stream, __VA_ARGS__)
        if (p == 0) {
            CK(chk_transposed, a.in[8] + (size_t)1 * 1024 * 1536, 1536, (const bf16_t*)(ws + WS_WQKV) + (size_t)1 * 1536 * 1024, ew, 60u);
            CK(chk_transposed, a.in[17] + (size_t)3 * 1024 * 2048, 2048, (const bf16_t*)(ws + WS_WPQ) + (size_t)3 * 2048 * 1024, ew, 60u);
            CK(chk_transposed, a.in[11] + (size_t)1 * 1024 * 3072, 3072, (const bf16_t*)(ws + WS_WIN) + (size_t)1 * 3072 * 1024, ew, 60u);
            CK(chk_fp8, a.in[19], ws + WS_PU8, (size_t)NLAYER * NEXP * D, U_SCALE, ew, 61u);
            CK(chk_fp8, a.in[20], ws + WS_PV8, (size_t)NLAYER * NEXP * D, V_SCALE, ew, 62u);
        } else {
            const int L = (p - 1) / PH_PER_LAYER, k = (p - 1) % PH_PER_LAYER, jj = L >> 1; const unsigned code = 10u + (unsigned)(L * 12 + k);
            if ((L & 1) == 0) {
                if (k == 0) { CK(chk_gemm, XBp, 1024, (const bf16_t*)(ws + WS_WQKV) + (size_t)jj * QKVW * D, 1024, 1024, T, QKVW, (const void*)BIGp, QKVW, 0, ew, code);
                    if (L == 0) { const int z = 2; const bf16_t* W = (const bf16_t*)(ws + WS_WMKV) + (size_t)z * 2048 * 1024; const bf16_t* MB = (const bf16_t*)(ws + WS_MEMB);
                        CK(chk_gemm, MB, 1024, W, 1024, 1024, 512, 1024, (const void*)(out + O_MKP + (size_t)z * 512 * 1024), 1024, 1, ew, 63u);
                        CK(chk_gemm, MB, 1024, W + (size_t)1024 * 1024, 1024, 1024, 512, 1024, (const void*)(out + O_MVP + (size_t)z * 512 * 1024), 1024, 1, ew, 64u);
                        CK(chk_gemm, MB, 1024, W, 1024, 1024, 512, 1024, (const void*)((const bf16_t*)(ws + WS_MK) + (size_t)z * 512 * 1024), 1024, 0, ew, 65u);
                        CK(chk_gemm, W + (size_t)1024 * 1024, 1024, MB, 1024, 1024, 1024, 512, (const void*)((const bf16_t*)(ws + WS_MVT) + (size_t)z * 1024 * 512), 512, 0, ew, 66u); } }
                if (k == 1) { CK(chk_attn_prompt, BIGp, OBp, a.in[9] + jj * 16, ew, code);
                    CK(chk_attn_sample, BIGp, OBp, a.in[9] + jj * 16, a.in[2] + (size_t)jj * 4194304, a.in[3] + (size_t)jj * 4194304, out + O_WKS + (size_t)jj * 4194304, out + O_WVS + (size_t)jj * 4194304, ew, code);
                    CK(chk_winp, BIGp, out + O_WKP + (size_t)jj * 65536, out + O_WVP + (size_t)jj * 65536, ew, code); }
                if (k == 2) CK(chk_gemm, OBp, 1024, (const bf16_t*)(ws + WS_WO) + (size_t)jj * D * D, 1024, 1024, T, D, (const void*)FBp, D, 1, ew, code);
            } else {
                if (k == 0) CK(chk_gemm, XBp, 1024, (const bf16_t*)(ws + WS_WIN) + (size_t)jj * 3072 * D, 1024, 1024, T, 3072, (const void*)BIGp, 3072, 0, ew, code);
                if (k == 1) CK(chk_conv, BIGp, OBp, a.in[12] + (size_t)jj * 3 * D, a.in[4] + (size_t)jj * DBATCH * 2 * D, out + O_CVP + (size_t)jj * 4096, out + O_CVS + (size_t)jj * DBATCH * 2 * D, ew, code);
                if (k == 2) CK(chk_gemm, OBp, 1024, (const bf16_t*)(ws + WS_WOUT) + (size_t)jj * D * D, 1024, 1024, T, D, (const void*)FBp, D, 1, ew, code);
            }
            if (k == 3 && L == 0) CK(chk_ln, a.in[0], a.in[1], FBp, a.in[21], a.in[22], Xp, XBp, ew, code);
            if (k == 4) CK(chk_gemm, XBp, 1024, (const bf16_t*)(ws + WS_WMQ) + (size_t)L * D * D, 1024, 1024, T, D, (const void*)BIGp, D, 0, ew, code);
            if (k == 5) CK(chk_mem_sample, BIGp, a.in[5] + (size_t)L * 33554432, a.in[6] + (size_t)L * 33554432, OBp, ew, code);
            if (k == 6) CK(chk_mem_prompt, BIGp, (const bf16_t*)(ws + WS_MK) + (size_t)L * 512 * 1024, (const bf16_t*)(ws + WS_MVT) + (size_t)L * 1024 * 512, OBp, ew, code);
            if (k == 7) CK(chk_gemm, OBp, 1024, (const bf16_t*)(ws + WS_WMO) + (size_t)L * D * D, 1024, 1024, T, D, (const void*)FBp, D, 1, ew, code);
            if (k == 9) CK(chk_gemm, XBp, 1024, (const bf16_t*)(ws + WS_WPQ) + (size_t)L * 2048 * D, 1024, 1024, T, 2048, (const void*)BIGp, 2048, 0, ew, code);
            if (k == 10) hipLaunchKernelGGL(chk_router, dim3(96), dim3(256), 0, stream, BIGp, (const bf16_t*)(ws + WS_SUBK) + (size_t)L * 2 * 128 * 128, (const int*)(ws + WS_EID), (const float*)(ws + WS_GW), ew, code);
            if (k == 11 && L == NLAYER - 1) hipLaunchKernelGGL(chk_expert, dim3(24), dim3(256), 0, stream, ws + WS_PU8 + (size_t)L * NEXP * D, ws + WS_PV8 + (size_t)L * NEXP * D, ws + WS_X8, (const int*)(ws + WS_EID), (const float*)(ws + WS_GW),
                                                           Xp, out, a.in[21] + (size_t)(L * 3 + 2) * D, a.in[22] + (size_t)(L * 3 + 2) * D, ew, code);
        }
        if (p == N_PHASES - 1) hipLaunchKernelGGL(dbg_final, dim3(1), dim3(1), 0, stream, ew, out);
#undef CK
#endif
    }
#else
    a.ph_lo = 0; a.ph_hi = N_PHASES;
    hipLaunchKernelGGL(mega_fwd, dim3(grid), dim3(NTHREADS), LDS_BYTES, stream, a);
#endif
    const hipError_t le = hipPeekAtLastError();
    if (le != hipSuccess) fprintf(stderr, "kernel_launch: launch failed: %s\n", hipGetErrorName(le));
}
```

```cpp
#include <hip/hip_runtime.h>
#include <cstdio>
#include <cstdint>

#ifndef MK_DUP
#define MK_DUP 0
#endif
#ifndef MK_STAMP
#define MK_STAMP 0
#endif
#ifndef MK_SEL_A
#define MK_SEL_A 12
#define MK_SEL_B 0
#endif
#ifndef MK_DEBUG
#define MK_DEBUG 0
#endif
#if MK_DEBUG
#define MK_PER_PHASE 1
#endif
#ifndef MK_PER_PHASE
#define MK_PER_PHASE 0
#endif

#define LAS __attribute__((address_space(3)))
#define GAS __attribute__((address_space(1)))
typedef unsigned short bf16_t;
typedef short bf16x8 __attribute__((ext_vector_type(8)));
typedef float f32x4 __attribute__((ext_vector_type(4)));
typedef float f32x2 __attribute__((ext_vector_type(2)));
typedef float f32x16 __attribute__((ext_vector_type(16)));
typedef unsigned u32x4 __attribute__((ext_vector_type(4)));
typedef unsigned u32x2 __attribute__((ext_vector_type(2)));

constexpr int D = 1024, SEQ = 8192, NBATCH = 2, TP = NBATCH * SEQ, DBATCH = 128, DSEQ = 4, TS = DBATCH * DSEQ, T = TP + TS;
constexpr int QKVW = 1536, NEXP = 16384, NLAYER = 4;
constexpr float DN_ALPHA = 1.6817928305074292f;
constexpr float LN_EPS = 1e-5f;
constexpr float LOG2E = 1.4426950408889634f;
constexpr float U_SCALE = 64.f, V_SCALE = 16.f;

constexpr size_t O_YP = 0, O_YS = 16777216, O_WKP = O_YS + 524288, O_WVP = O_WKP + 131072, O_CVP = O_WVP + 131072, O_MKP = O_CVP + 8192,
                 O_MVP = O_MKP + 2097152, O_WKS = O_MVP + 2097152, O_WVS = O_WKS + 8388608, O_CVS = O_WVS + 8388608, O_END = O_CVS + 524288;

constexpr size_t MiB = 1u << 20;
constexpr size_t WS_CTL = 0, CTL_ZERO_BYTES = 1 * MiB;
constexpr size_t WS_WQKV = 2 * MiB, WS_WO = 8 * MiB, WS_WIN = 12 * MiB, WS_WOUT = 24 * MiB, WS_WMQ = 28 * MiB, WS_WMKV = 36 * MiB, WS_WMO = 52 * MiB, WS_WPQ = 60 * MiB;
constexpr size_t WS_SUBK = 76 * MiB, WS_MEMB = 77 * MiB, WS_MK = 78 * MiB, WS_MVT = 82 * MiB, WS_PU8 = 86 * MiB, WS_PV8 = 150 * MiB;
constexpr size_t WS_X = 214 * MiB, WS_XB = 280 * MiB, WS_BIG = 313 * MiB, WS_OB = 412 * MiB, WS_F = 445 * MiB, WS_SP = 511 * MiB;
constexpr size_t WS_EID = 543 * MiB, WS_GW = 552 * MiB, WS_AW = 561 * MiB, WS_X8 = 570 * MiB, WS_EIDS = 587 * MiB, WS_GWS = 596 * MiB, WS_OFFS = 605 * MiB, WS_END = 607 * MiB;
constexpr int CW_BAR = 4096;

constexpr int LDS_SCRATCH = 153600;
constexpr int MISC_OFF = LDS_SCRATCH;
constexpr int LDS_BYTES = 155648;

__device__ __forceinline__ unsigned f2bf(float f) { unsigned u = __builtin_bit_cast(unsigned, f); return (u + 0x7fffu + ((u >> 16) & 1u)) >> 16; }
__device__ __forceinline__ unsigned pk2(float lo, float hi) { return f2bf(lo) | (f2bf(hi) << 16); }
__device__ __forceinline__ float bf2f(unsigned b) { return __builtin_bit_cast(float, b << 16); }
__device__ __forceinline__ float bflo(unsigned w) { return __builtin_bit_cast(float, w << 16); }
__device__ __forceinline__ float bfhi(unsigned w) { return __builtin_bit_cast(float, w & 0xffff0000u); }
__device__ __forceinline__ unsigned cvt_pk_bf16(float lo, float hi) { unsigned r; asm volatile("v_cvt_pk_bf16_f32 %0, %1, %2" : "=v"(r) : "v"(lo), "v"(hi)); return r; }
__device__ __forceinline__ float wave_sum(float v) {
#pragma unroll
    for (int o = 1; o < 64; o <<= 1) v += __shfl_xor(v, o);
    return v;
}
__device__ __forceinline__ float wave_max(float v) {
#pragma unroll
    for (int o = 1; o < 64; o <<= 1) v = fmaxf(v, __shfl_xor(v, o));
    return v;
}
#define LDS_WAIT() asm volatile("s_waitcnt lgkmcnt(0)" ::: "memory")
#define VM_WAIT() asm volatile("s_waitcnt vmcnt(0)" ::: "memory")
__device__ __forceinline__ void st_wt16(void* p, u32x4 v) { asm volatile("global_store_dwordx4 %0, %1, off sc1\n\ts_nop 1" :: "v"(p), "v"(v) : "memory"); }
__device__ __forceinline__ void st_wt16f(void* p, f32x4 v) { asm volatile("global_store_dwordx4 %0, %1, off sc1\n\ts_nop 1" :: "v"(p), "v"(v) : "memory"); }
__device__ __forceinline__ void st_wt8(void* p, u32x2 v) { asm volatile("global_store_dwordx2 %0, %1, off sc1\n\ts_nop 1" :: "v"(p), "v"(v) : "memory"); }
#define WG_BAR() do { asm volatile("s_waitcnt vmcnt(0) lgkmcnt(0)" ::: "memory"); __builtin_amdgcn_s_barrier(); asm volatile("" ::: "memory"); } while (0)

#define XB_TMO      128
#define XB_XCNT(j)  (256  + 64 * (j))
#define XB_XSUB(j)  (1280 + 64 * (j))
#define XB_XGEN(j)  (2304 + 64 * (j))
#define XB_TOP      3328
#define XB_TOPGEN   3392
#define XCD_BAR_WORDS 3456
#define XB_SPIN_CAP (1u << 21)

__device__ __forceinline__ unsigned xb_ld(unsigned* p)              { return __hip_atomic_load(p, __ATOMIC_RELAXED, __HIP_MEMORY_SCOPE_AGENT); }
__device__ __forceinline__ unsigned xb_add(unsigned* p, unsigned v) { return __hip_atomic_fetch_add(p, v, __ATOMIC_RELAXED, __HIP_MEMORY_SCOPE_AGENT); }
__device__ __forceinline__ unsigned xb_xcc_id() { return (unsigned)__builtin_amdgcn_s_getreg((3 << 11) | 20) & 0xFu; }
#define XB_SPIN(cond, bar) do { unsigned _sp = 0; while (cond) { __builtin_amdgcn_s_sleep(1); \
    if ((++_sp & 255u) == 0u) { if (xb_ld(&(bar)[XB_TMO])) break; if (_sp > XB_SPIN_CAP) { atomicAdd(&(bar)[XB_TMO], 1u); break; } } } } while (0)

struct XcdBarrier { unsigned* bar; unsigned x; volatile LAS unsigned* st; };

__device__ __forceinline__ XcdBarrier xcd_barrier_post(unsigned* bar, volatile LAS unsigned* st) {
    XcdBarrier b; b.bar = bar; b.x = xb_xcc_id(); b.st = st;
    if (threadIdx.x == 0) (void)xb_add(&bar[XB_XCNT(b.x)], 1u);
    return b;
}
__device__ __forceinline__ void xcd_barrier_complete(unsigned* bar, unsigned x, unsigned& nloc, unsigned& nx) {
    const unsigned G = gridDim.x * gridDim.y * gridDim.z;
    unsigned sum, cnt, mine, sp = 0u;
    for (;;) {
        sum = 0u; cnt = 0u; mine = 0u;
#pragma unroll
        for (unsigned j = 0; j < 16; ++j) { const unsigned c = xb_ld(&bar[XB_XCNT(j)]); sum += c; cnt += (c > 0u) ? 1u : 0u; mine = (j == x) ? c : mine; }
        if (sum == G) break;
        __builtin_amdgcn_s_sleep(1);
        if ((++sp & 255u) == 0u) { if (xb_ld(&bar[XB_TMO])) break; if (sp > XB_SPIN_CAP) { atomicAdd(&bar[XB_TMO], 1u); break; } }
    }
    nloc = mine > 0u ? mine : 1u; nx = cnt > 0u ? cnt : 1u;
}
__device__ __forceinline__ void xcd_barrier(const XcdBarrier& b) {
    asm volatile("s_waitcnt vmcnt(0)" ::: "memory");
    __syncthreads();
    if (threadIdx.x == 0) {
        unsigned* bar = b.bar;
        __builtin_amdgcn_s_waitcnt(0);
        unsigned nloc = b.st[0], nx = b.st[1];
        if (nloc == 0u) { xcd_barrier_complete(bar, b.x, nloc, nx); b.st[0] = nloc; b.st[1] = nx; }
        const unsigned old = xb_add(&bar[XB_XSUB(b.x)], 1u);
        const unsigned gen = old / nloc;
        if (old + 1u == (gen + 1u) * nloc) {
            __builtin_amdgcn_fence(__ATOMIC_RELEASE, "agent");
            asm volatile("s_waitcnt vmcnt(0)" ::: "memory");
            const unsigned og = xb_add(&bar[XB_TOP], 1u);
            const unsigned tg = og / nx;
            if (og + 1u == (tg + 1u) * nx) xb_add(&bar[XB_TOPGEN], 1u);
            else XB_SPIN(xb_ld(&bar[XB_TOPGEN]) == tg, bar);
            __builtin_amdgcn_fence(__ATOMIC_ACQUIRE, "agent");
            xb_add(&bar[XB_XGEN(b.x)], 1u);
            asm volatile("s_waitcnt vmcnt(0)" ::: "memory");
        } else {
            XB_SPIN(xb_ld(&bar[XB_XGEN(b.x)]) == gen, bar);
            __builtin_amdgcn_fence(__ATOMIC_ACQUIRE, "agent");
            asm volatile("s_waitcnt vmcnt(0)" ::: "memory");
        }
    }
    __syncthreads();
}

namespace pg8 {
constexpr int BM = 256, BK = 64, HALF = 128, HTB = HALF * BK * 2, STAGE_BYTES = 8 * HTB, NXCD = 8, WGM = 8;
__host__ __device__ __forceinline__ int lds_byte(int r, int c) { const int st = (r >> 4) * 2 + (c >> 5), rr = r & 15, cc = c & 31, ob = rr * 64 + cc * 2; return st * 1024 + (ob ^ (((ob >> 9) & 1) << 5)); }
__host__ __device__ __forceinline__ void stage_rc(int b, int& R, int& C) { const int st = b / 1024, sb = b % 1024, swz = sb ^ (((sb >> 9) & 1) << 5); R = (st >> 1) * 16 + swz / 64; C = (st & 1) * 32 + (swz % 64) / 2; }
__host__ __device__ __forceinline__ int perm32(int rho) { const int n = rho >> 4, i = rho & 15; return 8 * (i >> 2) + 4 * n + (i & 3); }

struct Unit { unsigned aoff, boff; int crow, ccol, z; };
struct Gemm { const bf16_t* A; const bf16_t* Bt; int lda, ldb, K; };

template <class Epi, class Sched, bool ALIGN_EPI>
__device__ __forceinline__ void gemm_phase(LAS unsigned char* lds, const int tid, const Gemm g, const Sched& S, const Epi& E) {
    const int wid = __builtin_amdgcn_readfirstlane(tid >> 6), lane = tid & 63, wr = wid >> 2, wc = wid & 3, fr = lane & 15, fq = lane >> 4;
    const int nt = g.K / BK;
    unsigned voffA[2], voffB[2];
#pragma unroll
    for (int i = 0; i < 2; ++i) { int R, C; stage_rc(tid * 16 + i * 8192, R, C); const int Rb = Epi::PERM ? ((R & ~31) + perm32(R & 31)) : R;
        voffA[i] = (unsigned)(R * g.lda + C) * 2u; voffB[i] = (unsigned)(Rb * g.ldb + C) * 2u; }
    const size_t kstep = (size_t)(BK * 2);
    const size_t hstepA = (size_t)HALF * g.lda * 2, hstepB = (size_t)HALF * g.ldb * 2;
    const unsigned ldsw = (unsigned)wid * 1024u;
    const int aoff = lds_byte(wr * 64 + fr, fq * 8), boff = lds_byte(wc * 32 + fr, fq * 8);
#define PG8_SA(b, h) (((b) * 2 + (h)) * HTB)
#define PG8_SB(b, h) ((4 + (b) * 2 + (h)) * HTB)
#define PG8_STAGE(bufoff, gbase, voff) do { _Pragma("unroll") for (int _i = 0; _i < 2; ++_i) \
        __builtin_amdgcn_global_load_lds((const unsigned*)((const char*)(gbase) + (voff)[_i]), (LAS unsigned*)(lds + (bufoff) + ldsw + _i * 8192), 16, 0, 0); } while (0)
#define PG8_LDA(dst, b, h) do { _Pragma("unroll") for (int m = 0; m < 4; ++m) _Pragma("unroll") for (int k = 0; k < 2; ++k) dst[m][k] = *(const LAS bf16x8*)(lds + PG8_SA(b, h) + aoff + m * 2048 + k * 1024); } while (0)
#define PG8_LDB(dst, b, h) do { _Pragma("unroll") for (int n = 0; n < 2; ++n) _Pragma("unroll") for (int k = 0; k < 2; ++k) dst[n][k] = *(const LAS bf16x8*)(lds + PG8_SB(b, h) + boff + n * 2048 + k * 1024); } while (0)
#define PG8_MMA(ai, bj, At, Bt) do { __builtin_amdgcn_s_setprio(1); _Pragma("unroll") for (int m = 0; m < 4; ++m) _Pragma("unroll") for (int n = 0; n < 2; ++n) _Pragma("unroll") for (int k = 0; k < 2; ++k) \
        acc[ai][bj][m][n] = __builtin_amdgcn_mfma_f32_16x16x32_bf16(Bt[n][k], At[m][k], acc[ai][bj][m][n], 0, 0, 0); __builtin_amdgcn_s_setprio(0); } while (0)
#define PG8_WAIT_V(n) asm volatile("s_waitcnt vmcnt(" #n ")" ::: "memory")
#define PG8_WAIT_L(n) asm volatile("s_waitcnt lgkmcnt(" #n ")" ::: "memory")
#define PG8_BAR __builtin_amdgcn_s_barrier()
#define PG8_SCHED __builtin_amdgcn_sched_barrier(0)
    Unit cur, nxt; int ui = 0;
    if (!S.next(0, cur)) return;
    f32x4 acc[2][2][4][2];
#pragma unroll
    for (int a = 0; a < 2; ++a)
#pragma unroll
        for (int b = 0; b < 2; ++b)
#pragma unroll
            for (int m = 0; m < 4; ++m)
#pragma unroll
                for (int n = 0; n < 2; ++n) acc[a][b][m][n] = (f32x4){0.f, 0.f, 0.f, 0.f};
    bf16x8 At[4][2], B0[2][2], B1[2][2];
    const char* cA = (const char*)g.A + (size_t)cur.aoff * 2; const char* cB = (const char*)g.Bt + (size_t)cur.boff * 2;
    PG8_STAGE(PG8_SB(0, 0), cB, voffB); PG8_STAGE(PG8_SB(0, 1), cB + hstepB, voffB); PG8_STAGE(PG8_SA(0, 0), cA, voffA); PG8_STAGE(PG8_SA(0, 1), cA + hstepA, voffA);
    if (wr == 1) PG8_BAR;
    PG8_WAIT_V(2); PG8_BAR;
    PG8_STAGE(PG8_SB(1, 0), cB + kstep, voffB); PG8_STAGE(PG8_SA(1, 0), cA + kstep, voffA); PG8_STAGE(PG8_SB(1, 1), cB + hstepB + kstep, voffB);
    PG8_WAIT_V(6); PG8_BAR;
    for (;;) {
        const bool has_next = S.next(ui + 1, nxt);
        const char* nA = has_next ? (const char*)g.A + (size_t)nxt.aoff * 2 : cA; const char* nB = has_next ? (const char*)g.Bt + (size_t)nxt.boff * 2 : cB;
#pragma unroll 1
        for (int t = 0; t < nt; t += 2) {
            const bool last = (t == nt - 2);
            const char* a1 = cA + (size_t)(t + 1) * kstep;
            const char* a2 = last ? nA : cA + (size_t)(t + 2) * kstep; const char* b2 = last ? nB : cB + (size_t)(t + 2) * kstep;
            const char* a3 = a2 + kstep; const char* b3 = b2 + kstep;
            PG8_LDB(B0, 0, 0); PG8_LDB(B1, 0, 1); PG8_SCHED; PG8_LDA(At, 0, 0); PG8_STAGE(PG8_SA(1, 1), a1 + hstepA, voffA);
            PG8_WAIT_V(8); PG8_WAIT_L(0); PG8_BAR; PG8_MMA(0, 0, At, B0); PG8_MMA(0, 1, At, B1); PG8_BAR; PG8_SCHED;
            PG8_LDA(At, 0, 1); PG8_STAGE(PG8_SB(0, 0), b2, voffB); PG8_STAGE(PG8_SB(0, 1), b2 + hstepB, voffB); PG8_STAGE(PG8_SA(0, 0), a2, voffA);
            PG8_WAIT_V(8); PG8_WAIT_L(0); PG8_BAR; PG8_MMA(1, 0, At, B0); PG8_MMA(1, 1, At, B1); PG8_BAR; PG8_SCHED;
            PG8_LDB(B0, 1, 0); PG8_LDB(B1, 1, 1); PG8_SCHED; PG8_LDA(At, 1, 0); PG8_STAGE(PG8_SA(0, 1), a2 + hstepA, voffA);
            PG8_WAIT_V(8); PG8_WAIT_L(0); PG8_BAR; PG8_MMA(0, 0, At, B0); PG8_MMA(0, 1, At, B1); PG8_BAR; PG8_SCHED;
            PG8_LDA(At, 1, 1); PG8_STAGE(PG8_SB(1, 0), b3, voffB); PG8_STAGE(PG8_SB(1, 1), b3 + hstepB, voffB); PG8_STAGE(PG8_SA(1, 0), a3, voffA);
            PG8_WAIT_V(8); PG8_WAIT_L(0); PG8_BAR; PG8_MMA(1, 0, At, B0); PG8_MMA(1, 1, At, B1); PG8_BAR; PG8_SCHED;
        }
        if constexpr (ALIGN_EPI) { if (wr == 0) PG8_BAR; }
        if constexpr (!Epi::AFTER_DRAIN) { E(acc, cur, wr, wc, fr, fq); }
        if (!has_next) break;
#pragma unroll
        for (int a = 0; a < 2; ++a)
#pragma unroll
            for (int b = 0; b < 2; ++b)
#pragma unroll
                for (int m = 0; m < 4; ++m)
#pragma unroll
                    for (int n = 0; n < 2; ++n) acc[a][b][m][n] = (f32x4){0.f, 0.f, 0.f, 0.f};
        cur = nxt; cA = nA; cB = nB; ++ui;
        if constexpr (ALIGN_EPI) { if (wr == 1) PG8_BAR; }
    }
    PG8_WAIT_V(0);
    if constexpr (!ALIGN_EPI) { if (wr == 0) PG8_BAR; }
    PG8_BAR;
    if constexpr (Epi::AFTER_DRAIN) { E.fused(acc, cur, wr, wc, fr, fq, lds, wid, lane); }
#undef PG8_SA
#undef PG8_SB
#undef PG8_STAGE
#undef PG8_LDA
#undef PG8_LDB
#undef PG8_MMA
#undef PG8_WAIT_V
#undef PG8_WAIT_L
#undef PG8_BAR
#undef PG8_SCHED
}

struct PlainSched {
    int nM, nN, nwg, G, c; unsigned am, bn;
    __device__ __forceinline__ void init(int M, int N, int lda, int ldb, int G_, int c_) { nM = M / BM; nN = N / BM; nwg = nM * nN; G = G_; c = c_; am = (unsigned)(BM * lda); bn = (unsigned)(BM * ldb); }
    __device__ __forceinline__ bool next(int i, Unit& u) const {
        const long L = (long)i * G + c; if (L >= (long)nwg * ((MK_DUP & 2) ? 2 : 1)) return false;
        int wgid = (int)(L % nwg); { const int q = nwg / NXCD, r = nwg % NXCD, xcd = wgid % NXCD, off = wgid / NXCD; wgid = (xcd < r ? xcd * (q + 1) : r * (q + 1) + (xcd - r) * q) + off; }
        const int nig = WGM * nN, gid = wgid / nig, fm = gid * WGM, gsz = (nM - fm) < WGM ? (nM - fm) : WGM;
        const int pm = fm + ((wgid % nig) % gsz), pn = (wgid % nig) / gsz;
        u.aoff = (unsigned)pm * am; u.boff = (unsigned)pn * bn; u.crow = pm * BM; u.ccol = pn * BM; u.z = 0; return true;
    }
};
struct MemKVSched {
    int c, first;
    __device__ __forceinline__ bool next(int i, Unit& u) const {
        const int L = c - first; if (i != 0 || L < 0 || L >= 64) return false;
        const int z = L >> 4, pm = (L >> 3) & 1, pn = L & 7;
        u.aoff = (unsigned)(pm * 256 * 1024); u.boff = (unsigned)((z * 2048 + pn * 256) * 1024); u.crow = pm * 256; u.ccol = pn * 256; u.z = z; return true;
    }
};
struct MemSSched {
    int c, layer;
    __device__ __forceinline__ bool next(int i, Unit& u) const {
        if (i >= ((MK_DUP & 4) ? 2 : 1) || c >= 256) return false;
        const int b = c >> 7, h = (c >> 5) & 3, pm = c & 31;
        u.aoff = (unsigned)((b * SEQ + pm * 256) * 1024 + h * 256); u.boff = (unsigned)((layer * 512 + b * 256) * 1024 + h * 256);
        u.crow = b * SEQ + pm * 256; u.ccol = h * 256; u.z = 0; return true;
    }
};
struct MemPVSched {
    int c, layer;
    __device__ __forceinline__ bool next(int i, Unit& u) const {
        if (i >= ((MK_DUP & 4) ? 2 : 1) || c >= 256) return false;
        const int b = c >> 7, h = (c >> 5) & 3, pm = c & 31;
        u.aoff = (unsigned)((b * SEQ + pm * 256) * 1024 + h * 256); u.boff = (unsigned)((layer * 1024 + h * 256) * 512 + b * 256);
        u.crow = b * SEQ + pm * 256; u.ccol = h * 256; u.z = 0; return true;
    }
};

struct EpiBf16 {
    static constexpr bool PERM = true, AFTER_DRAIN = false;
    bf16_t* O; int ldc;
    __device__ __forceinline__ void operator()(const f32x4 (&acc)[2][2][4][2], const Unit& u, int wr, int wc, int fr, int fq) const {
        const int row0 = u.crow + wr * 64 + fr, col0 = u.ccol + wc * 32 + 8 * fq;
#pragma unroll
        for (int ai = 0; ai < 2; ++ai)
#pragma unroll
            for (int m = 0; m < 4; ++m) { bf16_t* rowp = O + (size_t)(row0 + ai * HALF + m * 16) * ldc + col0;
#pragma unroll
                for (int bj = 0; bj < 2; ++bj) { const f32x4 v0 = acc[ai][bj][m][0], v1 = acc[ai][bj][m][1];
                    u32x4 w; w.x = cvt_pk_bf16(v0[0], v0[1]); w.y = cvt_pk_bf16(v0[2], v0[3]); w.z = cvt_pk_bf16(v1[0], v1[1]); w.w = cvt_pk_bf16(v1[2], v1[3]);
                    st_wt16(rowp + bj * HALF, w); } }
    }
};
struct EpiExp {
    static constexpr bool PERM = true, AFTER_DRAIN = false;
    bf16_t* O; int ldc; float scale_l2; LAS float* RS;
    __device__ __forceinline__ void operator()(const f32x4 (&acc)[2][2][4][2], const Unit& u, int wr, int wc, int fr, int fq) const {
        const int row0 = u.crow + wr * 64 + fr, col0 = u.ccol + wc * 32 + 8 * fq;
#pragma unroll
        for (int ai = 0; ai < 2; ++ai)
#pragma unroll
            for (int m = 0; m < 4; ++m) { bf16_t* rowp = O + (size_t)(row0 + ai * HALF + m * 16) * ldc + col0; float rs = 0.f;
#pragma unroll
                for (int bj = 0; bj < 2; ++bj) { f32x4 v0 = acc[ai][bj][m][0], v1 = acc[ai][bj][m][1];
#pragma unroll
                    for (int e = 0; e < 4; ++e) { v0[e] = __builtin_amdgcn_exp2f(fminf(fmaxf(v0[e] * scale_l2, -100.f), 100.f)); v1[e] = __builtin_amdgcn_exp2f(fminf(fmaxf(v1[e] * scale_l2, -100.f), 100.f)); }
                    rs += ((v0[0] + v0[1]) + (v0[2] + v0[3])) + ((v1[0] + v1[1]) + (v1[2] + v1[3]));
                    u32x4 w; w.x = cvt_pk_bf16(v0[0], v0[1]); w.y = cvt_pk_bf16(v0[2], v0[3]); w.z = cvt_pk_bf16(v1[0], v1[1]); w.w = cvt_pk_bf16(v1[2], v1[3]);
                    *(u32x4*)(rowp + bj * HALF) = w; }
                rs += __shfl_xor(rs, 16); rs += __shfl_xor(rs, 32);
                if (fq == 0) RS[wc * 256 + ai * HALF + wr * 64 + m * 16 + fr] = rs; }
    }
};
struct EpiBf16Scale {
    static constexpr bool PERM = true, AFTER_DRAIN = false;
    bf16_t* O; int ldc; const LAS float* RS;
    __device__ __forceinline__ void operator()(const f32x4 (&acc)[2][2][4][2], const Unit& u, int wr, int wc, int fr, int fq) const {
        const int row0 = u.crow + wr * 64 + fr, col0 = u.ccol + wc * 32 + 8 * fq;
#pragma unroll
        for (int ai = 0; ai < 2; ++ai)
#pragma unroll
            for (int m = 0; m < 4; ++m) { bf16_t* rowp = O + (size_t)(row0 + ai * HALF + m * 16) * ldc + col0; const int tr = ai * HALF + wr * 64 + m * 16 + fr;
                const float inv = 1.f / ((RS[tr] + RS[256 + tr]) + (RS[512 + tr] + RS[768 + tr]));
#pragma unroll
                for (int bj = 0; bj < 2; ++bj) { const f32x4 v0 = acc[ai][bj][m][0] * inv, v1 = acc[ai][bj][m][1] * inv;
                    u32x4 w; w.x = cvt_pk_bf16(v0[0], v0[1]); w.y = cvt_pk_bf16(v0[2], v0[3]); w.z = cvt_pk_bf16(v1[0], v1[1]); w.w = cvt_pk_bf16(v1[2], v1[3]);
                    st_wt16(rowp + bj * HALF, w); } }
    }
};
struct EpiF32 {
    static constexpr bool PERM = false, AFTER_DRAIN = false;
    float* C; int ldc;
    __device__ __forceinline__ void operator()(const f32x4 (&acc)[2][2][4][2], const Unit& u, int wr, int wc, int fr, int fq) const {
        const int row0 = u.crow + wr * 64 + fr, col0 = u.ccol + wc * 32 + 4 * fq;
#pragma unroll
        for (int ai = 0; ai < 2; ++ai)
#pragma unroll
            for (int m = 0; m < 4; ++m) { float* rowp = C + (size_t)(row0 + ai * HALF + m * 16) * ldc + col0;
#pragma unroll
                for (int bj = 0; bj < 2; ++bj)
#pragma unroll
                    for (int n = 0; n < 2; ++n) *(f32x4*)(rowp + bj * HALF + n * 16) = acc[ai][bj][m][n]; }
    }
};
struct EpiMemKV {
    static constexpr bool PERM = false, AFTER_DRAIN = false;
    float* outK; float* outV; bf16_t* MK; bf16_t* MVT;
    __device__ __forceinline__ void operator()(const f32x4 (&acc)[2][2][4][2], const Unit& u, int wr, int wc, int fr, int fq) const {
        const int row0 = u.crow + wr * 64 + fr; const bool isV = u.ccol >= 1024; const int col0 = (isV ? u.ccol - 1024 : u.ccol) + wc * 32 + 4 * fq;
        float* C = (isV ? outV : outK) + (size_t)u.z * 512 * 1024;
#pragma unroll
        for (int ai = 0; ai < 2; ++ai)
#pragma unroll
            for (int m = 0; m < 4; ++m) { const int row = row0 + ai * HALF + m * 16;
#pragma unroll
                for (int bj = 0; bj < 2; ++bj)
#pragma unroll
                    for (int n = 0; n < 2; ++n) { const f32x4 v = acc[ai][bj][m][n]; const int col = col0 + bj * HALF + n * 16;
                        *(f32x4*)(C + (size_t)row * 1024 + col) = v;
                        if (!isV) { u32x2 w; w.x = cvt_pk_bf16(v[0], v[1]); w.y = cvt_pk_bf16(v[2], v[3]); *(u32x2*)(MK + ((size_t)u.z * 512 + row) * 1024 + col) = w; }
                        else {
#pragma unroll
                            for (int e = 0; e < 4; ++e) MVT[((size_t)u.z * 1024 + col + e) * 512 + row] = (bf16_t)f2bf(v[e]); } } }
    }
};
struct EpiSoftmax {
    static constexpr bool PERM = true, AFTER_DRAIN = true;
    bf16_t* P; int ldc; float scale_l2;
    __device__ __forceinline__ void fused(f32x4 (&acc)[2][2][4][2], const Unit& u, int wr, int wc, int fr, int fq, LAS unsigned char* lds, int wid, int lane) const {
        LAS f32x2* TAB = (LAS f32x2*)lds;
        float mw[2][4];
#pragma unroll
        for (int ai = 0; ai < 2; ++ai)
#pragma unroll
            for (int m = 0; m < 4; ++m) {
                float mx = -3.0e38f;
#pragma unroll
                for (int bj = 0; bj < 2; ++bj)
#pragma unroll
                    for (int n = 0; n < 2; ++n) { f32x4 x = acc[ai][bj][m][n] * scale_l2; acc[ai][bj][m][n] = x; mx = fmaxf(mx, fmaxf(fmaxf(x[0], x[1]), fmaxf(x[2], x[3]))); }
                mx = fmaxf(mx, __shfl_xor(mx, 16)); mx = fmaxf(mx, __shfl_xor(mx, 32));
                float s = 0.f;
#pragma unroll
                for (int bj = 0; bj < 2; ++bj)
#pragma unroll
                    for (int n = 0; n < 2; ++n) { f32x4 x = acc[ai][bj][m][n]; x[0] = __builtin_amdgcn_exp2f(x[0] - mx); x[1] = __builtin_amdgcn_exp2f(x[1] - mx); x[2] = __builtin_amdgcn_exp2f(x[2] - mx); x[3] = __builtin_amdgcn_exp2f(x[3] - mx);
                        acc[ai][bj][m][n] = x; s += (x[0] + x[1]) + (x[2] + x[3]); }
                s += __shfl_xor(s, 16); s += __shfl_xor(s, 32);
                mw[ai][m] = mx;
                if (fq == 0) TAB[(ai * HALF + wr * 64 + m * 16 + fr) * 4 + wc] = (f32x2){mx, s};
            }
        asm volatile("s_waitcnt lgkmcnt(0)" ::: "memory"); __builtin_amdgcn_s_barrier(); asm volatile("" ::: "memory");
        const int row0 = u.crow + wr * 64 + fr, col0 = u.ccol + wc * 32 + 8 * fq;
#pragma unroll
        for (int ai = 0; ai < 2; ++ai)
#pragma unroll
            for (int m = 0; m < 4; ++m) {
                const int r = ai * HALF + wr * 64 + m * 16 + fr;
                const f32x2 t0 = TAB[r * 4 + 0], t1 = TAB[r * 4 + 1], t2 = TAB[r * 4 + 2], t3 = TAB[r * 4 + 3];
                const float M = fmaxf(fmaxf(t0.x, t1.x), fmaxf(t2.x, t3.x));
                const float L = t0.y * __builtin_amdgcn_exp2f(t0.x - M) + t1.y * __builtin_amdgcn_exp2f(t1.x - M) + t2.y * __builtin_amdgcn_exp2f(t2.x - M) + t3.y * __builtin_amdgcn_exp2f(t3.x - M);
                const float f = __builtin_amdgcn_exp2f(mw[ai][m] - M) / L;
                bf16_t* rowp = P + (size_t)(row0 + ai * HALF + m * 16) * ldc + col0;
#pragma unroll
                for (int bj = 0; bj < 2; ++bj) { const f32x4 v0 = acc[ai][bj][m][0] * f, v1 = acc[ai][bj][m][1] * f;
                    u32x4 w; w.x = cvt_pk_bf16(v0[0], v0[1]); w.y = cvt_pk_bf16(v0[2], v0[3]); w.z = cvt_pk_bf16(v1[0], v1[1]); w.w = cvt_pk_bf16(v1[2], v1[3]);
                    *(u32x4*)(rowp + bj * HALF) = w; }
            }
        asm volatile("s_waitcnt lgkmcnt(0)" ::: "memory"); __builtin_amdgcn_s_barrier(); asm volatile("" ::: "memory");
    }
};
}

constexpr int NWAVES = 8, NTHREADS = 512;
struct Args { const float* in[23]; float* out; unsigned char* ws; int ph_lo, ph_hi; };
struct Frame { LAS unsigned char* lds; int tid, lane, wave, G, bid; };

struct TrItem { const float* src; bf16_t* dst; int N; };
__device__ __forceinline__ void tr_load(const TrItem& t, float (&wv)[32], int lane) {
#pragma unroll
    for (int i = 0; i < 32; ++i) { const int kk = 2 * i + (lane >> 5); wv[i] = t.src[(size_t)kk * t.N + (lane & 31)]; }
}
__device__ __forceinline__ void tr_process(const TrItem& t, const float (&wv)[32], LAS float* scr, int lane) {
#pragma unroll
    for (int i = 0; i < 32; ++i) { const int kk = 2 * i + (lane >> 5); scr[kk * 33 + (lane & 31)] = wv[i]; }
    LDS_WAIT(); asm volatile("" ::: "memory");
    const int c = lane & 7;
#pragma unroll
    for (int j = 0; j < 4; ++j) { const int n = (lane >> 3) + 8 * j; const LAS float* s = scr + (8 * c) * 33 + n;
        u32x4 o; o.x = pk2(s[0 * 33], s[1 * 33]); o.y = pk2(s[2 * 33], s[3 * 33]); o.z = pk2(s[4 * 33], s[5 * 33]); o.w = pk2(s[6 * 33], s[7 * 33]);
        *(u32x4*)(t.dst + (size_t)n * 1024 + 8 * c) = o; }
    LDS_WAIT(); asm volatile("" ::: "memory");
}
__device__ __forceinline__ void cvt_bf16_range(const float* src, bf16_t* dst, size_t n, size_t gtid, size_t nthr) {
    size_t i = gtid * 8;
#pragma unroll 1
    for (; i + 3 * nthr * 8 < n; i += 4 * nthr * 8) {
        f32x4 a[4], b[4];
#pragma unroll
        for (int j = 0; j < 4; ++j) { a[j] = *(const f32x4*)(src + i + j * nthr * 8); b[j] = *(const f32x4*)(src + i + j * nthr * 8 + 4); }
#pragma unroll
        for (int j = 0; j < 4; ++j) { u32x4 o; o.x = pk2(a[j][0], a[j][1]); o.y = pk2(a[j][2], a[j][3]); o.z = pk2(b[j][0], b[j][1]); o.w = pk2(b[j][2], b[j][3]); *(u32x4*)(dst + i + j * nthr * 8) = o; }
    }
    for (; i < n; i += nthr * 8) { const f32x4 a = *(const f32x4*)(src + i), b = *(const f32x4*)(src + i + 4);
        u32x4 o; o.x = pk2(a[0], a[1]); o.y = pk2(a[2], a[3]); o.z = pk2(b[0], b[1]); o.w = pk2(b[2], b[3]); *(u32x4*)(dst + i) = o; }
}
__device__ __forceinline__ unsigned pack_fp8x4(f32x4 a, float sc) {
    int p = __builtin_amdgcn_cvt_pk_fp8_f32(a[0] * sc, a[1] * sc, 0, false);
    p = __builtin_amdgcn_cvt_pk_fp8_f32(a[2] * sc, a[3] * sc, p, true);
    return (unsigned)p;
}
constexpr float SU8 = 800.f, SX8 = 20.f;
__device__ __forceinline__ unsigned pack_i8x4(f32x4 a, float sc) {
    unsigned r = 0;
#pragma unroll
    for (int e = 0; e < 4; ++e) { const int q = (int)__builtin_rintf(fminf(fmaxf(a[e] * sc, -127.f), 127.f)); r |= ((unsigned)q & 0xffu) << (8 * e); }
    return r;
}
__device__ __forceinline__ void cvt_i8_range(const float* src, unsigned char* dst, size_t n, float sc, size_t gtid, size_t nthr) {
    for (size_t i = gtid * 16; i < n; i += nthr * 16) {
        const f32x4 a = __builtin_nontemporal_load((const f32x4*)(src + i)), b = __builtin_nontemporal_load((const f32x4*)(src + i + 4)),
                    c = __builtin_nontemporal_load((const f32x4*)(src + i + 8)), d = __builtin_nontemporal_load((const f32x4*)(src + i + 12));
        u32x4 o; o.x = pack_i8x4(a, sc); o.y = pack_i8x4(b, sc); o.z = pack_i8x4(c, sc); o.w = pack_i8x4(d, sc); *(u32x4*)(dst + i) = o; }
}
__device__ __forceinline__ void cvt_fp8_range(const float* src, unsigned char* dst, size_t n, float sc, size_t gtid, size_t nthr) {
    for (size_t i = gtid * 16; i < n; i += nthr * 16) {
        const f32x4 a = __builtin_nontemporal_load((const f32x4*)(src + i)), b = __builtin_nontemporal_load((const f32x4*)(src + i + 4)),
                    c = __builtin_nontemporal_load((const f32x4*)(src + i + 8)), d = __builtin_nontemporal_load((const f32x4*)(src + i + 12));
        u32x4 o; o.x = pack_fp8x4(a, sc); o.y = pack_fp8x4(b, sc); o.z = pack_fp8x4(c, sc); o.w = pack_fp8x4(d, sc); *(u32x4*)(dst + i) = o; }
}
__device__ __forceinline__ void p0_prologue(const Frame& F, const Args& A) {
    unsigned char* ws = A.ws;
    LAS float* scr = (LAS float*)(F.lds + F.wave * 16384);
    const int gw = F.bid * NWAVES + F.wave, NGW = F.G * NWAVES;
    constexpr int NITEMS = 2 * 768 + 2 * 512 + 2 * 1536 + 2 * 512 + 4 * 512 + 4 * 1024 + 4 * 512 + 4 * 1024;
#define TR_GROUP(t, SRC, DSTOFF, NL, NN) if (!found) { constexpr int IT = 16 * ((NN) / 32); if (r < (NL) * IT) { const int l = r / IT, it2 = r % IT, kb = it2 / ((NN) / 32), nb = it2 % ((NN) / 32); \
        t.src = (SRC) + (size_t)l * 1024 * (NN) + (size_t)(64 * kb) * (NN) + 32 * nb; t.dst = (bf16_t*)(ws + (DSTOFF)) + (size_t)l * (NN) * 1024 + (size_t)(32 * nb) * 1024 + 64 * kb; t.N = (NN); found = true; } else r -= (NL) * IT; }
#define TR_LOCATE(it_, t) do { int r = (it_); bool found = false; \
        TR_GROUP(t, A.in[8], WS_WQKV, 2, 1536) TR_GROUP(t, A.in[10], WS_WO, 2, 1024) TR_GROUP(t, A.in[11], WS_WIN, 2, 3072) TR_GROUP(t, A.in[13], WS_WOUT, 2, 1024) \
        TR_GROUP(t, A.in[14], WS_WMQ, 4, 1024) TR_GROUP(t, A.in[15], WS_WMKV, 4, 2048) TR_GROUP(t, A.in[16], WS_WMO, 4, 1024) TR_GROUP(t, A.in[17], WS_WPQ, 4, 2048) } while (0)
    if (gw < NITEMS) {
        TrItem cur, nxt; float wa[32], wb[32];
        TR_LOCATE(gw, cur); tr_load(cur, wa, F.lane);
#pragma unroll 1
        for (int it = gw; it < NITEMS; it += NGW) {
            const bool has = (it + NGW < NITEMS);
            if (has) { TR_LOCATE(it + NGW, nxt); tr_load(nxt, wb, F.lane); }
            tr_process(cur, wa, scr, F.lane);
            if (has) { cur = nxt;
#pragma unroll
                for (int i = 0; i < 32; ++i) wa[i] = wb[i]; }
        }
    }
#undef TR_LOCATE
#undef TR_GROUP
    const size_t gtid = (size_t)F.bid * NTHREADS + F.tid, nthr = (size_t)F.G * NTHREADS;
    cvt_bf16_range(A.in[18], (bf16_t*)(ws + WS_SUBK), (size_t)NLAYER * 2 * 128 * 128, gtid, nthr);
    cvt_bf16_range(A.in[7], (bf16_t*)(ws + WS_MEMB), (size_t)512 * 1024, gtid, nthr);
    cvt_bf16_range(A.in[0], (bf16_t*)(ws + WS_XB), (size_t)TP * D, gtid, nthr);
    cvt_bf16_range(A.in[1], (bf16_t*)(ws + WS_XB) + (size_t)TP * D, (size_t)TS * D, gtid, nthr);
}

template <bool FIRST>
__device__ __forceinline__ void ln_phase(const Frame& F, const float* xa, const float* xb, const bf16_t* XBin, const bf16_t* Fb, const float* gam, const float* bet,
                                         bf16_t* XB, unsigned char* X8  , float* YOUT  ) {
    const int gw = F.bid * NWAVES + F.wave, NGW = F.G * NWAVES, lane = F.lane;
    f32x4 gv[4], bv[4];
#define LN_COL(i) (8 * lane + 512 * ((i) >> 1) + 4 * ((i) & 1))
#pragma unroll
    for (int i = 0; i < 4; ++i) { gv[i] = *(const f32x4*)(gam + LN_COL(i)); bv[i] = *(const f32x4*)(bet + LN_COL(i)); }
    if (gw >= T) return;
#define LN_LOADX(dst, r_) do { if (FIRST) { const float* xr_ = ((r_) < TP) ? xa + (size_t)(r_) * D : xb + (size_t)((r_) - TP) * D; \
            _Pragma("unroll") for (int i = 0; i < 4; ++i) dst[i] = *(const f32x4*)(xr_ + LN_COL(i)); } \
        else { _Pragma("unroll") for (int j = 0; j < 2; ++j) { const u32x4 w_ = *(const u32x4*)(XBin + (size_t)(r_) * D + 8 * lane + 512 * j); \
            dst[2 * j] = (f32x4){bflo(w_.x), bfhi(w_.x), bflo(w_.y), bfhi(w_.y)}; dst[2 * j + 1] = (f32x4){bflo(w_.z), bfhi(w_.z), bflo(w_.w), bfhi(w_.w)}; } } } while (0)
    f32x4 xc[4]; u32x4 fc[2];
    LN_LOADX(xc, gw);
#pragma unroll
    for (int j = 0; j < 2; ++j) fc[j] = *(const u32x4*)(Fb + (size_t)gw * D + 8 * lane + 512 * j);
#pragma unroll 1
    for (int r = gw; r < T; r += NGW) {
        const int rn = (r + NGW < T) ? r + NGW : r;
        f32x4 xn[4]; u32x4 fn[2];
        LN_LOADX(xn, rn);
#pragma unroll
        for (int j = 0; j < 2; ++j) fn[j] = *(const u32x4*)(Fb + (size_t)rn * D + 8 * lane + 512 * j);
        f32x4 v[4]; float s = 0.f;
#pragma unroll
        for (int j = 0; j < 2; ++j) { const f32x4 f0 = (f32x4){bflo(fc[j].x), bfhi(fc[j].x), bflo(fc[j].y), bfhi(fc[j].y)}, f1 = (f32x4){bflo(fc[j].z), bfhi(fc[j].z), bflo(fc[j].w), bfhi(fc[j].w)};
            v[2 * j] = xc[2 * j] * DN_ALPHA + f0; v[2 * j + 1] = xc[2 * j + 1] * DN_ALPHA + f1; }
#pragma unroll
        for (int i = 0; i < 4; ++i) s += (v[i][0] + v[i][1]) + (v[i][2] + v[i][3]);
        const float mean = wave_sum(s) * (1.f / D); float s2 = 0.f;
#pragma unroll
        for (int i = 0; i < 4; ++i) { v[i] = v[i] - mean; s2 += (v[i][0] * v[i][0] + v[i][1] * v[i][1]) + (v[i][2] * v[i][2] + v[i][3] * v[i][3]); }
        const float rstd = 1.f / sqrtf(wave_sum(s2) * (1.f / D) + LN_EPS);
        f32x4 y[4];
#pragma unroll
        for (int i = 0; i < 4; ++i) { y[i] = v[i] * rstd * gv[i] + bv[i]; if (YOUT) *(f32x4*)(YOUT + (size_t)r * D + LN_COL(i)) = y[i]; }
#pragma unroll
        for (int j = 0; j < 2; ++j) {
            u32x4 w; w.x = pk2(y[2 * j][0], y[2 * j][1]); w.y = pk2(y[2 * j][2], y[2 * j][3]); w.z = pk2(y[2 * j + 1][0], y[2 * j + 1][1]); w.w = pk2(y[2 * j + 1][2], y[2 * j + 1][3]);
            st_wt16(XB + (size_t)r * D + 8 * lane + 512 * j, w);
            if (X8) { u32x2 q8; q8.x = pack_i8x4(y[2 * j], SX8); q8.y = pack_i8x4(y[2 * j + 1], SX8); *(u32x2*)(X8 + (size_t)r * D + 8 * lane + 512 * j) = q8; } }
#pragma unroll
        for (int i = 0; i < 4; ++i) xc[i] = xn[i];
#pragma unroll
        for (int j = 0; j < 2; ++j) fc[j] = fn[j];
    }
#undef LN_LOADX
#undef LN_COL
}

__device__ __forceinline__ void load_u8(const bf16_t* BIG, int row, int c0, float (&u)[8]) {
    const u32x4 gc = *(const u32x4*)(BIG + (size_t)row * 3072 + 1024 + c0), h = *(const u32x4*)(BIG + (size_t)row * 3072 + 2048 + c0);
#pragma unroll
    for (int e = 0; e < 4; ++e) { u[2 * e] = bflo(gc[e]) * bflo(h[e]); u[2 * e + 1] = bfhi(gc[e]) * bfhi(h[e]); }
}
__device__ __forceinline__ void conv_rows_generic(const Frame& F, const bf16_t* BIG, bf16_t* OB, const float* cw  , const float* state  , float* cvp  , float* cvs  , size_t idx_lo, size_t idx_hi) {
    const size_t gtid = (size_t)F.bid * NTHREADS + F.tid, nthr = (size_t)F.G * NTHREADS;
    for (size_t idx = idx_lo + gtid; idx < idx_hi; idx += nthr) {
        const int r = (int)(idx >> 7), c0 = (int)(idx & 127) * 8;
        float u0[8], um1[8], um2[8];
        load_u8(BIG, r, c0, u0);
        if (r < TP) {
            const int t = r & (SEQ - 1), b = r >> 13;
            if (t >= 1) load_u8(BIG, r - 1, c0, um1); else {
#pragma unroll
                for (int e = 0; e < 8; ++e) um1[e] = 0.f; }
            if (t >= 2) load_u8(BIG, r - 2, c0, um2); else {
#pragma unroll
                for (int e = 0; e < 8; ++e) um2[e] = 0.f; }
            if (t >= SEQ - 2) { float* o = cvp + ((size_t)b * 2 + (t - (SEQ - 2))) * D + c0; *(f32x4*)o = (f32x4){u0[0], u0[1], u0[2], u0[3]}; *(f32x4*)(o + 4) = (f32x4){u0[4], u0[5], u0[6], u0[7]}; }
        } else {
            const int rr = r - TP, b = rr >> 2, l = rr & 3;
            const float* st = state + (size_t)b * 2 * D + c0;
            if (l >= 1) load_u8(BIG, r - 1, c0, um1); else { const f32x4 a = *(const f32x4*)(st + D), c = *(const f32x4*)(st + D + 4);
#pragma unroll
                for (int e = 0; e < 4; ++e) { um1[e] = a[e]; um1[4 + e] = c[e]; } }
            if (l >= 2) load_u8(BIG, r - 2, c0, um2); else { const f32x4 a = *(const f32x4*)(st + (size_t)l * D), c = *(const f32x4*)(st + (size_t)l * D + 4);
#pragma unroll
                for (int e = 0; e < 4; ++e) { um2[e] = a[e]; um2[4 + e] = c[e]; } }
            if (l >= 2) { float* o = cvs + ((size_t)b * 2 + (l - 2)) * D + c0; *(f32x4*)o = (f32x4){u0[0], u0[1], u0[2], u0[3]}; *(f32x4*)(o + 4) = (f32x4){u0[4], u0[5], u0[6], u0[7]}; }
        }
        const u32x4 gb = *(const u32x4*)(BIG + (size_t)r * 3072 + c0);
        float w0[8], w1[8], w2[8];
#pragma unroll
        for (int e = 0; e < 2; ++e) { const f32x4 a = *(const f32x4*)(cw + c0 + 4 * e), b2 = *(const f32x4*)(cw + D + c0 + 4 * e), c = *(const f32x4*)(cw + 2 * D + c0 + 4 * e);
#pragma unroll
            for (int q = 0; q < 4; ++q) { w0[4 * e + q] = a[q]; w1[4 * e + q] = b2[q]; w2[4 * e + q] = c[q]; } }
        float y[8];
#pragma unroll
        for (int e = 0; e < 8; ++e) { const float z = w0[e] * um2[e] + w1[e] * um1[e] + w2[e] * u0[e]; const float g = (e & 1) ? bfhi(gb[e >> 1]) : bflo(gb[e >> 1]); y[e] = g * z; }
        u32x4 o; o.x = pk2(y[0], y[1]); o.y = pk2(y[2], y[3]); o.z = pk2(y[4], y[5]); o.w = pk2(y[6], y[7]);
        st_wt16(OB + (size_t)r * D + c0, o);
    }
}

__device__ __forceinline__ void conv_phase(const Frame& F, const bf16_t* BIG, bf16_t* OB, const float* cw  , const float* state  , float* cvp  , float* cvs  ) {
    const int gtid = F.bid * NTHREADS + F.tid, nthr = F.G * NTHREADS;
    if ((nthr & 127) == 0) {
        const int c0 = (gtid & 127) * 8, r0 = gtid >> 7, rstep = nthr >> 7;
        float w0[8], w1[8], w2[8];
#pragma unroll
        for (int e = 0; e < 2; ++e) { const f32x4 a = *(const f32x4*)(cw + c0 + 4 * e), b2 = *(const f32x4*)(cw + D + c0 + 4 * e), c = *(const f32x4*)(cw + 2 * D + c0 + 4 * e);
#pragma unroll
            for (int q = 0; q < 4; ++q) { w0[4 * e + q] = a[q]; w1[4 * e + q] = b2[q]; w2[4 * e + q] = c[q]; } }
#define CV_LD(R, r_) do { const int t_ = (r_) & (SEQ - 1); const int r1_ = (t_ >= 1) ? (r_) - 1 : (r_), r2_ = (t_ >= 2) ? (r_) - 2 : (r_); \
            R[0] = *(const u32x4*)(BIG + (size_t)(r_) * 3072 + c0); R[1] = *(const u32x4*)(BIG + (size_t)(r_) * 3072 + 1024 + c0); R[2] = *(const u32x4*)(BIG + (size_t)(r_) * 3072 + 2048 + c0); \
            R[3] = *(const u32x4*)(BIG + (size_t)r1_ * 3072 + 1024 + c0); R[4] = *(const u32x4*)(BIG + (size_t)r1_ * 3072 + 2048 + c0); \
            R[5] = *(const u32x4*)(BIG + (size_t)r2_ * 3072 + 1024 + c0); R[6] = *(const u32x4*)(BIG + (size_t)r2_ * 3072 + 2048 + c0); } while (0)
#define CV_FIN(R, r_) do { const int t_ = (r_) & (SEQ - 1), b_ = (r_) >> 13; const float m1_ = (t_ >= 1) ? 1.f : 0.f, m2_ = (t_ >= 2) ? 1.f : 0.f; float u0_[8], y_[8]; \
            _Pragma("unroll") for (int e = 0; e < 4; ++e) { \
                u0_[2 * e] = bflo(R[1][e]) * bflo(R[2][e]); u0_[2 * e + 1] = bfhi(R[1][e]) * bfhi(R[2][e]); \
                const float a1_ = bflo(R[3][e]) * bflo(R[4][e]) * m1_, b1_ = bfhi(R[3][e]) * bfhi(R[4][e]) * m1_, a2_ = bflo(R[5][e]) * bflo(R[6][e]) * m2_, b2_ = bfhi(R[5][e]) * bfhi(R[6][e]) * m2_; \
                y_[2 * e] = bflo(R[0][e]) * (w0[2 * e] * a2_ + w1[2 * e] * a1_ + w2[2 * e] * u0_[2 * e]); y_[2 * e + 1] = bfhi(R[0][e]) * (w0[2 * e + 1] * b2_ + w1[2 * e + 1] * b1_ + w2[2 * e + 1] * u0_[2 * e + 1]); } \
            if (t_ >= SEQ - 2) { float* o_ = cvp + ((size_t)b_ * 2 + (t_ - (SEQ - 2))) * D + c0; *(f32x4*)o_ = (f32x4){u0_[0], u0_[1], u0_[2], u0_[3]}; *(f32x4*)(o_ + 4) = (f32x4){u0_[4], u0_[5], u0_[6], u0_[7]}; } \
            u32x4 o4_; o4_.x = pk2(y_[0], y_[1]); o4_.y = pk2(y_[2], y_[3]); o4_.z = pk2(y_[4], y_[5]); o4_.w = pk2(y_[6], y_[7]); st_wt16(OB + (size_t)(r_) * D + c0, o4_); } while (0)
#pragma unroll 1
        for (int r = r0; r < TP; r += 2 * rstep) {
            const int rb = r + rstep; const bool hasb = rb < TP; const int rbc = hasb ? rb : r;
            u32x4 Ra[7], Rb[7];
            CV_LD(Ra, r); CV_LD(Rb, rbc);
            CV_FIN(Ra, r);
            if (hasb) CV_FIN(Rb, rb);
        }
#undef CV_LD
#undef CV_FIN
        conv_rows_generic(F, BIG, OB, cw, state, cvp, cvs, (size_t)TP * 128, (size_t)T * 128);
    } else conv_rows_generic(F, BIG, OB, cw, state, cvp, cvs, 0, (size_t)T * 128);
}

__device__ __forceinline__ void cvt_tables_part(const Frame& F, const Args& A, unsigned char* ws, int layer, int q) {
    if (F.bid < 8) return;
    const size_t n = (size_t)NEXP * D, b0 = (n * q / 3) & ~(size_t)15, b1 = (q == 2) ? n : ((n * (q + 1) / 3) & ~(size_t)15);
    const size_t gtid = (size_t)(F.bid - 8) * NTHREADS + F.tid, nthr = (size_t)(F.G - 8) * NTHREADS;
    cvt_i8_range(A.in[19] + (size_t)layer * n + b0, ws + WS_PU8 + (size_t)layer * n + b0, b1 - b0, SU8, gtid, nthr);
    cvt_fp8_range(A.in[20] + (size_t)layer * n + b0, ws + WS_PV8 + (size_t)layer * n + b0, b1 - b0, V_SCALE, gtid, nthr);
}
constexpr int MG_PITCH = 68;
constexpr int MG_WAVE  = 32 * MG_PITCH;
template <int N> __device__ __forceinline__ void mini_gemm(const Frame& F, const bf16_t* A, const bf16_t* Bt, bf16_t* C, int ldc) {
    constexpr int NC = N / 1024;
    if (F.bid >= 256) return;
    const int lane = F.lane, r = lane & 15, q = lane >> 4, rb = F.bid >> 4, cb = F.bid & 15, kw = F.wave;
    const int row0 = rb * 32, col0 = cb * (N / 16);
    const bf16_t* ap = A + (size_t)(row0 + r) * 1024 + kw * 128 + 8 * q;
    const bf16_t* bp = Bt + (size_t)(col0 + r) * 1024 + kw * 128 + 8 * q;
    LAS float* P = (LAS float*)F.lds;
    bf16x8 af[2][4], bfr[4][4];
#pragma unroll
    for (int m = 0; m < 2; ++m)
#pragma unroll
        for (int s = 0; s < 4; ++s) af[m][s] = *(const bf16x8*)(ap + (size_t)m * 16 * 1024 + 32 * s);
#pragma unroll
    for (int n = 0; n < 4; ++n)
#pragma unroll
        for (int s = 0; s < 4; ++s) bfr[n][s] = *(const bf16x8*)(bp + (size_t)n * 16 * 1024 + 32 * s);
    WG_BAR();
#pragma unroll 1
    for (int c = 0; c < NC; ++c) {
        f32x4 acc[2][4];
#pragma unroll
        for (int m = 0; m < 2; ++m)
#pragma unroll
            for (int n = 0; n < 4; ++n) acc[m][n] = (f32x4){0.f, 0.f, 0.f, 0.f};
#pragma unroll
        for (int s = 0; s < 4; ++s)
#pragma unroll
            for (int m = 0; m < 2; ++m)
#pragma unroll
                for (int n = 0; n < 4; ++n) acc[m][n] = __builtin_amdgcn_mfma_f32_16x16x32_bf16(af[m][s], bfr[n][s], acc[m][n], 0, 0, 0);
        if (c + 1 < NC) {
#pragma unroll
            for (int n = 0; n < 4; ++n)
#pragma unroll
                for (int s = 0; s < 4; ++s) bfr[n][s] = *(const bf16x8*)(bp + (size_t)((c + 1) * 64 + n * 16) * 1024 + 32 * s);
        }
#pragma unroll
        for (int m = 0; m < 2; ++m)
#pragma unroll
            for (int n = 0; n < 4; ++n)
#pragma unroll
                for (int e = 0; e < 4; ++e) P[kw * MG_WAVE + (16 * m + 4 * q + e) * MG_PITCH + 16 * n + r] = acc[m][n][e];
        WG_BAR();
        {
            const int row = F.tid >> 4, c4 = (F.tid & 15) * 4;
            f32x4 s4 = *(LAS f32x4*)(P + row * MG_PITCH + c4);
#pragma unroll
            for (int w = 1; w < 8; ++w) { const f32x4 t4 = *(LAS f32x4*)(P + w * MG_WAVE + row * MG_PITCH + c4); s4[0] += t4[0]; s4[1] += t4[1]; s4[2] += t4[2]; s4[3] += t4[3]; }
            u32x2 o; o.x = pk2(s4[0], s4[1]); o.y = pk2(s4[2], s4[3]);
            *(u32x2*)(C + (size_t)(row0 + row) * ldc + col0 + c * 64 + c4) = o;
        }
        if (c + 1 < NC) WG_BAR();
    }
}

constexpr int AT_KP = 72, AT_VP = 264;
__device__ __forceinline__ void attn_prompt_unit(const Frame& F, const bf16_t* BIG, bf16_t* OB, const float* sinks, float* wkp, float* wvp, int unit) {
    const int kvh = unit & 3, qb = (unit >> 2) & 63, b = unit >> 8;
    const int tid = F.tid, lane = F.lane, wave = F.wave;
    LAS bf16_t* Ks = (LAS bf16_t*)F.lds;
    LAS bf16_t* Vt = (LAS bf16_t*)(F.lds + 256 * AT_KP * 2);
#pragma unroll
    for (int it = 0; it < 4; ++it) {
        const int id = tid + 512 * it, row = id >> 3, c16 = id & 7, kpos = qb * 128 - 128 + row;
        u32x4 kv = (u32x4){0u, 0u, 0u, 0u}, vv = (u32x4){0u, 0u, 0u, 0u};
        if (kpos >= 0) { const bf16_t* src = BIG + (size_t)(b * SEQ + kpos) * QKVW + 1024 + kvh * 64 + c16 * 8; kv = *(const u32x4*)src; vv = *(const u32x4*)(src + 256); }
        *(LAS u32x4*)(Ks + row * AT_KP + c16 * 8) = kv;
#pragma unroll
        for (int e = 0; e < 4; ++e) { Vt[(c16 * 8 + 2 * e) * AT_VP + row] = (bf16_t)(vv[e] & 0xffffu); Vt[(c16 * 8 + 2 * e + 1) * AT_VP + row] = (bf16_t)(vv[e] >> 16); }
    }
    WG_BAR();
    const int g = wave >> 1, half = wave & 1, head = kvh * 4 + g, qi = lane & 15, q4 = lane >> 4;
    const float sinkl = sinks[head] * LOG2E;
    constexpr float SC = 0.125f * LOG2E;
#pragma unroll 1
    for (int qt = 0; qt < 4; ++qt) {
        const int i0 = half * 64 + qt * 16, i = i0 + qi;
        const bf16_t* qp = BIG + (size_t)(b * SEQ + qb * 128 + i) * QKVW + head * 64 + q4 * 8;
        const bf16x8 qf0 = *(const bf16x8*)qp, qf1 = *(const bf16x8*)(qp + 32);
        const int t0 = i0 >> 4, t0p = t0 < 6 ? t0 : 6, kt0 = 16 * t0p;
        f32x4 acc[10];
#pragma unroll
        for (int t = 0; t < 10; ++t) {
            const LAS bf16_t* kr = Ks + (kt0 + 16 * t + qi) * AT_KP + q4 * 8;
            const bf16x8 kf0 = *(const LAS bf16x8*)kr, kf1 = *(const LAS bf16x8*)(kr + 32);
            f32x4 a = (f32x4){0.f, 0.f, 0.f, 0.f};
            a = __builtin_amdgcn_mfma_f32_16x16x32_bf16(kf0, qf0, a, 0, 0, 0);
            a = __builtin_amdgcn_mfma_f32_16x16x32_bf16(kf1, qf1, a, 0, 0, 0);
            acc[t] = a;
        }
        float mx = -1.0e30f;
#pragma unroll
        for (int t = 0; t < 10; ++t) {
            const int kb = kt0 + 16 * t;
            const bool inside = (kb >= i0 + 15) && (kb + 15 <= i0 + 128) && (qb > 0 || kb >= 128);
            if (inside) {
#pragma unroll
                for (int r = 0; r < 4; ++r) mx = fmaxf(mx, acc[t][r]);
            } else {
#pragma unroll
                for (int r = 0; r < 4; ++r) { const int kk = kb + 4 * q4 + r; const bool ok = (kk >= i) && (kk <= i + 128) && (qb > 0 || kk >= 128);
                    const float s = ok ? acc[t][r] : -1.0e30f; acc[t][r] = s; mx = fmaxf(mx, s); }
            }
        }
        mx = fmaxf(mx, __shfl_xor(mx, 16)); mx = fmaxf(mx, __shfl_xor(mx, 32)); mx = fmaxf(mx * SC, sinkl);
        float sum = 0.f; const float nmx = -mx;
#pragma unroll
        for (int t = 0; t < 10; ++t)
#pragma unroll
            for (int r = 0; r < 4; ++r) { const float p = __builtin_amdgcn_exp2f(__builtin_fmaf(acc[t][r], SC, nmx)); acc[t][r] = p; sum += p; }
        sum += __shfl_xor(sum, 16); sum += __shfl_xor(sum, 32);
        const float inv = 1.f / (sum + __builtin_amdgcn_exp2f(sinkl - mx));
        f32x4 o[4];
#pragma unroll
        for (int dt = 0; dt < 4; ++dt) o[dt] = (f32x4){0.f, 0.f, 0.f, 0.f};
#pragma unroll
        for (int s2 = 0; s2 < 5; ++s2) {
            u32x4 pw; pw.x = cvt_pk_bf16(acc[2 * s2][0], acc[2 * s2][1]); pw.y = cvt_pk_bf16(acc[2 * s2][2], acc[2 * s2][3]);
            pw.z = cvt_pk_bf16(acc[2 * s2 + 1][0], acc[2 * s2 + 1][1]); pw.w = cvt_pk_bf16(acc[2 * s2 + 1][2], acc[2 * s2 + 1][3]);
            const bf16x8 pf = __builtin_bit_cast(bf16x8, pw);
#pragma unroll
            for (int dt = 0; dt < 4; ++dt) {
                const LAS bf16_t* vr = Vt + (16 * dt + qi) * AT_VP + kt0 + 32 * s2 + 4 * q4;
                const u32x2 lo = *(const LAS u32x2*)vr, hi = *(const LAS u32x2*)(vr + 16);
                u32x4 vw; vw.x = lo.x; vw.y = lo.y; vw.z = hi.x; vw.w = hi.y;
                o[dt] = __builtin_amdgcn_mfma_f32_16x16x32_bf16(__builtin_bit_cast(bf16x8, vw), pf, o[dt], 0, 0, 0);
            }
        }
        bf16_t* op = OB + (size_t)(b * SEQ + qb * 128 + i) * D + head * 64 + 4 * q4;
#pragma unroll
        for (int dt = 0; dt < 4; ++dt) { u32x2 w; w.x = pk2(o[dt][0] * inv, o[dt][1] * inv); w.y = pk2(o[dt][2] * inv, o[dt][3] * inv); *(u32x2*)(op + 16 * dt) = w; }
    }
    if (qb == 63) {
        for (int e = tid; e < 128 * 64; e += NTHREADS) { const int i = e >> 6, d = e & 63;
            wkp[((size_t)(b * 128 + i) * 4 + kvh) * 64 + d] = bf2f(Ks[(128 + i) * AT_KP + d]);
            wvp[((size_t)(b * 128 + i) * 4 + kvh) * 64 + d] = bf2f(Vt[d * AT_VP + 128 + i]); }
    }
    WG_BAR();
}

constexpr int AS_P = 65;
__device__ __forceinline__ void attn_sample_unit(const Frame& F, const bf16_t* BIG, bf16_t* OB, const float* sinks, const float* cwk, const float* cwv  ,
                                                 float* wks, float* wvs, int unit) {
    const int kvh = unit & 3, b = unit >> 2, tid = F.tid, lane = F.lane, wave = F.wave;
    LAS float* Kc = (LAS float*)F.lds;
    LAS float* Vc = Kc + 132 * AS_P;
    LAS float* Ps = Vc + 132 * AS_P;
    LAS float* Qs = Ps + 16 * 136;
#pragma unroll
    for (int it = 0; it < 4; ++it) { const int id = tid + 512 * it, row = id >> 4, c4 = id & 15;
        const size_t so = (((size_t)b * 128 + row) * 4 + kvh) * 64 + c4 * 4;
        const f32x4 k = *(const f32x4*)(cwk + so), v = *(const f32x4*)(cwv + so);
#pragma unroll
        for (int e = 0; e < 4; ++e) { Kc[row * AS_P + c4 * 4 + e] = k[e]; Vc[row * AS_P + c4 * 4 + e] = v[e]; } }
    if (tid < 256) { const int l = tid >> 6, d = tid & 63; const bf16_t* src = BIG + (size_t)(TP + b * 4 + l) * QKVW + 1024 + kvh * 64 + d;
        Kc[(128 + l) * AS_P + d] = bf2f(src[0]); Vc[(128 + l) * AS_P + d] = bf2f(src[256]); }
#pragma unroll
    for (int e = 0; e < 2; ++e) { const int idx = tid + 512 * e, qrow = idx >> 6, d = idx & 63, g = qrow >> 2, l = qrow & 3;
        Qs[qrow * 64 + d] = bf2f(BIG[(size_t)(TP + b * 4 + l) * QKVW + (kvh * 4 + g) * 64 + d]); }
    WG_BAR();
    constexpr float SC = 0.125f * LOG2E;
    {
        float s[2][3];
#pragma unroll
        for (int p = 0; p < 3; ++p) { s[0][p] = 0.f; s[1][p] = 0.f; }
        const int kc2 = (lane + 128 < 132) ? lane + 128 : 131;
#pragma unroll 1
        for (int d = 0; d < 64; d += 4) {
            const f32x4 q0 = *(const LAS f32x4*)(Qs + (2 * wave) * 64 + d), q1 = *(const LAS f32x4*)(Qs + (2 * wave + 1) * 64 + d);
#pragma unroll
            for (int p = 0; p < 3; ++p) { const int key = (p < 2) ? lane + 64 * p : kc2;
#pragma unroll
                for (int e = 0; e < 4; ++e) { const float kd = Kc[key * AS_P + d + e]; s[0][p] += q0[e] * kd; s[1][p] += q1[e] * kd; } }
        }
#pragma unroll
        for (int rr = 0; rr < 2; ++rr) { const int qrow = 2 * wave + rr, l = qrow & 3, g = qrow >> 2; const float sinkl = sinks[kvh * 4 + g] * LOG2E;
            float mx = -1.0e30f;
#pragma unroll
            for (int p = 0; p < 3; ++p) { const int key = lane + 64 * p; const bool ok = key < 128 ? (key >= l) : (key < 132 && (key - 128) <= l);
                s[rr][p] = ok ? s[rr][p] * SC : -1.0e30f; mx = fmaxf(mx, s[rr][p]); }
            mx = fmaxf(wave_max(mx), sinkl);
            float sum = 0.f;
#pragma unroll
            for (int p = 0; p < 3; ++p) { s[rr][p] = __builtin_amdgcn_exp2f(s[rr][p] - mx); sum += s[rr][p]; }
            sum = wave_sum(sum);
            const float inv = 1.f / (sum + __builtin_amdgcn_exp2f(sinkl - mx));
#pragma unroll
            for (int p = 0; p < 3; ++p) { const int key = lane + 64 * p; if (key < 132) Ps[qrow * 136 + key] = s[rr][p] * inv; } }
    }
    WG_BAR();
    {
        float o0 = 0.f, o1 = 0.f;
#pragma unroll 4
        for (int key = 0; key < 132; ++key) { const float v = Vc[key * AS_P + lane]; o0 += Ps[(2 * wave) * 136 + key] * v; o1 += Ps[(2 * wave + 1) * 136 + key] * v; }
#pragma unroll
        for (int rr = 0; rr < 2; ++rr) { const int qrow = 2 * wave + rr, l = qrow & 3, g = qrow >> 2;
            OB[(size_t)(TP + b * 4 + l) * D + (kvh * 4 + g) * 64 + lane] = (bf16_t)f2bf(rr ? o1 : o0); }
    }
    for (int e = tid; e < 128 * 64; e += NTHREADS) { const int i = e >> 6, d = e & 63; const size_t oo = (((size_t)b * 128 + i) * 4 + kvh) * 64 + d;
        wks[oo] = Kc[(i + 4) * AS_P + d]; wvs[oo] = Vc[(i + 4) * AS_P + d]; }
    WG_BAR();
}

__device__ __forceinline__ void mem_sample_unit(const Frame& F, const bf16_t* QM, bf16_t* OB, const float* ck, const float* cv  , int unit) {
    const int h = unit & 3, b = unit >> 2, tid = F.tid, lane = F.lane, wave = F.wave;
    LAS float* Sc = (LAS float*)F.lds;
    LAS float* PT = Sc + 1024;
    LAS float* Red = PT + 1024;
    f32x4 q[4];
#pragma unroll
    for (int l = 0; l < 4; ++l) { const u32x2 w = *(const u32x2*)(QM + (size_t)(TP + b * 4 + l) * D + h * 256 + 4 * lane); q[l] = (f32x4){bflo(w.x), bfhi(w.x), bflo(w.y), bfhi(w.y)}; }
    const float* kb = ck + ((size_t)b * 256 * 4 + h) * 256 + 4 * lane;
    const float* vb = cv + ((size_t)b * 256 * 4 + h) * 256 + 4 * lane;
#pragma unroll 1
    for (int m0 = 0; m0 < 32; m0 += 8) {
        f32x4 kr[8];
#pragma unroll
        for (int j = 0; j < 8; ++j) kr[j] = __builtin_nontemporal_load((const f32x4*)(kb + (size_t)(wave * 32 + m0 + j) * 1024));
#pragma unroll
        for (int j = 0; j < 8; ++j) {
            float d[4];
#pragma unroll
            for (int l = 0; l < 4; ++l) d[l] = wave_sum((q[l][0] * kr[j][0] + q[l][1] * kr[j][1]) + (q[l][2] * kr[j][2] + q[l][3] * kr[j][3]));
            if (lane < 4) Sc[lane * 256 + wave * 32 + m0 + j] = (lane == 0 ? d[0] : lane == 1 ? d[1] : lane == 2 ? d[2] : d[3]);
        }
    }
    WG_BAR();
    if (wave < 4) {
        constexpr float SC = 0.0625f * LOG2E;
        float s[4]; float mx = -3.0e38f;
#pragma unroll
        for (int j = 0; j < 4; ++j) { s[j] = Sc[wave * 256 + lane + 64 * j] * SC; mx = fmaxf(mx, s[j]); }
        mx = wave_max(mx); float sum = 0.f;
#pragma unroll
        for (int j = 0; j < 4; ++j) { s[j] = __builtin_amdgcn_exp2f(s[j] - mx); sum += s[j]; }
        const float inv = 1.f / wave_sum(sum);
#pragma unroll
        for (int j = 0; j < 4; ++j) PT[(lane + 64 * j) * 4 + wave] = s[j] * inv;
    }
    WG_BAR();
    f32x4 o[4];
#pragma unroll
    for (int l = 0; l < 4; ++l) o[l] = (f32x4){0.f, 0.f, 0.f, 0.f};
#pragma unroll 1
    for (int m0 = 0; m0 < 32; m0 += 8) {
        f32x4 vr[8];
#pragma unroll
        for (int j = 0; j < 8; ++j) vr[j] = __builtin_nontemporal_load((const f32x4*)(vb + (size_t)(wave * 32 + m0 + j) * 1024));
#pragma unroll
        for (int j = 0; j < 8; ++j) { const f32x4 p = *(const LAS f32x4*)(PT + (wave * 32 + m0 + j) * 4);
#pragma unroll
            for (int l = 0; l < 4; ++l) o[l] += vr[j] * p[l]; }
    }
#pragma unroll
    for (int l = 0; l < 4; ++l) *(LAS f32x4*)(Red + (wave * 4 + l) * 256 + 4 * lane) = o[l];
    WG_BAR();
#pragma unroll
    for (int e = 0; e < 2; ++e) { const int idx = tid + 512 * e, l = idx >> 8, d = idx & 255; float a = 0.f;
#pragma unroll
        for (int w = 0; w < 8; ++w) a += Red[(w * 4 + l) * 256 + d];
        OB[(size_t)(TP + b * 4 + l) * D + h * 256 + d] = (bf16_t)f2bf(a); }
    WG_BAR();
}

__device__ __forceinline__ void mem_softmax_tile(const Frame& F, const float* S, bf16_t* P) {
    const int c = F.bid, b = c >> 7, h = (c >> 5) & 3, pm = c & 31, lane = F.lane;
    const size_t base = (size_t)(b * SEQ + pm * 256 + F.wave * 32) * D + h * 256 + 4 * lane;
    constexpr float SC = 0.0625f * LOG2E;
#pragma unroll 4
    for (int r = 0; r < 32; ++r) {
        f32x4 x = *(const f32x4*)(S + base + (size_t)r * D) * SC;
        const float mx = wave_max(fmaxf(fmaxf(x[0], x[1]), fmaxf(x[2], x[3])));
        x[0] = __builtin_amdgcn_exp2f(x[0] - mx); x[1] = __builtin_amdgcn_exp2f(x[1] - mx); x[2] = __builtin_amdgcn_exp2f(x[2] - mx); x[3] = __builtin_amdgcn_exp2f(x[3] - mx);
        const float inv = 1.f / wave_sum((x[0] + x[1]) + (x[2] + x[3]));
        u32x2 w; w.x = pk2(x[0] * inv, x[1] * inv); w.y = pk2(x[2] * inv, x[3] * inv);
        *(u32x2*)(P + base + (size_t)r * D) = w;
    }
}

#define CE_DESC(a, b) { const float _hi = fmaxf(a, b), _lo = fminf(a, b); a = _hi; b = _lo; }
#define CE_ASC(a, b)  { const float _hi = fmaxf(a, b), _lo = fminf(a, b); a = _lo; b = _hi; }
template <int OFF> __device__ __forceinline__ void sort16_desc(float (&v)[64]) {
#pragma unroll
    for (int kk = 0; kk < 4; ++kk)
#pragma unroll
        for (int jj = kk; jj >= 0; --jj)
#pragma unroll
            for (int i = 0; i < 16; ++i) { const int k = 2 << kk, j = 1 << jj, l = i ^ j; if (l > i) { if ((i & k) == 0) CE_DESC(v[OFF + i], v[OFF + l]) else CE_ASC(v[OFF + i], v[OFF + l]) } }
}
__device__ __forceinline__ void merge_top16(float (&a)[16], const float (&b)[16]) {
#pragma unroll
    for (int i = 0; i < 16; ++i) a[i] = fmaxf(a[i], b[15 - i]);
#pragma unroll
    for (int jj = 3; jj >= 0; --jj)
#pragma unroll
        for (int i = 0; i < 16; ++i) { const int j = 1 << jj, l = i ^ j; if (l > i) CE_DESC(a[i], a[l]) }
}
__device__ __forceinline__ void top16_of_64(float (&v)[64], float (&out)[16]) {
    sort16_desc<0>(v); sort16_desc<16>(v); sort16_desc<32>(v); sort16_desc<48>(v);
    float b[16], c[16];
#pragma unroll
    for (int i = 0; i < 16; ++i) { out[i] = v[i]; b[i] = v[16 + i]; }
    merge_top16(out, b);
#pragma unroll
    for (int i = 0; i < 16; ++i) { c[i] = v[32 + i]; b[i] = v[48 + i]; }
    merge_top16(c, b);
    merge_top16(out, c);
}
__host__ __device__ constexpr int cand_cnt(int i) { return 16 / (i + 1); }
__host__ __device__ constexpr int cand_off(int i) { int o = 0; for (int k = 0; k < i; ++k) o += cand_cnt(k); return o; }
static_assert(cand_off(16) == 50, "50 admissible (i, j) pairs");

constexpr int RT_SKP = 136;
constexpr int RT_TBL_OFF = 2 * 128 * RT_SKP * 2;
__device__ __forceinline__ void router_phase(const Frame& F, const bf16_t* BIG, const bf16_t* SUBK  , int* EID, float* GW) {
    const int tid = F.tid, lane = F.lane, wave = F.wave;
    LAS bf16_t* SK = (LAS bf16_t*)F.lds;
    LAS unsigned char* TBL = F.lds + RT_TBL_OFF + (wave * 64 + lane) * 36;
#pragma unroll
    for (int it = 0; it < 8; ++it) { const int id = tid + 512 * it, c = id >> 11, n = (id >> 4) & 127, k16 = id & 15;
        *(LAS u32x4*)(SK + (c * 128 + n) * RT_SKP + k16 * 8) = *(const u32x4*)(SUBK + (size_t)(c * 128 + n) * 128 + k16 * 8); }
    WG_BAR();
    const int gw = F.bid * NWAVES + wave, NGW = F.G * NWAVES, r31 = lane & 31, hh = lane >> 5;
#pragma unroll 1
    for (int unit = gw; unit < (T / 32) * 4; unit += NGW) {
        const int tg = unit >> 2, hp = unit & 3, tok = tg * 32 + r31;
        float keepA[2][16], a[16], b[16];
        bf16x8 qf[8];
        { const bf16_t* qp = BIG + (size_t)tok * 2048 + (2 * hp) * 256 + 8 * hh;
#pragma unroll
          for (int s = 0; s < 8; ++s) qf[s] = *(const bf16x8*)(qp + 16 * s); }
#pragma unroll 1
        for (int p = 0; p < 4; ++p) {
            const int head = 2 * hp + (p >> 1), c = p & 1;
            float v[64];
#pragma unroll
            for (int kt = 0; kt < 4; ++kt) {
                f32x16 acc;
#pragma unroll
                for (int e = 0; e < 16; ++e) acc[e] = 0.f;
                const LAS bf16_t* kr = SK + (c * 128 + kt * 32 + r31) * RT_SKP + 8 * hh;
#pragma unroll
                for (int s = 0; s < 8; ++s) acc = __builtin_amdgcn_mfma_f32_32x32x16_bf16(*(const LAS bf16x8*)(kr + 16 * s), qf[s], acc, 0, 0, 0);
                if (kt == 3) { const int pn = (p < 3) ? p + 1 : 3; const bf16_t* qp = BIG + (size_t)tok * 2048 + (2 * hp + (pn >> 1)) * 256 + (pn & 1) * 128 + 8 * hh;
#pragma unroll
                    for (int s = 0; s < 8; ++s) qf[s] = *(const bf16x8*)(qp + 16 * s); }
#pragma unroll
                for (int e = 0; e < 16; ++e) { const unsigned key = (unsigned)(32 * kt + (e & 3) + 8 * (e >> 2)) + 4u * (unsigned)hh;
                    float x_ = acc[e]; asm volatile("" : "+v"(x_));
                    v[kt * 16 + e] = __builtin_bit_cast(float, (__builtin_bit_cast(unsigned, x_) & ~127u) | key); }
            }
            float f[16], o[16];
            top16_of_64(v, f);
#pragma unroll
            for (int i = 0; i < 16; ++i) o[i] = __shfl_xor(f[i], 32);
            merge_top16(f, o);
            if (p < 2) {
#pragma unroll
                for (int i = 0; i < 16; ++i) { if (c == 0) keepA[0][i] = f[i]; else keepA[1][i] = f[i]; }
            } else {
#pragma unroll
                for (int i = 0; i < 16; ++i) { if (c == 0) a[i] = hh ? f[i] : keepA[0][i]; else b[i] = hh ? f[i] : keepA[1][i]; }
            }
        }
        const int head = 2 * hp + hh;
        float cv[64];
#pragma unroll
        for (int i = 0; i < 16; ++i)
#pragma unroll
            for (int j = 0; j < 16; ++j) if (j < cand_cnt(i)) {
                const float s = __builtin_bit_cast(float, __builtin_bit_cast(unsigned, a[i]) & ~127u) + __builtin_bit_cast(float, __builtin_bit_cast(unsigned, b[j]) & ~127u);
                cv[cand_off(i) + j] = __builtin_bit_cast(float, (__builtin_bit_cast(unsigned, s) & ~255u) | (unsigned)(i * 16 + j)); }
#pragma unroll
        for (int n = 50; n < 64; ++n) cv[n] = -3.0e38f;
        float top[16];
        top16_of_64(cv, top);
#pragma unroll
        for (int w = 0; w < 4; ++w) {
            const unsigned wa = (__builtin_bit_cast(unsigned, a[4 * w]) & 127u) | ((__builtin_bit_cast(unsigned, a[4 * w + 1]) & 127u) << 8) | ((__builtin_bit_cast(unsigned, a[4 * w + 2]) & 127u) << 16) | ((__builtin_bit_cast(unsigned, a[4 * w + 3]) & 127u) << 24);
            const unsigned wb = (__builtin_bit_cast(unsigned, b[4 * w]) & 127u) | ((__builtin_bit_cast(unsigned, b[4 * w + 1]) & 127u) << 8) | ((__builtin_bit_cast(unsigned, b[4 * w + 2]) & 127u) << 16) | ((__builtin_bit_cast(unsigned, b[4 * w + 3]) & 127u) << 24);
            *(LAS unsigned*)(TBL + 4 * w) = wa; *(LAS unsigned*)(TBL + 16 + 4 * w) = wb; }
        LDS_WAIT();
        const float c0 = __builtin_bit_cast(float, __builtin_bit_cast(unsigned, top[0]) & ~255u);
        float e[16]; float es = 0.f; int id[16];
#pragma unroll
        for (int k = 0; k < 16; ++k) { const unsigned bits = __builtin_bit_cast(unsigned, top[k]); const float cs = __builtin_bit_cast(float, bits & ~255u);
            e[k] = __builtin_amdgcn_exp2f((cs - c0) * LOG2E); es += e[k];
            const int i1 = TBL[(bits >> 4) & 15u], i2 = TBL[16 + (bits & 15u)]; id[k] = i1 * 128 + i2; }
        const float inv = 1.f / es;
#if MK_DEBUG
        { float* dp = (float*)((unsigned char*)EID - WS_EID + WS_SP) + ((size_t)tok * 8 + head) * 48;
#pragma unroll
          for (int i = 0; i < 16; ++i) { dp[i] = a[i]; dp[16 + i] = b[i]; dp[32 + i] = top[i]; } }
#endif
        int* ep = EID + ((size_t)tok * 8 + head) * 16; float* gp = GW + ((size_t)tok * 8 + head) * 16;
#pragma unroll
        for (int k = 0; k < 16; k += 4) { *(int4*)(ep + k) = make_int4(id[k], id[k + 1], id[k + 2], id[k + 3]); *(f32x4*)(gp + k) = (f32x4){e[k] * inv, e[k + 1] * inv, e[k + 2] * inv, e[k + 3] * inv}; }
        LDS_WAIT();
    }
    WG_BAR();
}

__device__ __forceinline__ float gelu_as(float v) {
    const float av = fabsf(v), d = av * 0.2316418882f + 1.0f, t = __builtin_amdgcn_rcpf(d);
    float q = t * 0.5307027145f + (-0.7265760135f); q = q * t + 0.7107068705f; q = q * t + (-0.142248368f); q = q * t + 0.127414796f; q = q * t;
    const float e = __builtin_amdgcn_exp2f(v * v * (-0.72134752044f)), m = v * (q * e);
    return v < 0.f ? m : v - m;
}
constexpr int EX_PITCH = 1040, EX_WBYTES = 16 * EX_PITCH + 512;
__device__ __forceinline__ void expert_phase(const Frame& F, const unsigned char* PU, const unsigned char* PV  , const unsigned char* X8, const int* EID, const float* GW,
                                             const float* Xin, float* Xout, bf16_t* XB, const float* gam, const float* bet) {
    const int lane = F.lane, wave = F.wave, r15 = lane & 15, q4 = lane >> 4;
    LAS unsigned char* buf = F.lds + wave * EX_WBYTES;
    LAS float* Aw = (LAS float*)(buf + 16 * EX_PITCH);
    const int gw = F.bid * NWAVES + wave, NGW = F.G * NWAVES;
    f32x4 gv[4], bv[4];
#pragma unroll
    for (int j = 0; j < 4; ++j) { gv[j] = *(const f32x4*)(gam + 16 * lane + 4 * j); bv[j] = *(const f32x4*)(bet + 16 * lane + 4 * j); }
#pragma unroll 1
    for (int t = gw; t < T; t += NGW) {
        const int e0 = EID[(size_t)t * 128 + lane], e1 = EID[(size_t)t * 128 + 64 + lane];
        {
            u32x4 xq[16];
#pragma unroll
            for (int s = 0; s < 16; ++s) xq[s] = *(const u32x4*)(X8 + (size_t)t * D + 64 * s + 16 * q4);
#pragma unroll 1
            for (int m = 0; m < 8; ++m) {
                const int ev = (m < 4) ? e0 : e1;
#pragma unroll
                for (int r = 0; r < 16; ++r) { const int j = __builtin_amdgcn_readlane(ev, ((m & 3) << 4) + r);
                    __builtin_amdgcn_global_load_lds((const unsigned*)(PU + (size_t)j * D + 16 * lane), (LAS unsigned*)(buf + r * EX_PITCH), 16, 0, 0); }
                const f32x4 gq = *(const f32x4*)(GW + (size_t)t * 128 + 16 * m + 4 * q4);
                VM_WAIT();
                f32x4 acc = (f32x4){0.f, 0.f, 0.f, 0.f};
#pragma unroll
                for (int s = 0; s < 16; ++s) { const u32x4 av = *(const LAS u32x4*)(buf + r15 * EX_PITCH + 64 * s + 16 * q4);
                    const long alo = (long)(((unsigned long long)av.y << 32) | av.x), ahi = (long)(((unsigned long long)av.w << 32) | av.z);
                    const long xlo = (long)(((unsigned long long)xq[s].y << 32) | xq[s].x), xhi = (long)(((unsigned long long)xq[s].w << 32) | xq[s].z);
                    acc = __builtin_amdgcn_mfma_f32_16x16x32_fp8_fp8(alo, xlo, acc, 0, 0, 0);
                    acc = __builtin_amdgcn_mfma_f32_16x16x32_fp8_fp8(ahi, xhi, acc, 0, 0, 0); }
                f32x4 av4;
#pragma unroll
                for (int r = 0; r < 4; ++r) av4[r] = gelu_as(acc[r] * (1.f / U_SCALE)) * gq[r] * (1.f / V_SCALE);
                if (r15 == 0) *(LAS f32x4*)(Aw + 16 * m + 4 * q4) = av4;
                LDS_WAIT();
            }
        }
        float f[16];
#pragma unroll
        for (int i = 0; i < 16; ++i) f[i] = 0.f;
#pragma unroll 1
        for (int j0 = 0; j0 < 128; j0 += 8) {
            const int ev = (j0 < 64) ? e0 : e1;
            u32x4 vr[8];
#pragma unroll
            for (int jj = 0; jj < 8; ++jj) { const int j = __builtin_amdgcn_readlane(ev, (j0 & 63) + jj); vr[jj] = *(const u32x4*)(PV + (size_t)j * D + 16 * lane); }
            const f32x4 a0 = *(const LAS f32x4*)(Aw + j0), a1 = *(const LAS f32x4*)(Aw + j0 + 4);
#pragma unroll
            for (int jj = 0; jj < 8; ++jj) { const float aj = jj < 4 ? a0[jj] : a1[jj - 4];
#pragma unroll
                for (int w = 0; w < 4; ++w) { const f32x2 lo = __builtin_amdgcn_cvt_pk_f32_fp8((int)vr[jj][w], false), hi = __builtin_amdgcn_cvt_pk_f32_fp8((int)vr[jj][w], true);
                    f[4 * w] += aj * lo.x; f[4 * w + 1] += aj * lo.y; f[4 * w + 2] += aj * hi.x; f[4 * w + 3] += aj * hi.y; } }
        }
        f32x4 v[4]; float s = 0.f;
#pragma unroll
        for (int j = 0; j < 4; ++j) { const f32x4 x = *(const f32x4*)(Xin + (size_t)t * D + 16 * lane + 4 * j); v[j] = x * DN_ALPHA + (f32x4){f[4 * j], f[4 * j + 1], f[4 * j + 2], f[4 * j + 3]}; s += (v[j][0] + v[j][1]) + (v[j][2] + v[j][3]); }
        const float mean = wave_sum(s) * (1.f / D); float s2 = 0.f;
#pragma unroll
        for (int j = 0; j < 4; ++j) { v[j] = v[j] - mean; s2 += (v[j][0] * v[j][0] + v[j][1] * v[j][1]) + (v[j][2] * v[j][2] + v[j][3] * v[j][3]); }
        const float rstd = 1.f / sqrtf(wave_sum(s2) * (1.f / D) + LN_EPS);
        u32x4 w0, w1;
#pragma unroll
        for (int j = 0; j < 4; ++j) { const f32x4 y = v[j] * rstd * gv[j] + bv[j]; *(f32x4*)(Xout + (size_t)t * D + 16 * lane + 4 * j) = y;
            const unsigned p0 = pk2(y[0], y[1]), p1 = pk2(y[2], y[3]);
            if (j == 0) { w0.x = p0; w0.y = p1; } else if (j == 1) { w0.z = p0; w0.w = p1; } else if (j == 2) { w1.x = p0; w1.y = p1; } else { w1.z = p0; w1.w = p1; } }
        *(u32x4*)(XB + (size_t)t * D + 16 * lane) = w0; *(u32x4*)(XB + (size_t)t * D + 16 * lane + 8) = w1;
        LDS_WAIT();
    }
}

__device__ __forceinline__ void dec16(const u32x4 w, float (&o)[16]) {
#pragma unroll
    for (int q = 0; q < 4; ++q) { const f32x2 lo = __builtin_amdgcn_cvt_pk_f32_fp8((int)w[q], false), hi = __builtin_amdgcn_cvt_pk_f32_fp8((int)w[q], true); o[4 * q] = lo.x; o[4 * q + 1] = lo.y; o[4 * q + 2] = hi.x; o[4 * q + 3] = hi.y; }
}
template <int CTRL> __device__ __forceinline__ float dpp_f(float v) { return __builtin_bit_cast(float, __builtin_amdgcn_update_dpp(0, __builtin_bit_cast(int, v), CTRL, 0xF, 0xF, true)); }
__device__ __forceinline__ float sum8(float p) { p += dpp_f<0xB1>(p); p += dpp_f<0x4E>(p); p += dpp_f<0x141>(p); return p; }
#define EXC_ROWS(R, elo, ehi, TAB) do { _Pragma("unroll") for (int i_ = 0; i_ < 16; ++i_) { const int idx_ = 8 * i_ + r8; int e_ = __shfl(idx_ < 64 ? elo : ehi, idx_ & 63); if (EMASK != 0x3fff) e_ &= EMASK; \
        R[i_] = *(const u32x4*)((TAB) + ((unsigned)e_ * 1024u + (unsigned)cofs)); } } while (0)
#define U_TOK(i) (t0 + ((i) < nit ? (i) : nit - 1) * tstep)
constexpr float PH_SCALE = 0.25f;
typedef _Float16 h16x2 __attribute__((ext_vector_type(2)));
template <int EMASK = 0x3fff> __device__ __forceinline__ void expert_u_phase(const Frame& F, const unsigned char* PU, const unsigned char* X8, const int* EID, unsigned* PH) {
    const int lane = F.lane, c = lane & 7, r8 = lane >> 3, x = F.bid & 7, cofs = 128 * x + 16 * c;
    const int t0 = (F.bid >> 3) * NWAVES + F.wave, tstep = (F.G >> 3) * NWAVES, nit = (T - t0 + tstep - 1) / tstep;
#define U_COMPUTE(R, xs, tt, valid) do { int p_[16]; \
        _Pragma("unroll") for (int i_ = 0; i_ < 16; ++i_) { int d_ = __builtin_amdgcn_sdot4((int)R[i_][0], (int)xs[0], 0, false); d_ = __builtin_amdgcn_sdot4((int)R[i_][1], (int)xs[1], d_, false); \
            d_ = __builtin_amdgcn_sdot4((int)R[i_][2], (int)xs[2], d_, false); p_[i_] = __builtin_amdgcn_sdot4((int)R[i_][3], (int)xs[3], d_, false); } \
          \
        int q_[8], r_[4], s_[2]; \
        _Pragma("unroll") for (int i_ = 0; i_ < 8; ++i_) { const int keep_ = (c < 4) ? p_[i_] : p_[i_ + 8], send_ = (c < 4) ? p_[i_ + 8] : p_[i_]; q_[i_] = keep_ + __builtin_amdgcn_update_dpp(0, send_, 0x141, 0xF, 0xF, true); } \
        _Pragma("unroll") for (int i_ = 0; i_ < 4; ++i_) { const int keep_ = ((c & 2) == 0) ? q_[i_] : q_[i_ + 4], send_ = ((c & 2) == 0) ? q_[i_ + 4] : q_[i_]; r_[i_] = keep_ + __builtin_amdgcn_update_dpp(0, send_, 0x4E, 0xF, 0xF, true); } \
        _Pragma("unroll") for (int i_ = 0; i_ < 2; ++i_) { const int keep_ = ((c & 1) == 0) ? r_[i_] : r_[i_ + 2], send_ = ((c & 1) == 0) ? r_[i_ + 2] : r_[i_]; s_[i_] = keep_ + __builtin_amdgcn_update_dpp(0, send_, 0xB1, 0xF, 0xF, true); } \
        if (valid) PH[((size_t)(tt) * 8 + x) * 64 + lane] = __builtin_bit_cast(unsigned, __builtin_amdgcn_cvt_pkrtz((float)s_[0] * PH_SCALE, (float)s_[1] * PH_SCALE)); } while (0)
    if (nit <= 0) return;
    int ealo = EID[(size_t)U_TOK(0) * 128 + lane], eahi = EID[(size_t)U_TOK(0) * 128 + 64 + lane]; u32x4 xa = *(const u32x4*)(X8 + (size_t)U_TOK(0) * D + cofs);
    int eblo = EID[(size_t)U_TOK(1) * 128 + lane], ebhi = EID[(size_t)U_TOK(1) * 128 + 64 + lane]; u32x4 xb = *(const u32x4*)(X8 + (size_t)U_TOK(1) * D + cofs);
    u32x4 Ra[16], Rb[16];
    EXC_ROWS(Ra, ealo, eahi, PU);
#pragma unroll 1
    for (int i = 0; i < nit; i += 2) {
        EXC_ROWS(Rb, eblo, ebhi, PU);
        const int tn = U_TOK(i + 2); const int enlo = EID[(size_t)tn * 128 + lane], enhi = EID[(size_t)tn * 128 + 64 + lane]; const u32x4 xn = *(const u32x4*)(X8 + (size_t)tn * D + cofs);
        U_COMPUTE(Ra, xa, U_TOK(i), true);
        EXC_ROWS(Ra, enlo, enhi, PU);
        const int tm = U_TOK(i + 3); const int emlo = EID[(size_t)tm * 128 + lane], emhi = EID[(size_t)tm * 128 + 64 + lane]; const u32x4 xm = *(const u32x4*)(X8 + (size_t)tm * D + cofs);
        U_COMPUTE(Rb, xb, U_TOK(i + 1), (i + 1 < nit));
        xa = xn; eblo = emlo; ebhi = emhi; xb = xm;
    }
#undef U_COMPUTE
}
__device__ __forceinline__ void expert_a_phase(const Frame& F, const unsigned* PH, const float* GW, unsigned* AW) {
    const int gw = F.bid * NWAVES + F.wave, NGW = F.G * NWAVES, lane = F.lane, e0 = 16 * (lane & 7) + (lane >> 3), e1 = e0 + 8;
#pragma unroll 1
    for (int t = gw; t < T; t += 2 * NGW) {
        const int tb = (t + NGW < T) ? t + NGW : t;
        unsigned wa[8], wb[8];
#pragma unroll
        for (int xx = 0; xx < 8; ++xx) { wa[xx] = PH[((size_t)t * 8 + xx) * 64 + lane]; wb[xx] = PH[((size_t)tb * 8 + xx) * 64 + lane]; }
        const float ga0 = GW[(size_t)t * 128 + e0], ga1 = GW[(size_t)t * 128 + e1], gb0 = GW[(size_t)tb * 128 + e0], gb1 = GW[(size_t)tb * 128 + e1];
        float sa0 = 0.f, sa1 = 0.f, sb0 = 0.f, sb1 = 0.f;
#pragma unroll
        for (int xx = 0; xx < 8; ++xx) { const h16x2 ha = __builtin_bit_cast(h16x2, wa[xx]), hb = __builtin_bit_cast(h16x2, wb[xx]); sa0 += (float)ha[0]; sa1 += (float)ha[1]; sb0 += (float)hb[0]; sb1 += (float)hb[1]; }
#define A_PACK(s_, g_) ({ const float a_ = gelu_as((s_) * (1.f / (PH_SCALE * SU8 * SX8))) * (g_); __builtin_bit_cast(unsigned, __builtin_amdgcn_cvt_pkrtz(a_, a_)); })
        AW[(size_t)t * 128 + e0] = A_PACK(sa0, ga0);
        AW[(size_t)t * 128 + e1] = A_PACK(sa1, ga1);
        if (tb != t) { AW[(size_t)tb * 128 + e0] = A_PACK(sb0, gb0); AW[(size_t)tb * 128 + e1] = A_PACK(sb1, gb1); }
#undef A_PACK
    }
}
__device__ __forceinline__ void expert_v_phase(const Frame& F, const unsigned char* PV, const int* EID, const unsigned* AW, bf16_t* FH) {
    const int lane = F.lane, c = lane & 7, r8 = lane >> 3, x = F.bid & 7, cofs = 128 * x + 16 * c;
    const int t0 = (F.bid >> 3) * NWAVES + F.wave, tstep = (F.G >> 3) * NWAVES, nit = (T - t0 + tstep - 1) / tstep;
#define VH_ROWS(R, ev) do { _Pragma("unroll") for (int i_ = 0; i_ < 8; ++i_) { const int e_ = __shfl(ev, 8 * i_ + r8); R[i_] = *(const u32x4*)(PV + ((unsigned)e_ * 1024u + (unsigned)cofs)); } } while (0)
#define VH_FMA(R, av) do { _Pragma("unroll") for (int i_ = 0; i_ < 8; ++i_) { const h16x2 a2_ = __builtin_bit_cast(h16x2, __shfl((int)av, 8 * i_ + r8)); \
            _Pragma("unroll") for (int q_ = 0; q_ < 4; ++q_) { const h16x2 lo_ = __builtin_amdgcn_cvt_scalef32_pk_f16_fp8((int)R[i_][q_], 1.f / V_SCALE, false), hi_ = __builtin_amdgcn_cvt_scalef32_pk_f16_fp8((int)R[i_][q_], 1.f / V_SCALE, true); \
                acc2[2 * q_] = __builtin_elementwise_fma(lo_, a2_, acc2[2 * q_]); acc2[2 * q_ + 1] = __builtin_elementwise_fma(hi_, a2_, acc2[2 * q_ + 1]); } } } while (0)
    if (nit <= 0) return;
#define V_META(t_, lo_, hi_, al_, ah_) do { lo_ = EID[(size_t)(t_) * 128 + lane]; hi_ = EID[(size_t)(t_) * 128 + 64 + lane]; al_ = AW[(size_t)(t_) * 128 + lane]; ah_ = AW[(size_t)(t_) * 128 + 64 + lane]; } while (0)
#define V_FIN(tt, valid) do { h16x2 q[4], rr[2], ss; \
        _Pragma("unroll") for (int e = 0; e < 4; ++e) { const h16x2 keep = (lane < 32) ? acc2[e] : acc2[e + 4], send = (lane < 32) ? acc2[e + 4] : acc2[e]; q[e] = keep + __builtin_bit_cast(h16x2, __shfl_xor(__builtin_bit_cast(int, send), 32)); } \
        _Pragma("unroll") for (int e = 0; e < 2; ++e) { const h16x2 keep = ((lane & 16) == 0) ? q[e] : q[e + 2], send = ((lane & 16) == 0) ? q[e + 2] : q[e]; rr[e] = keep + __builtin_bit_cast(h16x2, __shfl_xor(__builtin_bit_cast(int, send), 16)); } \
        { const h16x2 keep = ((lane & 8) == 0) ? rr[0] : rr[1], send = ((lane & 8) == 0) ? rr[1] : rr[0]; \
          ss = keep + __builtin_bit_cast(h16x2, __builtin_amdgcn_update_dpp(0, __builtin_bit_cast(int, send), 0x128, 0xF, 0xF, true)); } \
        if (valid) { const int colb = 8 * (lane >> 5) + 4 * ((lane >> 4) & 1) + 2 * ((lane >> 3) & 1); *(unsigned*)(FH + (size_t)(tt) * D + cofs + colb) = pk2((float)ss[0], (float)ss[1]); } } while (0)
#define V_ZERO() do { _Pragma("unroll") for (int e = 0; e < 8; ++e) acc2[e] = (h16x2){(_Float16)0.f, (_Float16)0.f}; } while (0)
    int ealo, eahi, eblo, ebhi, enlo, enhi, emlo, emhi; unsigned aalo, aahi, ablo, abhi, anlo, anhi, amlo, amhi;
    V_META(U_TOK(0), ealo, eahi, aalo, aahi); V_META(U_TOK(1), eblo, ebhi, ablo, abhi); V_META(U_TOK(2), enlo, enhi, anlo, anhi); V_META(U_TOK(3), emlo, emhi, amlo, amhi);
    u32x4 Ra[16], Rb[16];
    VH_ROWS(Ra, ealo); VH_ROWS((Ra + 8), eahi);
#pragma unroll 1
    for (int i = 0; i < nit; i += 2) {
        int eplo, ephi, eqlo, eqhi; unsigned aplo, aphi, aqlo, aqhi;
        V_META(U_TOK(i + 4), eplo, ephi, aplo, aphi); V_META(U_TOK(i + 5), eqlo, eqhi, aqlo, aqhi);
        VH_ROWS(Rb, eblo); VH_ROWS((Rb + 8), ebhi);
        h16x2 acc2[8];
        V_ZERO(); VH_FMA(Ra, aalo); VH_FMA((Ra + 8), aahi); V_FIN(U_TOK(i), true);
        VH_ROWS(Ra, enlo); VH_ROWS((Ra + 8), enhi);
        V_ZERO(); VH_FMA(Rb, ablo); VH_FMA((Rb + 8), abhi); V_FIN(U_TOK(i + 1), (i + 1 < nit));
        aalo = anlo; aahi = anhi; eblo = emlo; ebhi = emhi; ablo = amlo; abhi = amhi;
        enlo = eplo; enhi = ephi; anlo = aplo; anhi = aphi; emlo = eqlo; emhi = eqhi; amlo = aqlo; amhi = aqhi;
    }
#undef V_META
#undef V_FIN
#undef V_ZERO
#undef VH_ROWS
#undef VH_FMA
}
#undef U_TOK
#undef EXC_ROWS

constexpr int PH_PER_LAYER = 16, N_PHASES = 1 + NLAYER * PH_PER_LAYER;
__global__ void __launch_bounds__(NTHREADS, 2) mega_fwd(Args args) {
    extern __shared__ __attribute__((aligned(16))) unsigned char lds_raw[];
    Frame F; F.lds = (LAS unsigned char*)lds_raw; F.tid = threadIdx.x; F.lane = F.tid & 63; F.wave = __builtin_amdgcn_readfirstlane(F.tid >> 6); F.G = gridDim.x; F.bid = blockIdx.x;
    int wave_s = __builtin_amdgcn_readfirstlane((int)threadIdx.x >> 6); asm volatile("" : "+s"(wave_s));
#define FRESH() do { int t_; asm volatile("v_mbcnt_lo_u32_b32 %0, -1, 0\n\tv_mbcnt_hi_u32_b32 %0, -1, %0\n\tv_lshl_add_u32 %0, %1, 6, %0" : "=&v"(t_) : "s"(wave_s));     F.tid = t_; F.lane = t_ & 63; F.wave = __builtin_amdgcn_readfirstlane(t_ >> 6); { GAS unsigned char* wsg_ = (GAS unsigned char*)args.ws; asm volatile("" : "+s"(wsg_)); ws = (unsigned char*)wsg_; } { LAS unsigned char* l_ = (LAS unsigned char*)lds_raw; asm volatile("" : "+s"(l_)); F.lds = l_; } } while (0)
    unsigned char* ws = args.ws;
#define DUPN(bit) ((MK_DUP & (bit)) ? 2 : 1)
#define XDUM ((float*)(ws + WS_END))
#define XBDUM ((bf16_t*)(ws + WS_END + 70 * MiB))
#define X8DUM (ws + WS_END + 110 * MiB)
    volatile LAS unsigned* MISC = (volatile LAS unsigned*)(F.lds + MISC_OFF);
    for (int u = F.tid; u < (LDS_BYTES - MISC_OFF) / 4; u += NTHREADS) MISC[u] = 0u;
    __syncthreads();
    unsigned* ctl = (unsigned*)(args.ws + WS_CTL);
    XcdBarrier bar; bar.bar = ctl + CW_BAR; bar.x = 0; bar.st = nullptr;
    if (!MK_PER_PHASE) bar = xcd_barrier_post(ctl + CW_BAR, MISC + 8);
    const int lo = args.ph_lo, hi = args.ph_hi;
#define IN(k) (lo <= (k) && (k) < hi)
#define SEAM(k) do { if (IN(k) && IN((k) + 1)) { XcdBarrier b_ = bar; { GAS unsigned* bp_ = (GAS unsigned*)bar.bar; asm volatile("" : "+s"(bp_), "+s"(b_.x)); b_.bar = (unsigned*)bp_; } xcd_barrier(b_); if (MK_DUP & 32) xcd_barrier(b_); } } while (0)
#define XB ((bf16_t*)(ws + WS_XB))
#define BIG ((bf16_t*)(ws + WS_BIG))
#define OB ((bf16_t*)(ws + WS_OB))
#define SP ((bf16_t*)(ws + WS_SP))
#define X ((float*)(ws + WS_X))
#define FB ((float*)(ws + WS_F))
#define FBH ((bf16_t*)(ws + WS_F))
#define MK ((bf16_t*)(ws + WS_MK))
#define MVT ((bf16_t*)(ws + WS_MVT))
#define EID ((int*)(ws + WS_EID))
#define GW ((float*)(ws + WS_GW))
#define X8 (ws + WS_X8)
    float* out = args.out;
    const float* ln_g = args.in[21]; const float* ln_b = args.in[22];

#if MK_STAMP
    unsigned long long* stp = (unsigned long long*)(ctl + 32768);
    if (blockIdx.x == 0 && threadIdx.x == 0) stp[0] = __builtin_amdgcn_s_memrealtime();
#define STAMP(k) do { if (blockIdx.x == 0 && threadIdx.x == 0) stp[(k) + 1] = __builtin_amdgcn_s_memrealtime(); } while (0)
#else
#define STAMP(k) do { } while (0)
#endif
    if (IN(0)) { FRESH(); for (int dd = 0; dd < DUPN(16); ++dd) p0_prologue(F, args); }
    SEAM(0); STAMP(0);

#pragma unroll 1
    for (int layer = 0; layer < NLAYER; ++layer) {
        const int pb = 1 + layer * PH_PER_LAYER, jj = layer >> 1;
        const bool first = (layer == 0);
        if ((layer & 1) == 0) {
            if (IN(pb + 0)) { FRESH();
                if (first) {
                    pg8::Gemm g{(const bf16_t*)(ws + WS_MEMB), (const bf16_t*)(ws + WS_WMKV), 1024, 1024, 1024}; pg8::MemKVSched S{F.bid, 192};
                    pg8::EpiMemKV E{out + O_MKP, out + O_MVP, MK, MVT};
                    pg8::gemm_phase<pg8::EpiMemKV, pg8::MemKVSched, true>(F.lds, F.tid, g, S, E);
                }
                pg8::Gemm g{XB, (const bf16_t*)(ws + WS_WQKV) + (size_t)jj * QKVW * D, 1024, 1024, 1024}; pg8::PlainSched S; S.init(T, QKVW, 1024, 1024, F.G, F.bid);
                pg8::EpiBf16 E{BIG, QKVW};
                pg8::gemm_phase<pg8::EpiBf16, pg8::PlainSched, true>(F.lds, F.tid, g, S, E);
            }
            SEAM(pb + 0); STAMP(pb + 0);
            if (IN(pb + 1)) { FRESH();
                const float* sinks = args.in[9] + jj * 16;
                for (int u = F.bid; u < 512; u += F.G) attn_prompt_unit(F, BIG, OB, sinks, out + O_WKP + (size_t)jj * 65536, out + O_WVP + (size_t)jj * 65536, u);
                for (int u = F.bid; u < 512; u += F.G) attn_sample_unit(F, BIG, OB, sinks, args.in[2] + (size_t)jj * 4194304, args.in[3] + (size_t)jj * 4194304,
                                                                        out + O_WKS + (size_t)jj * 4194304, out + O_WVS + (size_t)jj * 4194304, u);
            }
            SEAM(pb + 1); STAMP(pb + 1);
            if (IN(pb + 2)) { FRESH();
                pg8::Gemm g{OB, (const bf16_t*)(ws + WS_WO) + (size_t)jj * D * D, 1024, 1024, 1024}; pg8::PlainSched S; S.init(TP, D, 1024, 1024, F.G, F.bid);
                pg8::EpiBf16 E{FBH, D};
                pg8::gemm_phase<pg8::EpiBf16, pg8::PlainSched, true>(F.lds, F.tid, g, S, E);
                mini_gemm<1024>(F, OB + (size_t)TP * D, (const bf16_t*)(ws + WS_WO) + (size_t)jj * D * D, FBH + (size_t)TP * D, D);
            }
            SEAM(pb + 2); STAMP(pb + 2);
        } else {
            if (IN(pb + 0)) { FRESH();
                pg8::Gemm g{XB, (const bf16_t*)(ws + WS_WIN) + (size_t)jj * 3072 * D, 1024, 1024, 1024}; pg8::PlainSched S; S.init(TP, 3072, 1024, 1024, F.G, F.bid);
                pg8::EpiBf16 E{BIG, 3072};
                pg8::gemm_phase<pg8::EpiBf16, pg8::PlainSched, true>(F.lds, F.tid, g, S, E);
                mini_gemm<3072>(F, XB + (size_t)TP * D, (const bf16_t*)(ws + WS_WIN) + (size_t)jj * 3072 * D, BIG + (size_t)TP * 3072, 3072);
            }
            SEAM(pb + 0); STAMP(pb + 0);
            if (IN(pb + 1)) FRESH(); if (IN(pb + 1)) for (int dd = 0; dd < DUPN(1024); ++dd) conv_phase(F, BIG, OB, args.in[12] + (size_t)jj * 3 * D, args.in[4] + (size_t)jj * DBATCH * 2 * D, out + O_CVP + (size_t)jj * 4096, out + O_CVS + (size_t)jj * DBATCH * 2 * D);
            SEAM(pb + 1); STAMP(pb + 1);
            if (IN(pb + 2)) { FRESH();
                pg8::Gemm g{OB, (const bf16_t*)(ws + WS_WOUT) + (size_t)jj * D * D, 1024, 1024, 1024}; pg8::PlainSched S; S.init(TP, D, 1024, 1024, F.G, F.bid);
                pg8::EpiBf16 E{FBH, D};
                pg8::gemm_phase<pg8::EpiBf16, pg8::PlainSched, true>(F.lds, F.tid, g, S, E);
                mini_gemm<1024>(F, OB + (size_t)TP * D, (const bf16_t*)(ws + WS_WOUT) + (size_t)jj * D * D, FBH + (size_t)TP * D, D);
            }
            SEAM(pb + 2); STAMP(pb + 2);
        }
        if (IN(pb + 3)) { FRESH(); if (first) ln_phase<true>(F, args.in[0], args.in[1], XB, FBH, ln_g + (size_t)(layer * 3 + 0) * D, ln_b + (size_t)(layer * 3 + 0) * D, XB, nullptr, nullptr);
                          else ln_phase<false>(F, nullptr, nullptr, XB, FBH, ln_g + (size_t)(layer * 3 + 0) * D, ln_b + (size_t)(layer * 3 + 0) * D, XB, nullptr, nullptr); }
        if ((MK_DUP & 8) && IN(pb + 3)) ln_phase<false>(F, nullptr, nullptr, XB, FBH, ln_g + (size_t)(layer * 3 + 0) * D, ln_b + (size_t)(layer * 3 + 0) * D, XBDUM, nullptr, nullptr);
        SEAM(pb + 3); STAMP(pb + 3);
        if (IN(pb + 4)) { FRESH();
            pg8::Gemm g{XB, (const bf16_t*)(ws + WS_WMQ) + (size_t)layer * D * D, 1024, 1024, 1024}; pg8::PlainSched S; S.init(TP, D, 1024, 1024, F.G, F.bid);
            pg8::EpiBf16 E{BIG, D};
            pg8::gemm_phase<pg8::EpiBf16, pg8::PlainSched, true>(F.lds, F.tid, g, S, E);
            mini_gemm<1024>(F, XB + (size_t)TP * D, (const bf16_t*)(ws + WS_WMQ) + (size_t)layer * D * D, BIG + (size_t)TP * D, D);
        }
        SEAM(pb + 4); STAMP(pb + 4);
        if (IN(pb + 5)) { FRESH();
          if (F.bid & 1) { for (int u = F.bid; u < 512; u += F.G) mem_sample_unit(F, BIG, OB, args.in[5] + (size_t)layer * 33554432, args.in[6] + (size_t)layer * 33554432, u); }
          {
            {
                pg8::Gemm g{BIG, MK, 1024, 1024, 256}; pg8::MemSSched S{F.bid, layer};
                pg8::EpiExp E{SP, D, 0.0625f * LOG2E, (LAS float*)(F.lds + pg8::STAGE_BYTES)};
                pg8::gemm_phase<pg8::EpiExp, pg8::MemSSched, true>(F.lds, F.tid, g, S, E);
            }
            WG_BAR();
            {
                pg8::Gemm g2{SP, MVT, 1024, 512, 256}; pg8::MemPVSched S2{F.bid, layer};
                pg8::EpiBf16Scale E2{OB, D, (const LAS float*)(F.lds + pg8::STAGE_BYTES)};
                pg8::gemm_phase<pg8::EpiBf16Scale, pg8::MemPVSched, true>(F.lds, F.tid, g2, S2, E2);
            }
            WG_BAR();
          }
          if (!(F.bid & 1)) { for (int u = F.bid; u < 512; u += F.G) mem_sample_unit(F, BIG, OB, args.in[5] + (size_t)layer * 33554432, args.in[6] + (size_t)layer * 33554432, u); }
        }
        SEAM(pb + 5); STAMP(pb + 5);
        if (IN(pb + 7)) { FRESH();
            pg8::Gemm g{OB, (const bf16_t*)(ws + WS_WMO) + (size_t)layer * D * D, 1024, 1024, 1024}; pg8::PlainSched S; S.init(TP, D, 1024, 1024, F.G, F.bid);
            pg8::EpiBf16 E{FBH, D};
            pg8::gemm_phase<pg8::EpiBf16, pg8::PlainSched, true>(F.lds, F.tid, g, S, E);
            mini_gemm<1024>(F, OB + (size_t)TP * D, (const bf16_t*)(ws + WS_WMO) + (size_t)layer * D * D, FBH + (size_t)TP * D, D);
        }
        SEAM(pb + 7); STAMP(pb + 7);
        if (IN(pb + 8)) FRESH(); if (IN(pb + 8)) ln_phase<false>(F, nullptr, nullptr, XB, FBH, ln_g + (size_t)(layer * 3 + 1) * D, ln_b + (size_t)(layer * 3 + 1) * D, XB, X8, nullptr);
        if ((MK_DUP & 8) && IN(pb + 8)) ln_phase<false>(F, nullptr, nullptr, XB, FBH, ln_g + (size_t)(layer * 3 + 1) * D, ln_b + (size_t)(layer * 3 + 1) * D, XBDUM, X8DUM, nullptr);
        SEAM(pb + 8); STAMP(pb + 8);
        if (IN(pb + 9)) { FRESH();
            pg8::Gemm g{XB, (const bf16_t*)(ws + WS_WPQ) + (size_t)layer * 2048 * D, 1024, 1024, 1024}; pg8::PlainSched S; S.init(TP, 2048, 1024, 1024, F.G, F.bid);
            pg8::EpiBf16 E{BIG, 2048};
            pg8::gemm_phase<pg8::EpiBf16, pg8::PlainSched, true>(F.lds, F.tid, g, S, E);
            mini_gemm<2048>(F, XB + (size_t)TP * D, (const bf16_t*)(ws + WS_WPQ) + (size_t)layer * 2048 * D, BIG + (size_t)TP * 2048, 2048);
        }
        SEAM(pb + 9); STAMP(pb + 9);
        if (IN(pb + 10)) FRESH();
        if (IN(pb + 10) && (F.bid & 1)) { cvt_tables_part(F, args, ws, layer, 0); cvt_tables_part(F, args, ws, layer, 1); cvt_tables_part(F, args, ws, layer, 2); }
        if (IN(pb + 10)) for (int dd = 0; dd < DUPN(4096); ++dd) router_phase(F, BIG, (const bf16_t*)(ws + WS_SUBK) + (size_t)layer * 2 * 128 * 128, EID, GW);
        if (IN(pb + 10) && !(F.bid & 1)) { cvt_tables_part(F, args, ws, layer, 0); cvt_tables_part(F, args, ws, layer, 1); cvt_tables_part(F, args, ws, layer, 2); }
        SEAM(pb + 10); STAMP(pb + 10);
        if (IN(pb + 11)) { FRESH(); for (int dd = 0; dd < DUPN(128); ++dd) expert_u_phase(F, ws + WS_PU8 + (size_t)layer * NEXP * D, X8, EID, (unsigned*)BIG); }
                if ((MK_DUP & 512) && IN(pb + 11)) expert_u_phase<0xff>(F, ws + WS_PU8 + (size_t)layer * NEXP * D, X8, EID, (unsigned*)(ws + WS_END));
        SEAM(pb + 11); STAMP(pb + 11);
        if (IN(pb + 12)) { FRESH(); expert_a_phase(F, (const unsigned*)BIG, GW, (unsigned*)(ws + WS_AW)); }
        SEAM(pb + 12); STAMP(pb + 12);
        if (IN(pb + 13)) { FRESH(); for (int dd = 0; dd < DUPN(256); ++dd) expert_v_phase(F, ws + WS_PV8 + (size_t)layer * NEXP * D, EID, (const unsigned*)(ws + WS_AW), FBH); }
        SEAM(pb + 13); STAMP(pb + 13);
        if (IN(pb + 14)) FRESH(); if (IN(pb + 14)) ln_phase<false>(F, nullptr, nullptr, XB, FBH, ln_g + (size_t)(layer * 3 + 2) * D, ln_b + (size_t)(layer * 3 + 2) * D, XB, nullptr, (layer == NLAYER - 1) ? out : nullptr);
        SEAM(pb + 14); STAMP(pb + 14);
    }
#if MK_STAMP
    if (blockIdx.x == 0 && threadIdx.x == 0) {
        unsigned long long ta = 0, tb = 0;
        for (int L = 0; L < NLAYER; ++L) { const int pbx = 1 + L * PH_PER_LAYER;
            if (MK_SEL_A >= 1) ta += stp[pbx + MK_SEL_A - 1 + 1] - stp[pbx + MK_SEL_A - 1];
            if (MK_SEL_B >= 1) tb += stp[pbx + MK_SEL_B - 1 + 1] - stp[pbx + MK_SEL_B - 1]; }
        if (MK_SEL_A == 0) ta = stp[1] - stp[0];
        if (MK_SEL_B == 0) tb = stp[1] - stp[0];
        if (MK_SEL_A == 99) ta = stp[1 + (NLAYER - 1) * PH_PER_LAYER + 15] - stp[0];
        args.out[0] = 10.f * (float)(ta + tb);
        args.out[O_CVP] = 10.f * (float)tb;
    }
#endif
#undef IN
#undef SEAM
#undef XB
#undef BIG
#undef OB
#undef SP
#undef X
#undef FB
#undef FBH
#undef MK
#undef MVT
#undef EID
#undef GW
#undef X8
}


#if MK_DEBUG
__device__ __forceinline__ void dbg_fail(unsigned* ew, unsigned code) { atomicMax(ew, 100u - code); }
__device__ __forceinline__ bool dbg_close(float got, float ref, float rtol, float atol) { return (got == got) && fabsf(got - ref) <= atol + rtol * fabsf(ref); }
__device__ __forceinline__ unsigned dbg_hash(unsigned x) { x ^= x >> 16; x *= 0x7feb352du; x ^= x >> 15; x *= 0x846ca68bu; x ^= x >> 16; return x; }
__device__ __forceinline__ float dbg_fp8(const unsigned char* p, size_t i) { const unsigned w = (unsigned)p[i]; return __builtin_amdgcn_cvt_f32_fp8((int)w, 0); }

__global__ void chk_gemm(const bf16_t* A, int lda, const bf16_t* Bt, int ldb, int K, int M, int N, const void* outp, int ldc, int f32out, unsigned* ew, unsigned code) {
    const unsigned id = blockIdx.x * 256 + threadIdx.x; const unsigned h1 = dbg_hash(id * 2u + 1u), h2 = dbg_hash(id * 2u + 7777u);
    int r = (int)(h1 % (unsigned)M), c = (int)(h2 % (unsigned)N);
    if ((id & 7) == 0) r = M - 1 - (int)(h1 % 300u) % M; if ((id & 7) == 1) r = (int)(h1 % 5u); if ((id & 15) == 2) c = N - 1 - (int)(h2 % 9u);
    float s = 0.f; for (int k = 0; k < K; ++k) s += bf2f(A[(size_t)r * lda + k]) * bf2f(Bt[(size_t)c * ldb + k]);
    const float got = f32out ? ((const float*)outp)[(size_t)r * ldc + c] : bf2f(((const bf16_t*)outp)[(size_t)r * ldc + c]);
    if (!dbg_close(got, s, 0.02f, 0.03f)) dbg_fail(ew, code);
}
__global__ void chk_transposed(const float* W, int N, const bf16_t* WT, unsigned* ew, unsigned code) {
    const unsigned id = blockIdx.x * 256 + threadIdx.x; const int k = (int)(dbg_hash(id) % 1024u), n = (int)(dbg_hash(id + 99991u) % (unsigned)N);
    if (!dbg_close(bf2f(WT[(size_t)n * 1024 + k]), W[(size_t)k * N + n], 0.01f, 1e-6f)) dbg_fail(ew, code);
}
__global__ void chk_fp8(const float* src, const unsigned char* dst, size_t n, float sc, unsigned* ew, unsigned code) {
    const unsigned id = blockIdx.x * 256 + threadIdx.x; const size_t i = ((size_t)dbg_hash(id) * 16777u + dbg_hash(id + 5u)) % n;
    if (!dbg_close(dbg_fp8(dst, i), src[i] * sc, 0.07f, 0.003f)) dbg_fail(ew, code);
}
__global__ void chk_attn_prompt(const bf16_t* BIG, const bf16_t* OB, const float* sinks, unsigned* ew, unsigned code) {
    const unsigned id = blockIdx.x * 256 + threadIdx.x, h1 = dbg_hash(id + 31u);
    const int b = id & 1, head = (id >> 1) & 15, d = (int)(h1 % 64u); int pos = (int)(dbg_hash(id + 77u) % 8192u);
    { const int q = (id >> 7) & 7; const int spv = q == 0 ? 0 : q == 1 ? 1 : q == 2 ? 127 : q == 3 ? 128 : q == 4 ? 129 : q == 5 ? 8191 : q == 6 ? 8064 : 255; if ((id >> 5) % 3 == 0) pos = spv; }
    const int kvh = head >> 2; const bf16_t* q = BIG + (size_t)(b * SEQ + pos) * QKVW + head * 64;
    const int k0 = pos - 128 < 0 ? 0 : pos - 128; float m = sinks[head];
    for (int kp = k0; kp <= pos; ++kp) { const bf16_t* kr = BIG + (size_t)(b * SEQ + kp) * QKVW + 1024 + kvh * 64; float s = 0.f; for (int e = 0; e < 64; ++e) s += bf2f(q[e]) * bf2f(kr[e]); s *= 0.125f; m = fmaxf(m, s); }
    float den = expf(sinks[head] - m), o = 0.f;
    for (int kp = k0; kp <= pos; ++kp) { const bf16_t* kr = BIG + (size_t)(b * SEQ + kp) * QKVW + 1024 + kvh * 64; float s = 0.f; for (int e = 0; e < 64; ++e) s += bf2f(q[e]) * bf2f(kr[e]); s *= 0.125f;
        const float p = expf(s - m); den += p; o += p * bf2f(kr[256 + d]); }
    if (!dbg_close(bf2f(OB[(size_t)(b * SEQ + pos) * D + head * 64 + d]), o / den, 0.03f, 0.01f)) dbg_fail(ew, code);
}
__global__ void chk_attn_sample(const bf16_t* BIG, const bf16_t* OB, const float* sinks, const float* cwk, const float* cwv, const float* wks, const float* wvs, unsigned* ew, unsigned code) {
    const unsigned id = blockIdx.x * 256 + threadIdx.x, h1 = dbg_hash(id + 31u);
    const int b = (int)(h1 % 128u), l = id & 3, head = (id >> 2) & 15, d = (int)((h1 >> 8) % 64u), kvh = head >> 2;
    const bf16_t* q = BIG + (size_t)(TP + b * 4 + l) * QKVW + head * 64;
    float m = sinks[head];
    for (int pass = 0; pass < 2; ++pass) { float den = expf(sinks[head] - m), o = 0.f;
        for (int key = 0; key < 132; ++key) { const bool ok = key < 128 ? key >= l : (key - 128) <= l; if (!ok) continue; float s = 0.f;
            for (int e = 0; e < 64; ++e) { const float kd = key < 128 ? cwk[(((size_t)b * 128 + key) * 4 + kvh) * 64 + e] : bf2f(BIG[(size_t)(TP + b * 4 + key - 128) * QKVW + 1024 + kvh * 64 + e]); s += bf2f(q[e]) * kd; }
            s *= 0.125f; if (pass == 0) m = fmaxf(m, s); else { const float p = expf(s - m); den += p;
                o += p * (key < 128 ? cwv[(((size_t)b * 128 + key) * 4 + kvh) * 64 + d] : bf2f(BIG[(size_t)(TP + b * 4 + key - 128) * QKVW + 1280 + kvh * 64 + d])); } }
        if (pass == 1 && !dbg_close(bf2f(OB[(size_t)(TP + b * 4 + l) * D + head * 64 + d]), o / den, 0.03f, 0.01f)) dbg_fail(ew, code); }
    const int i = (int)((h1 >> 16) % 128u); const size_t oo = (((size_t)b * 128 + i) * 4 + kvh) * 64 + d;
    const float rk = i < 124 ? cwk[(((size_t)b * 128 + i + 4) * 4 + kvh) * 64 + d] : bf2f(BIG[(size_t)(TP + b * 4 + i - 124) * QKVW + 1024 + kvh * 64 + d]);
    const float rv = i < 124 ? cwv[(((size_t)b * 128 + i + 4) * 4 + kvh) * 64 + d] : bf2f(BIG[(size_t)(TP + b * 4 + i - 124) * QKVW + 1280 + kvh * 64 + d]);
    if (!dbg_close(wks[oo], rk, 1e-3f, 1e-5f) || !dbg_close(wvs[oo], rv, 1e-3f, 1e-5f)) dbg_fail(ew, code + 0u);
}
__global__ void chk_winp(const bf16_t* BIG, const float* wkp, const float* wvp, unsigned* ew, unsigned code) {
    const unsigned id = blockIdx.x * 256 + threadIdx.x, h1 = dbg_hash(id + 3u); const int b = id & 1, i = (int)(h1 % 128u), c = (int)((h1 >> 8) % 256u);
    const float rk = bf2f(BIG[(size_t)(b * SEQ + SEQ - 128 + i) * QKVW + 1024 + c]), rv = bf2f(BIG[(size_t)(b * SEQ + SEQ - 128 + i) * QKVW + 1280 + c]);
    if (!dbg_close(wkp[((size_t)b * 128 + i) * 256 + c], rk, 1e-3f, 1e-5f) || !dbg_close(wvp[((size_t)b * 128 + i) * 256 + c], rv, 1e-3f, 1e-5f)) dbg_fail(ew, code);
}
__global__ void chk_conv(const bf16_t* BIG, const bf16_t* OB, const float* cw, const float* state, const float* cvp, const float* cvs, unsigned* ew, unsigned code) {
    const unsigned id = blockIdx.x * 256 + threadIdx.x, h1 = dbg_hash(id + 3u); int r = (int)(h1 % (unsigned)T); const int c = (int)((h1 >> 12) % 1024u);
    { const int q = (id >> 2) & 7; const int spv = q == 0 ? 0 : q == 1 ? 1 : q == 2 ? 2 : q == 3 ? 8191 : q == 4 ? 8192 : q == 5 ? 8193 : q == 6 ? TP : T - 1; if ((id & 3) == 0) r = spv; } if ((id & 3) == 1) r = TP + (int)(h1 % 512u);
    auto U = [&](int row) { return bf2f(BIG[(size_t)row * 3072 + 1024 + c]) * bf2f(BIG[(size_t)row * 3072 + 2048 + c]); };
    float um1, um2; const float u0 = U(r);
    if (r < TP) { const int t = r % SEQ; um1 = t >= 1 ? U(r - 1) : 0.f; um2 = t >= 2 ? U(r - 2) : 0.f;
        if (t >= SEQ - 2 && !dbg_close(cvp[((size_t)(r / SEQ) * 2 + (t - (SEQ - 2))) * D + c], u0, 1e-3f, 1e-5f)) dbg_fail(ew, code); }
    else { const int rr = r - TP, b = rr >> 2, l = rr & 3; const float s0 = state[((size_t)b * 2 + 0) * D + c], s1 = state[((size_t)b * 2 + 1) * D + c];
        um1 = l >= 1 ? U(r - 1) : s1; um2 = l >= 2 ? U(r - 2) : (l == 1 ? s1 : s0);
        if (l >= 2 && !dbg_close(cvs[((size_t)b * 2 + (l - 2)) * D + c], u0, 1e-3f, 1e-5f)) dbg_fail(ew, code); }
    const float z = cw[c] * um2 + cw[D + c] * um1 + cw[2 * D + c] * u0, y = bf2f(BIG[(size_t)r * 3072 + c]) * z;
    if (!dbg_close(bf2f(OB[(size_t)r * D + c]), y, 0.01f, 0.01f)) dbg_fail(ew, code);
}
__global__ void chk_ln(const float* xa, const float* xb, const float* Fb, const float* gam, const float* bet, const float* Xo, const bf16_t* XBo, unsigned* ew, unsigned code) {
    __shared__ float red[256]; const int tid = threadIdx.x; const unsigned h1 = dbg_hash(blockIdx.x + 17u);
    int r = (int)(h1 % (unsigned)T); if (blockIdx.x == 0) r = 0; if (blockIdx.x == 1) r = T - 1; if (blockIdx.x == 2) r = TP;
    const float* xr = r < TP ? xa + (size_t)r * D : xb + (size_t)(r - TP) * D; float v[4], s = 0.f;
    for (int j = 0; j < 4; ++j) { v[j] = DN_ALPHA * xr[tid + 256 * j] + Fb[(size_t)r * D + tid + 256 * j]; s += v[j]; }
    red[tid] = s; __syncthreads(); for (int o = 128; o > 0; o >>= 1) { if (tid < o) red[tid] += red[tid + o]; __syncthreads(); } const float mean = red[0] / D; __syncthreads();
    s = 0.f; for (int j = 0; j < 4; ++j) s += (v[j] - mean) * (v[j] - mean);
    red[tid] = s; __syncthreads(); for (int o = 128; o > 0; o >>= 1) { if (tid < o) red[tid] += red[tid + o]; __syncthreads(); } const float rstd = 1.f / sqrtf(red[0] / D + LN_EPS);
    for (int j = 0; j < 4; ++j) { const int c = tid + 256 * j; const float y = (v[j] - mean) * rstd * gam[c] + bet[c];
        if (!dbg_close(Xo[(size_t)r * D + c], y, 1e-3f, 1e-3f) || !dbg_close(bf2f(XBo[(size_t)r * D + c]), y, 0.01f, 0.01f)) dbg_fail(ew, code); }
}
__global__ void chk_mem_prompt(const bf16_t* QM, const bf16_t* MKl, const bf16_t* MVTl, const bf16_t* OB, unsigned* ew, unsigned code) {
    const unsigned id = blockIdx.x * 256 + threadIdx.x, h1 = dbg_hash(id + 3u); const int b = id & 1, h = (id >> 1) & 3, d = (int)(h1 % 256u); int pos = (int)((h1 >> 8) % 8192u);
    if ((id & 31) == 0) pos = 8191; if ((id & 31) == 8) pos = 0;
    const bf16_t* q = QM + (size_t)(b * SEQ + pos) * D + h * 256; float m = -1e30f;
    for (int pass = 0; pass < 2; ++pass) { float den = 0.f, o = 0.f;
        for (int mm = 0; mm < 256; ++mm) { const bf16_t* kr = MKl + (size_t)(b * 256 + mm) * 1024 + h * 256; float s = 0.f; for (int e = 0; e < 256; ++e) s += bf2f(q[e]) * bf2f(kr[e]); s *= 0.0625f;
            if (pass == 0) m = fmaxf(m, s); else { const float p = expf(s - m); den += p; o += p * bf2f(MVTl[(size_t)(h * 256 + d) * 512 + b * 256 + mm]); } }
        if (pass == 1 && !dbg_close(bf2f(OB[(size_t)(b * SEQ + pos) * D + h * 256 + d]), o / den, 0.03f, 0.005f)) dbg_fail(ew, code); }
}
__global__ void chk_mem_sample(const bf16_t* QM, const float* ck, const float* cv, const bf16_t* OB, unsigned* ew, unsigned code) {
    const unsigned id = blockIdx.x * 256 + threadIdx.x, h1 = dbg_hash(id + 3u); const int b = (int)(h1 % 128u), l = id & 3, h = (id >> 2) & 3, d = (int)((h1 >> 8) % 256u);
    const bf16_t* q = QM + (size_t)(TP + b * 4 + l) * D + h * 256; float m = -1e30f;
    for (int pass = 0; pass < 2; ++pass) { float den = 0.f, o = 0.f;
        for (int mm = 0; mm < 256; ++mm) { const float* kr = ck + (((size_t)b * 256 + mm) * 4 + h) * 256; float s = 0.f; for (int e = 0; e < 256; ++e) s += bf2f(q[e]) * kr[e]; s *= 0.0625f;
            if (pass == 0) m = fmaxf(m, s); else { const float p = expf(s - m); den += p; o += p * cv[(((size_t)b * 256 + mm) * 4 + h) * 256 + d]; } }
        if (pass == 1 && !dbg_close(bf2f(OB[(size_t)(TP + b * 4 + l) * D + h * 256 + d]), o / den, 0.03f, 0.005f)) dbg_fail(ew, code); }
}
__global__ void chk_router(const bf16_t* BIG, const bf16_t* SUBK, const int* EID, const float* GW, unsigned* ew, unsigned code) {
    __shared__ float sc[256]; __shared__ float sv[2][16]; __shared__ int si[2][16]; __shared__ float cs[16]; __shared__ int ce[16]; __shared__ float comb[256];
    const int tid = threadIdx.x; const unsigned h1 = dbg_hash(blockIdx.x + 5u); int tok = (int)(h1 % (unsigned)T); const int head = blockIdx.x & 7;
    if (blockIdx.x < 8) tok = T - 1; else if (blockIdx.x < 16) tok = 0;
    { const int c = tid >> 7, n = tid & 127; float s = 0.f; for (int e = 0; e < 128; ++e) s += bf2f(BIG[(size_t)tok * 2048 + head * 256 + c * 128 + e]) * bf2f(SUBK[(size_t)(c * 128 + n) * 128 + e]); sc[tid] = s; }
    __syncthreads();
    if (tid < 2) { for (int k = 0; k < 16; ++k) { int bi = 0; float bv = -1e30f; for (int n = 0; n < 128; ++n) if (sc[tid * 128 + n] > bv) { bv = sc[tid * 128 + n]; bi = n; } sv[tid][k] = bv; si[tid][k] = bi; sc[tid * 128 + bi] = -2e30f; } }
    __syncthreads();
    comb[tid] = sv[0][tid >> 4] + sv[1][tid & 15];
    __syncthreads();
    if (tid == 0) { float mx = -1e30f; for (int k = 0; k < 16; ++k) { int bi = 0; float bv = -1e30f; for (int n = 0; n < 256; ++n) if (comb[n] > bv) { bv = comb[n]; bi = n; } cs[k] = bv; ce[k] = si[0][bi >> 4] * 128 + si[1][bi & 15]; comb[bi] = -2e30f; mx = fmaxf(mx, bv); }
        float den = 0.f; for (int k = 0; k < 16; ++k) den += expf(cs[k] - cs[0]);
        int nbad = 0;
        for (int k = 0; k < 16; ++k) { const int e = EID[((size_t)tok * 8 + head) * 16 + k]; const float g = GW[((size_t)tok * 8 + head) * 16 + k]; bool found = false;
            for (int j = 0; j < 16; ++j) if (ce[j] == e) { found = true; if (!dbg_close(g, expf(cs[j] - cs[0]) / den, 0.05f, 0.003f)) nbad += 4; }
            if (!found) nbad += 1; }
        if (nbad > 2) dbg_fail(ew, code);
        { int nmiss = 0, ng = 0;
          for (int k = 0; k < 16; ++k) { const int e = EID[((size_t)tok * 8 + head) * 16 + k]; const float g = GW[((size_t)tok * 8 + head) * 16 + k]; bool found = false;
            for (int j = 0; j < 16; ++j) if (ce[j] == e) { found = true; if (!dbg_close(g, expf(cs[j] - cs[0]) / den, 0.05f, 0.003f)) ++ng; }
            if (!found) ++nmiss; }
          unsigned mask = 0; (void)ng; (void)nmiss;
          const float* dp = (const float*)((const unsigned char*)EID - WS_EID + WS_SP) + ((size_t)tok * 8 + head) * 48;
          for (int c2 = 0; c2 < 2; ++c2) for (int i = 0; i < 16; ++i) { const unsigned bits = __builtin_bit_cast(unsigned, dp[16 * c2 + i]); const float val = __builtin_bit_cast(float, bits & ~127u);
              if (!dbg_close(val, sv[c2][i], 1e-3f, 1e-4f)) mask |= 1u; else if ((int)(bits & 127u) != si[c2][i]) mask |= 2u; }
          for (int n = 0; n < 256; ++n) comb[n] = __builtin_bit_cast(float, __builtin_bit_cast(unsigned, dp[n >> 4]) & ~127u) + __builtin_bit_cast(float, __builtin_bit_cast(unsigned, dp[16 + (n & 15)]) & ~127u);
          float den2 = 0.f, c00 = 0.f;
          for (int k = 0; k < 16; ++k) { int bi = 0; float bv = -1e30f; for (int n = 0; n < 256; ++n) if (comb[n] > bv) { bv = comb[n]; bi = n; } comb[bi] = -2e30f;
              const unsigned tb = __builtin_bit_cast(unsigned, dp[32 + k]); const float tv = __builtin_bit_cast(float, tb & ~255u);
              if (!dbg_close(tv, bv, 1e-3f, 1e-4f)) mask |= 4u;
              const int ci = (tb >> 4) & 15, cj = tb & 15; const int want = (int)(__builtin_bit_cast(unsigned, dp[ci]) & 127u) * 128 + (int)(__builtin_bit_cast(unsigned, dp[16 + cj]) & 127u);
              if (EID[((size_t)tok * 8 + head) * 16 + k] != want) mask |= 8u;
              if (k == 0) c00 = tv; den2 += expf(tv - c00); cs[k] = tv; }
          for (int k = 0; k < 16; ++k) if (!dbg_close(GW[((size_t)tok * 8 + head) * 16 + k], expf(cs[k] - c00) / den2, 0.02f, 1e-3f)) mask |= 16u;
          if (mask) atomicOr(ew + 1, mask); } }
}
__global__ void chk_expert(const unsigned char* PU, const unsigned char* PV, const unsigned char* X8p, const int* EID, const float* GW, const float* Xin, const float* Yo, const float* gam, const float* bet, unsigned* ew, unsigned code) {
    __shared__ float aw[128]; __shared__ float red[256]; const int tid = threadIdx.x; const unsigned h1 = dbg_hash(blockIdx.x + 9u);
    int t = (int)(h1 % (unsigned)T); if (blockIdx.x == 0) t = 0; if (blockIdx.x == 1) t = T - 1; if (blockIdx.x == 2) t = TP;
    if (tid < 128) { const int e = EID[(size_t)t * 128 + tid]; float hs = 0.f; for (int k = 0; k < 1024; ++k) hs += dbg_fp8(X8p, (size_t)t * D + k) * dbg_fp8(PU, (size_t)e * D + k);
        hs *= (1.f / U_SCALE); aw[tid] = 0.5f * hs * (1.f + erff(hs * 0.70710678f)) * GW[(size_t)t * 128 + tid]; }
    __syncthreads();
    float v[4], s = 0.f;
    for (int j = 0; j < 4; ++j) { const int c = tid + 256 * j; float f = 0.f; for (int k = 0; k < 128; ++k) f += aw[k] * dbg_fp8(PV, (size_t)EID[(size_t)t * 128 + k] * D + c); f *= (1.f / V_SCALE);
        v[j] = DN_ALPHA * Xin[(size_t)t * D + c] + f; s += v[j]; }
    red[tid] = s; __syncthreads(); for (int o = 128; o > 0; o >>= 1) { if (tid < o) red[tid] += red[tid + o]; __syncthreads(); } const float mean = red[0] / D; __syncthreads();
    s = 0.f; for (int j = 0; j < 4; ++j) s += (v[j] - mean) * (v[j] - mean);
    red[tid] = s; __syncthreads(); for (int o = 128; o > 0; o >>= 1) { if (tid < o) red[tid] += red[tid + o]; __syncthreads(); } const float rstd = 1.f / sqrtf(red[0] / D + LN_EPS);
    for (int j = 0; j < 4; ++j) { const int c = tid + 256 * j; const float y = (v[j] - mean) * rstd * gam[c] + bet[c]; if (!dbg_close(Yo[(size_t)t * D + c], y, 2e-3f, 2e-3f)) dbg_fail(ew, code); }
}
__global__ void dbg_final(const unsigned* ew, float* outp) { if (ew[1]) outp[0] = 1000.f * (float)(10u + ew[1]); else if (*ew) outp[0] = 1000.f * (float)(100u - *ew); }
#endif
extern "C" void kernel_launch(void* const* d_in, const int* in_sizes, int n_in, void* d_out, int out_size, void* d_ws, size_t ws_size, hipStream_t stream) {
    static int grid = 0;
    if (grid == 0) {
        if (n_in != 23 || (size_t)out_size != O_END || ws_size < WS_END + 200 * MiB) { fprintf(stderr, "kernel_launch: unexpected shapes (n_in %d out %d ws %zu); nothing launched\n", n_in, out_size, ws_size); grid = -1; return; }
        int dev = 0, cus = 0, per_cu = 0;
        if (hipGetDevice(&dev) != hipSuccess || hipDeviceGetAttribute(&cus, hipDeviceAttributeMultiprocessorCount, dev) != hipSuccess) { grid = -1; return; }
        if (hipFuncSetAttribute((const void*)mega_fwd, hipFuncAttributeMaxDynamicSharedMemorySize, LDS_BYTES) != hipSuccess) { fprintf(stderr, "kernel_launch: hipFuncSetAttribute failed\n"); grid = -1; return; }
        if (hipOccupancyMaxActiveBlocksPerMultiprocessor(&per_cu, (const void*)mega_fwd, NTHREADS, LDS_BYTES) != hipSuccess || per_cu < 1)
            fprintf(stderr, "kernel_launch: note: occupancy query reports %d workgroups per CU\n", per_cu);
        (void)hipGetLastError();
        grid = cus;
        if (grid != 256) fprintf(stderr, "kernel_launch: %d CUs; the memory-attention phases expect 256\n", grid);
    }
    if (grid < 0) return;
    if (hipMemsetAsync((char*)d_ws + WS_CTL, 0, CTL_ZERO_BYTES, stream) != hipSuccess) return;
    Args a{};
    for (int i = 0; i < 23; ++i) a.in[i] = (const float*)d_in[i];
    a.out = (float*)d_out; a.ws = (unsigned char*)d_ws;
#if MK_PER_PHASE
    for (int p = 0; p < N_PHASES; ++p) { a.ph_lo = p; a.ph_hi = p + 1; hipLaunchKernelGGL(mega_fwd, dim3(grid), dim3(NTHREADS), LDS_BYTES, stream, a);
#if MK_DEBUG
        unsigned char* ws = (unsigned char*)d_ws; float* out = (float*)d_out; unsigned* ew = (unsigned*)(ws + WS_CTL) + 16384;
        bf16_t* XBp = (bf16_t*)(ws + WS_XB); bf16_t* BIGp = (bf16_t*)(ws + WS_BIG); bf16_t* OBp = (bf16_t*)(ws + WS_OB); float* Xp = (float*)(ws + WS_X); float* FBp = (float*)(ws + WS_F);
#define CK(kern, ...) hipLaunchKernelGGL(kern, dim3(4), dim3(256), 0, stream, __VA_ARGS__)
        if (p == 0) {
            CK(chk_transposed, a.in[8] + (size_t)1 * 1024 * 1536, 1536, (const bf16_t*)(ws + WS_WQKV) + (size_t)1 * 1536 * 1024, ew, 60u);
            CK(chk_transposed, a.in[17] + (size_t)3 * 1024 * 2048, 2048, (const bf16_t*)(ws + WS_WPQ) + (size_t)3 * 2048 * 1024, ew, 60u);
            CK(chk_transposed, a.in[11] + (size_t)1 * 1024 * 3072, 3072, (const bf16_t*)(ws + WS_WIN) + (size_t)1 * 3072 * 1024, ew, 60u);
            CK(chk_fp8, a.in[19], ws + WS_PU8, (size_t)NLAYER * NEXP * D, U_SCALE, ew, 61u);
            CK(chk_fp8, a.in[20], ws + WS_PV8, (size_t)NLAYER * NEXP * D, V_SCALE, ew, 62u);
        } else {
            const int L = (p - 1) / PH_PER_LAYER, k = (p - 1) % PH_PER_LAYER, jj = L >> 1; const unsigned code = 10u + (unsigned)(L * 12 + k);
            if ((L & 1) == 0) {
                if (k == 0) { CK(chk_gemm, XBp, 1024, (const bf16_t*)(ws + WS_WQKV) + (size_t)jj * QKVW * D, 1024, 1024, T, QKVW, (const void*)BIGp, QKVW, 0, ew, code);
                    if (L == 0) { const int z = 2; const bf16_t* W = (const bf16_t*)(ws + WS_WMKV) + (size_t)z * 2048 * 1024; const bf16_t* MB = (const bf16_t*)(ws + WS_MEMB);
                        CK(chk_gemm, MB, 1024, W, 1024, 1024, 512, 1024, (const void*)(out + O_MKP + (size_t)z * 512 * 1024), 1024, 1, ew, 63u);
                        CK(chk_gemm, MB, 1024, W + (size_t)1024 * 1024, 1024, 1024, 512, 1024, (const void*)(out + O_MVP + (size_t)z * 512 * 1024), 1024, 1, ew, 64u);
                        CK(chk_gemm, MB, 1024, W, 1024, 1024, 512, 1024, (const void*)((const bf16_t*)(ws + WS_MK) + (size_t)z * 512 * 1024), 1024, 0, ew, 65u);
                        CK(chk_gemm, W + (size_t)1024 * 1024, 1024, MB, 1024, 1024, 1024, 512, (const void*)((const bf16_t*)(ws + WS_MVT) + (size_t)z * 1024 * 512), 512, 0, ew, 66u); } }
                if (k == 1) { CK(chk_attn_prompt, BIGp, OBp, a.in[9] + jj * 16, ew, code);
                    CK(chk_attn_sample, BIGp, OBp, a.in[9] + jj * 16, a.in[2] + (size_t)jj * 4194304, a.in[3] + (size_t)jj * 4194304, out + O_WKS + (size_t)jj * 4194304, out + O_WVS + (size_t)jj * 4194304, ew, code);
                    CK(chk_winp, BIGp, out + O_WKP + (size_t)jj * 65536, out + O_WVP + (size_t)jj * 65536, ew, code); }
                if (k == 2) CK(chk_gemm, OBp, 1024, (const bf16_t*)(ws + WS_WO) + (size_t)jj * D * D, 1024, 1024, T, D, (const void*)FBp, D, 1, ew, code);
            } else {
                if (k == 0) CK(chk_gemm, XBp, 1024, (const bf16_t*)(ws + WS_WIN) + (size_t)jj * 3072 * D, 1024, 1024, T, 3072, (const void*)BIGp, 3072, 0, ew, code);
                if (k == 1) CK(chk_conv, BIGp, OBp, a.in[12] + (size_t)jj * 3 * D, a.in[4] + (size_t)jj * DBATCH * 2 * D, out + O_CVP + (size_t)jj * 4096, out + O_CVS + (size_t)jj * DBATCH * 2 * D, ew, code);
                if (k == 2) CK(chk_gemm, OBp, 1024, (const bf16_t*)(ws + WS_WOUT) + (size_t)jj * D * D, 1024, 1024, T, D, (const void*)FBp, D, 1, ew, code);
            }
            if (k == 3 && L == 0) CK(chk_ln, a.in[0], a.in[1], FBp, a.in[21], a.in[22], Xp, XBp, ew, code);
            if (k == 4) CK(chk_gemm, XBp, 1024, (const bf16_t*)(ws + WS_WMQ) + (size_t)L * D * D, 1024, 1024, T, D, (const void*)BIGp, D, 0, ew, code);
            if (k == 5) CK(chk_mem_sample, BIGp, a.in[5] + (size_t)L * 33554432, a.in[6] + (size_t)L * 33554432, OBp, ew, code);
            if (k == 6) CK(chk_mem_prompt, BIGp, (const bf16_t*)(ws + WS_MK) + (size_t)L * 512 * 1024, (const bf16_t*)(ws + WS_MVT) + (size_t)L * 1024 * 512, OBp, ew, code);
            if (k == 7) CK(chk_gemm, OBp, 1024, (const bf16_t*)(ws + WS_WMO) + (size_t)L * D * D, 1024, 1024, T, D, (const void*)FBp, D, 1, ew, code);
            if (k == 9) CK(chk_gemm, XBp, 1024, (const bf16_t*)(ws + WS_WPQ) + (size_t)L * 2048 * D, 1024, 1024, T, 2048, (const void*)BIGp, 2048, 0, ew, code);
            if (k == 10) hipLaunchKernelGGL(chk_router, dim3(96), dim3(256), 0, stream, BIGp, (const bf16_t*)(ws + WS_SUBK) + (size_t)L * 2 * 128 * 128, (const int*)(ws + WS_EID), (const float*)(ws + WS_GW), ew, code);
            if (k == 11 && L == NLAYER - 1) hipLaunchKernelGGL(chk_expert, dim3(24), dim3(256), 0, stream, ws + WS_PU8 + (size_t)L * NEXP * D, ws + WS_PV8 + (size_t)L * NEXP * D, ws + WS_X8, (const int*)(ws + WS_EID), (const float*)(ws + WS_GW),
                                                           Xp, out, a.in[21] + (size_t)(L * 3 + 2) * D, a.in[22] + (size_t)(L * 3 + 2) * D, ew, code);
        }
        if (p == N_PHASES - 1) hipLaunchKernelGGL(dbg_final, dim3(1), dim3(1), 0, stream, ew, out);
#undef CK
#endif
    }
#else
    a.ph_lo = 0; a.ph_hi = N_PHASES;
    hipLaunchKernelGGL(mega_fwd, dim3(grid), dim3(NTHREADS), LDS_BYTES, stream, a);
#endif
    const hipError_t le = hipPeekAtLastError();
    if (le != hipSuccess) fprintf(stderr, "kernel_launch: launch failed: %s\n", hipGetErrorName(le));
}
```

```cpp
#include <hip/hip_runtime.h>
#include <cstdio>
#include <cstdint>

#ifndef MK_DUP
#define MK_DUP 0
#endif
#ifndef MK_STAMP
#define MK_STAMP 0
#endif
#ifndef MK_SEL_A
#define MK_SEL_A 12
#define MK_SEL_B 0
#endif
#ifndef MK_DEBUG
#define MK_DEBUG 0
#endif
#if MK_DEBUG
#define MK_PER_PHASE 1
#endif
#ifndef MK_PER_PHASE
#define MK_PER_PHASE 0
#endif

#define LAS __attribute__((address_space(3)))
#define GAS __attribute__((address_space(1)))
typedef unsigned short bf16_t;
typedef short bf16x8 __attribute__((ext_vector_type(8)));
typedef float f32x4 __attribute__((ext_vector_type(4)));
typedef float f32x2 __attribute__((ext_vector_type(2)));
typedef float f32x16 __attribute__((ext_vector_type(16)));
typedef unsigned u32x4 __attribute__((ext_vector_type(4)));
typedef unsigned u32x2 __attribute__((ext_vector_type(2)));

constexpr int D = 1024, SEQ = 8192, NBATCH = 2, TP = NBATCH * SEQ, DBATCH = 128, DSEQ = 4, TS = DBATCH * DSEQ, T = TP + TS;
constexpr int QKVW = 1536, NEXP = 16384, NLAYER = 4;
constexpr float DN_ALPHA = 1.6817928305074292f;
constexpr float LN_EPS = 1e-5f;
constexpr float LOG2E = 1.4426950408889634f;
constexpr float U_SCALE = 64.f, V_SCALE = 16.f;

constexpr size_t O_YP = 0, O_YS = 16777216, O_WKP = O_YS + 524288, O_WVP = O_WKP + 131072, O_CVP = O_WVP + 131072, O_MKP = O_CVP + 8192,
                 O_MVP = O_MKP + 2097152, O_WKS = O_MVP + 2097152, O_WVS = O_WKS + 8388608, O_CVS = O_WVS + 8388608, O_END = O_CVS + 524288;

constexpr size_t MiB = 1u << 20;
constexpr size_t WS_CTL = 0, CTL_ZERO_BYTES = 1 * MiB;
constexpr size_t WS_WQKV = 2 * MiB, WS_WO = 8 * MiB, WS_WIN = 12 * MiB, WS_WOUT = 24 * MiB, WS_WMQ = 28 * MiB, WS_WMKV = 36 * MiB, WS_WMO = 52 * MiB, WS_WPQ = 60 * MiB;
constexpr size_t WS_SUBK = 76 * MiB, WS_MEMB = 77 * MiB, WS_MK = 78 * MiB, WS_MVT = 82 * MiB, WS_PU8 = 86 * MiB, WS_PV8 = 150 * MiB;
constexpr size_t WS_X = 214 * MiB, WS_XB = 280 * MiB, WS_BIG = 313 * MiB, WS_OB = 412 * MiB, WS_F = 445 * MiB, WS_SP = 511 * MiB;
constexpr size_t WS_EID = 543 * MiB, WS_GW = 552 * MiB, WS_AW = 561 * MiB, WS_X8 = 570 * MiB, WS_EIDS = 587 * MiB, WS_GWS = 596 * MiB, WS_OFFS = 605 * MiB, WS_END = 607 * MiB;
constexpr int CW_BAR = 4096;

constexpr int LDS_SCRATCH = 153600;
constexpr int MISC_OFF = LDS_SCRATCH;
constexpr int LDS_BYTES = 155648;

__device__ __forceinline__ unsigned f2bf(float f) { unsigned u = __builtin_bit_cast(unsigned, f); return (u + 0x7fffu + ((u >> 16) & 1u)) >> 16; }
__device__ __forceinline__ unsigned pk2(float lo, float hi) { return f2bf(lo) | (f2bf(hi) << 16); }
__device__ __forceinline__ float bf2f(unsigned b) { return __builtin_bit_cast(float, b << 16); }
__device__ __forceinline__ float bflo(unsigned w) { return __builtin_bit_cast(float, w << 16); }
__device__ __forceinline__ float bfhi(unsigned w) { return __builtin_bit_cast(float, w & 0xffff0000u); }
__device__ __forceinline__ unsigned cvt_pk_bf16(float lo, float hi) { unsigned r; asm volatile("v_cvt_pk_bf16_f32 %0, %1, %2" : "=v"(r) : "v"(lo), "v"(hi)); return r; }
__device__ __forceinline__ float wave_sum(float v) {
#pragma unroll
    for (int o = 1; o < 64; o <<= 1) v += __shfl_xor(v, o);
    return v;
}
__device__ __forceinline__ float wave_max(float v) {
#pragma unroll
    for (int o = 1; o < 64; o <<= 1) v = fmaxf(v, __shfl_xor(v, o));
    return v;
}
#define LDS_WAIT() asm volatile("s_waitcnt lgkmcnt(0)" ::: "memory")
#define VM_WAIT() asm volatile("s_waitcnt vmcnt(0)" ::: "memory")
__device__ __forceinline__ void st_wt16(void* p, u32x4 v) { asm volatile("global_store_dwordx4 %0, %1, off sc1\n\ts_nop 1" :: "v"(p), "v"(v) : "memory"); }
__device__ __forceinline__ void st_wt16f(void* p, f32x4 v) { asm volatile("global_store_dwordx4 %0, %1, off sc1\n\ts_nop 1" :: "v"(p), "v"(v) : "memory"); }
__device__ __forceinline__ void st_wt8(void* p, u32x2 v) { asm volatile("global_store_dwordx2 %0, %1, off sc1\n\ts_nop 1" :: "v"(p), "v"(v) : "memory"); }
#define WG_BAR() do { asm volatile("s_waitcnt vmcnt(0) lgkmcnt(0)" ::: "memory"); __builtin_amdgcn_s_barrier(); asm volatile("" ::: "memory"); } while (0)

#define XB_TMO      128
#define XB_XCNT(j)  (256  + 64 * (j))
#define XB_XSUB(j)  (1280 + 64 * (j))
#define XB_XGEN(j)  (2304 + 64 * (j))
#define XB_TOP      3328
#define XB_TOPGEN   3392
#define XCD_BAR_WORDS 3456
#define XB_SPIN_CAP (1u << 21)

__device__ __forceinline__ unsigned xb_ld(unsigned* p)              { return __hip_atomic_load(p, __ATOMIC_RELAXED, __HIP_MEMORY_SCOPE_AGENT); }
__device__ __forceinline__ unsigned xb_add(unsigned* p, unsigned v) { return __hip_atomic_fetch_add(p, v, __ATOMIC_RELAXED, __HIP_MEMORY_SCOPE_AGENT); }
__device__ __forceinline__ unsigned xb_xcc_id() { return (unsigned)__builtin_amdgcn_s_getreg((3 << 11) | 20) & 0xFu; }
#define XB_SPIN(cond, bar) do { unsigned _sp = 0; while (cond) { __builtin_amdgcn_s_sleep(1); \
    if ((++_sp & 255u) == 0u) { if (xb_ld(&(bar)[XB_TMO])) break; if (_sp > XB_SPIN_CAP) { atomicAdd(&(bar)[XB_TMO], 1u); break; } } } } while (0)

struct XcdBarrier { unsigned* bar; unsigned x; volatile LAS unsigned* st; };

__device__ __forceinline__ XcdBarrier xcd_barrier_post(unsigned* bar, volatile LAS unsigned* st) {
    XcdBarrier b; b.bar = bar; b.x = xb_xcc_id(); b.st = st;
    if (threadIdx.x == 0) (void)xb_add(&bar[XB_XCNT(b.x)], 1u);
    return b;
}
__device__ __forceinline__ void xcd_barrier_complete(unsigned* bar, unsigned x, unsigned& nloc, unsigned& nx) {
    const unsigned G = gridDim.x * gridDim.y * gridDim.z;
    unsigned sum, cnt, mine, sp = 0u;
    for (;;) {
        sum = 0u; cnt = 0u; mine = 0u;
#pragma unroll
        for (unsigned j = 0; j < 16; ++j) { const unsigned c = xb_ld(&bar[XB_XCNT(j)]); sum += c; cnt += (c > 0u) ? 1u : 0u; mine = (j == x) ? c : mine; }
        if (sum == G) break;
        __builtin_amdgcn_s_sleep(1);
        if ((++sp & 255u) == 0u) { if (xb_ld(&bar[XB_TMO])) break; if (sp > XB_SPIN_CAP) { atomicAdd(&bar[XB_TMO], 1u); break; } }
    }
    nloc = mine > 0u ? mine : 1u; nx = cnt > 0u ? cnt : 1u;
}
__device__ __forceinline__ void xcd_barrier(const XcdBarrier& b) {
    asm volatile("s_waitcnt vmcnt(0)" ::: "memory");
    __syncthreads();
    if (threadIdx.x == 0) {
        unsigned* bar = b.bar;
        __builtin_amdgcn_s_waitcnt(0);
        unsigned nloc = b.st[0], nx = b.st[1];
        if (nloc == 0u) { xcd_barrier_complete(bar, b.x, nloc, nx); b.st[0] = nloc; b.st[1] = nx; }
        const unsigned old = xb_add(&bar[XB_XSUB(b.x)], 1u);
        const unsigned gen = old / nloc;
        if (old + 1u == (gen + 1u) * nloc) {
            __builtin_amdgcn_fence(__ATOMIC_RELEASE, "agent");
            asm volatile("s_waitcnt vmcnt(0)" ::: "memory");
            const unsigned og = xb_add(&bar[XB_TOP], 1u);
            const unsigned tg = og / nx;
            if (og + 1u == (tg + 1u) * nx) xb_add(&bar[XB_TOPGEN], 1u);
            else XB_SPIN(xb_ld(&bar[XB_TOPGEN]) == tg, bar);
            __builtin_amdgcn_fence(__ATOMIC_ACQUIRE, "agent");
            xb_add(&bar[XB_XGEN(b.x)], 1u);
            asm volatile("s_waitcnt vmcnt(0)" ::: "memory");
        } else {
            XB_SPIN(xb_ld(&bar[XB_XGEN(b.x)]) == gen, bar);
            __builtin_amdgcn_fence(__ATOMIC_ACQUIRE, "agent");
            asm volatile("s_waitcnt vmcnt(0)" ::: "memory");
        }
    }
    __syncthreads();
}

namespace pg8 {
constexpr int BM = 256, BK = 64, HALF = 128, HTB = HALF * BK * 2, STAGE_BYTES = 8 * HTB, NXCD = 8, WGM = 8;
__host__ __device__ __forceinline__ int lds_byte(int r, int c) { const int st = (r >> 4) * 2 + (c >> 5), rr = r & 15, cc = c & 31, ob = rr * 64 + cc * 2; return st * 1024 + (ob ^ (((ob >> 9) & 1) << 5)); }
__host__ __device__ __forceinline__ void stage_rc(int b, int& R, int& C) { const int st = b / 1024, sb = b % 1024, swz = sb ^ (((sb >> 9) & 1) << 5); R = (st >> 1) * 16 + swz / 64; C = (st & 1) * 32 + (swz % 64) / 2; }
__host__ __device__ __forceinline__ int perm32(int rho) { const int n = rho >> 4, i = rho & 15; return 8 * (i >> 2) + 4 * n + (i & 3); }

struct Unit { unsigned aoff, boff; int crow, ccol, z; };
struct Gemm { const bf16_t* A; const bf16_t* Bt; int lda, ldb, K; };

template <class Epi, class Sched, bool ALIGN_EPI>
__device__ __forceinline__ void gemm_phase(LAS unsigned char* lds, const int tid, const Gemm g, const Sched& S, const Epi& E) {
    const int wid = __builtin_amdgcn_readfirstlane(tid >> 6), lane = tid & 63, wr = wid >> 2, wc = wid & 3, fr = lane & 15, fq = lane >> 4;
    const int nt = g.K / BK;
    unsigned voffA[2], voffB[2];
#pragma unroll
    for (int i = 0; i < 2; ++i) { int R, C; stage_rc(tid * 16 + i * 8192, R, C); const int Rb = Epi::PERM ? ((R & ~31) + perm32(R & 31)) : R;
        voffA[i] = (unsigned)(R * g.lda + C) * 2u; voffB[i] = (unsigned)(Rb * g.ldb + C) * 2u; }
    const size_t kstep = (size_t)(BK * 2);
    const size_t hstepA = (size_t)HALF * g.lda * 2, hstepB = (size_t)HALF * g.ldb * 2;
    const unsigned ldsw = (unsigned)wid * 1024u;
    const int aoff = lds_byte(wr * 64 + fr, fq * 8), boff = lds_byte(wc * 32 + fr, fq * 8);
#define PG8_SA(b, h) (((b) * 2 + (h)) * HTB)
#define PG8_SB(b, h) ((4 + (b) * 2 + (h)) * HTB)
#define PG8_STAGE(bufoff, gbase, voff) do { _Pragma("unroll") for (int _i = 0; _i < 2; ++_i) \
        __builtin_amdgcn_global_load_lds((const unsigned*)((const char*)(gbase) + (voff)[_i]), (LAS unsigned*)(lds + (bufoff) + ldsw + _i * 8192), 16, 0, 0); } while (0)
#define PG8_LDA(dst, b, h) do { _Pragma("unroll") for (int m = 0; m < 4; ++m) _Pragma("unroll") for (int k = 0; k < 2; ++k) dst[m][k] = *(const LAS bf16x8*)(lds + PG8_SA(b, h) + aoff + m * 2048 + k * 1024); } while (0)
#define PG8_LDB(dst, b, h) do { _Pragma("unroll") for (int n = 0; n < 2; ++n) _Pragma("unroll") for (int k = 0; k < 2; ++k) dst[n][k] = *(const LAS bf16x8*)(lds + PG8_SB(b, h) + boff + n * 2048 + k * 1024); } while (0)
#define PG8_MMA(ai, bj, At, Bt) do { __builtin_amdgcn_s_setprio(1); _Pragma("unroll") for (int m = 0; m < 4; ++m) _Pragma("unroll") for (int n = 0; n < 2; ++n) _Pragma("unroll") for (int k = 0; k < 2; ++k) \
        acc[ai][bj][m][n] = __builtin_amdgcn_mfma_f32_16x16x32_bf16(Bt[n][k], At[m][k], acc[ai][bj][m][n], 0, 0, 0); __builtin_amdgcn_s_setprio(0); } while (0)
#define PG8_WAIT_V(n) asm volatile("s_waitcnt vmcnt(" #n ")" ::: "memory")
#define PG8_WAIT_L(n) asm volatile("s_waitcnt lgkmcnt(" #n ")" ::: "memory")
#define PG8_BAR __builtin_amdgcn_s_barrier()
#define PG8_SCHED __builtin_amdgcn_sched_barrier(0)
    Unit cur, nxt; int ui = 0;
    if (!S.next(0, cur)) return;
    f32x4 acc[2][2][4][2];
#pragma unroll
    for (int a = 0; a < 2; ++a)
#pragma unroll
        for (int b = 0; b < 2; ++b)
#pragma unroll
            for (int m = 0; m < 4; ++m)
#pragma unroll
                for (int n = 0; n < 2; ++n) acc[a][b][m][n] = (f32x4){0.f, 0.f, 0.f, 0.f};
    bf16x8 At[4][2], B0[2][2], B1[2][2];
    const char* cA = (const char*)g.A + (size_t)cur.aoff * 2; const char* cB = (const char*)g.Bt + (size_t)cur.boff * 2;
    PG8_STAGE(PG8_SB(0, 0), cB, voffB); PG8_STAGE(PG8_SB(0, 1), cB + hstepB, voffB); PG8_STAGE(PG8_SA(0, 0), cA, voffA); PG8_STAGE(PG8_SA(0, 1), cA + hstepA, voffA);
    if (wr == 1) PG8_BAR;
    PG8_WAIT_V(2); PG8_BAR;
    PG8_STAGE(PG8_SB(1, 0), cB + kstep, voffB); PG8_STAGE(PG8_SA(1, 0), cA + kstep, voffA); PG8_STAGE(PG8_SB(1, 1), cB + hstepB + kstep, voffB);
    PG8_WAIT_V(6); PG8_BAR;
    for (;;) {
        const bool has_next = S.next(ui + 1, nxt);
        const char* nA = has_next ? (const char*)g.A + (size_t)nxt.aoff * 2 : cA; const char* nB = has_next ? (const char*)g.Bt + (size_t)nxt.boff * 2 : cB;
#pragma unroll 1
        for (int t = 0; t < nt; t += 2) {
            const bool last = (t == nt - 2);
            const char* a1 = cA + (size_t)(t + 1) * kstep;
            const char* a2 = last ? nA : cA + (size_t)(t + 2) * kstep; const char* b2 = last ? nB : cB + (size_t)(t + 2) * kstep;
            const char* a3 = a2 + kstep; const char* b3 = b2 + kstep;
            PG8_LDB(B0, 0, 0); PG8_LDB(B1, 0, 1); PG8_SCHED; PG8_LDA(At, 0, 0); PG8_STAGE(PG8_SA(1, 1), a1 + hstepA, voffA);
            PG8_WAIT_V(8); PG8_WAIT_L(0); PG8_BAR; PG8_MMA(0, 0, At, B0); PG8_MMA(0, 1, At, B1); PG8_BAR; PG8_SCHED;
            PG8_LDA(At, 0, 1); PG8_STAGE(PG8_SB(0, 0), b2, voffB); PG8_STAGE(PG8_SB(0, 1), b2 + hstepB, voffB); PG8_STAGE(PG8_SA(0, 0), a2, voffA);
            PG8_WAIT_V(8); PG8_WAIT_L(0); PG8_BAR; PG8_MMA(1, 0, At, B0); PG8_MMA(1, 1, At, B1); PG8_BAR; PG8_SCHED;
            PG8_LDB(B0, 1, 0); PG8_LDB(B1, 1, 1); PG8_SCHED; PG8_LDA(At, 1, 0); PG8_STAGE(PG8_SA(0, 1), a2 + hstepA, voffA);
            PG8_WAIT_V(8); PG8_WAIT_L(0); PG8_BAR; PG8_MMA(0, 0, At, B0); PG8_MMA(0, 1, At, B1); PG8_BAR; PG8_SCHED;
            PG8_LDA(At, 1, 1); PG8_STAGE(PG8_SB(1, 0), b3, voffB); PG8_STAGE(PG8_SB(1, 1), b3 + hstepB, voffB); PG8_STAGE(PG8_SA(1, 0), a3, voffA);
            PG8_WAIT_V(8); PG8_WAIT_L(0); PG8_BAR; PG8_MMA(1, 0, At, B0); PG8_MMA(1, 1, At, B1); PG8_BAR; PG8_SCHED;
        }
        if constexpr (ALIGN_EPI) { if (wr == 0) PG8_BAR; }
        if constexpr (!Epi::AFTER_DRAIN) { E(acc, cur, wr, wc, fr, fq); }
        if (!has_next) break;
#pragma unroll
        for (int a = 0; a < 2; ++a)
#pragma unroll
            for (int b = 0; b < 2; ++b)
#pragma unroll
                for (int m = 0; m < 4; ++m)
#pragma unroll
                    for (int n = 0; n < 2; ++n) acc[a][b][m][n] = (f32x4){0.f, 0.f, 0.f, 0.f};
        cur = nxt; cA = nA; cB = nB; ++ui;
        if constexpr (ALIGN_EPI) { if (wr == 1) PG8_BAR; }
    }
    PG8_WAIT_V(0);
    if constexpr (!ALIGN_EPI) { if (wr == 0) PG8_BAR; }
    PG8_BAR;
    if constexpr (Epi::AFTER_DRAIN) { E.fused(acc, cur, wr, wc, fr, fq, lds, wid, lane); }
#undef PG8_SA
#undef PG8_SB
#undef PG8_STAGE
#undef PG8_LDA
#undef PG8_LDB
#undef PG8_MMA
#undef PG8_WAIT_V
#undef PG8_WAIT_L
#undef PG8_BAR
#undef PG8_SCHED
}

struct PlainSched {
    int nM, nN, nwg, G, c; unsigned am, bn;
    __device__ __forceinline__ void init(int M, int N, int lda, int ldb, int G_, int c_) { nM = M / BM; nN = N / BM; nwg = nM * nN; G = G_; c = c_; am = (unsigned)(BM * lda); bn = (unsigned)(BM * ldb); }
    __device__ __forceinline__ bool next(int i, Unit& u) const {
        const long L = (long)i * G + c; if (L >= (long)nwg * ((MK_DUP & 2) ? 2 : 1)) return false;
        int wgid = (int)(L % nwg); { const int q = nwg / NXCD, r = nwg % NXCD, xcd = wgid % NXCD, off = wgid / NXCD; wgid = (xcd < r ? xcd * (q + 1) : r * (q + 1) + (xcd - r) * q) + off; }
        const int nig = WGM * nN, gid = wgid / nig, fm = gid * WGM, gsz = (nM - fm) < WGM ? (nM - fm) : WGM;
        const int pm = fm + ((wgid % nig) % gsz), pn = (wgid % nig) / gsz;
        u.aoff = (unsigned)pm * am; u.boff = (unsigned)pn * bn; u.crow = pm * BM; u.ccol = pn * BM; u.z = 0; return true;
    }
};
struct MemKVSched {
    int c, first;
    __device__ __forceinline__ bool next(int i, Unit& u) const {
        const int L = c - first; if (i != 0 || L < 0 || L >= 64) return false;
        const int z = L >> 4, pm = (L >> 3) & 1, pn = L & 7;
        u.aoff = (unsigned)(pm * 256 * 1024); u.boff = (unsigned)((z * 2048 + pn * 256) * 1024); u.crow = pm * 256; u.ccol = pn * 256; u.z = z; return true;
    }
};
struct MemSSched {
    int c, layer;
    __device__ __forceinline__ bool next(int i, Unit& u) const {
        if (i >= ((MK_DUP & 4) ? 2 : 1) || c >= 256) return false;
        const int b = c >> 7, h = (c >> 5) & 3, pm = c & 31;
        u.aoff = (unsigned)((b * SEQ + pm * 256) * 1024 + h * 256); u.boff = (unsigned)((layer * 512 + b * 256) * 1024 + h * 256);
        u.crow = b * SEQ + pm * 256; u.ccol = h * 256; u.z = 0; return true;
    }
};
struct MemPVSched {
    int c, layer;
    __device__ __forceinline__ bool next(int i, Unit& u) const {
        if (i >= ((MK_DUP & 4) ? 2 : 1) || c >= 256) return false;
        const int b = c >> 7, h = (c >> 5) & 3, pm = c & 31;
        u.aoff = (unsigned)((b * SEQ + pm * 256) * 1024 + h * 256); u.boff = (unsigned)((layer * 1024 + h * 256) * 512 + b * 256);
        u.crow = b * SEQ + pm * 256; u.ccol = h * 256; u.z = 0; return true;
    }
};

struct EpiBf16 {
    static constexpr bool PERM = true, AFTER_DRAIN = false;
    bf16_t* O; int ldc;
    __device__ __forceinline__ void operator()(const f32x4 (&acc)[2][2][4][2], const Unit& u, int wr, int wc, int fr, int fq) const {
        const int row0 = u.crow + wr * 64 + fr, col0 = u.ccol + wc * 32 + 8 * fq;
#pragma unroll
        for (int ai = 0; ai < 2; ++ai)
#pragma unroll
            for (int m = 0; m < 4; ++m) { bf16_t* rowp = O + (size_t)(row0 + ai * HALF + m * 16) * ldc + col0;
#pragma unroll
                for (int bj = 0; bj < 2; ++bj) { const f32x4 v0 = acc[ai][bj][m][0], v1 = acc[ai][bj][m][1];
                    u32x4 w; w.x = cvt_pk_bf16(v0[0], v0[1]); w.y = cvt_pk_bf16(v0[2], v0[3]); w.z = cvt_pk_bf16(v1[0], v1[1]); w.w = cvt_pk_bf16(v1[2], v1[3]);
                    st_wt16(rowp + bj * HALF, w); } }
    }
};
struct EpiExp {
    static constexpr bool PERM = true, AFTER_DRAIN = false;
    bf16_t* O; int ldc; float scale_l2; LAS float* RS;
    __device__ __forceinline__ void operator()(const f32x4 (&acc)[2][2][4][2], const Unit& u, int wr, int wc, int fr, int fq) const {
        const int row0 = u.crow + wr * 64 + fr, col0 = u.ccol + wc * 32 + 8 * fq;
#pragma unroll
        for (int ai = 0; ai < 2; ++ai)
#pragma unroll
            for (int m = 0; m < 4; ++m) { bf16_t* rowp = O + (size_t)(row0 + ai * HALF + m * 16) * ldc + col0; float rs = 0.f;
#pragma unroll
                for (int bj = 0; bj < 2; ++bj) { f32x4 v0 = acc[ai][bj][m][0], v1 = acc[ai][bj][m][1];
#pragma unroll
                    for (int e = 0; e < 4; ++e) { v0[e] = __builtin_amdgcn_exp2f(fminf(fmaxf(v0[e] * scale_l2, -100.f), 100.f)); v1[e] = __builtin_amdgcn_exp2f(fminf(fmaxf(v1[e] * scale_l2, -100.f), 100.f)); }
                    rs += ((v0[0] + v0[1]) + (v0[2] + v0[3])) + ((v1[0] + v1[1]) + (v1[2] + v1[3]));
                    u32x4 w; w.x = cvt_pk_bf16(v0[0], v0[1]); w.y = cvt_pk_bf16(v0[2], v0[3]); w.z = cvt_pk_bf16(v1[0], v1[1]); w.w = cvt_pk_bf16(v1[2], v1[3]);
                    *(u32x4*)(rowp + bj * HALF) = w; }
                rs += __shfl_xor(rs, 16); rs += __shfl_xor(rs, 32);
                if (fq == 0) RS[wc * 256 + ai * HALF + wr * 64 + m * 16 + fr] = rs; }
    }
};
struct EpiBf16Scale {
    static constexpr bool PERM = true, AFTER_DRAIN = false;
    bf16_t* O; int ldc; const LAS float* RS;
    __device__ __forceinline__ void operator()(const f32x4 (&acc)[2][2][4][2], const Unit& u, int wr, int wc, int fr, int fq) const {
        const int row0 = u.crow + wr * 64 + fr, col0 = u.ccol + wc * 32 + 8 * fq;
#pragma unroll
        for (int ai = 0; ai < 2; ++ai)
#pragma unroll
            for (int m = 0; m < 4; ++m) { bf16_t* rowp = O + (size_t)(row0 + ai * HALF + m * 16) * ldc + col0; const int tr = ai * HALF + wr * 64 + m * 16 + fr;
                const float inv = 1.f / ((RS[tr] + RS[256 + tr]) + (RS[512 + tr] + RS[768 + tr]));
#pragma unroll
                for (int bj = 0; bj < 2; ++bj) { const f32x4 v0 = acc[ai][bj][m][0] * inv, v1 = acc[ai][bj][m][1] * inv;
                    u32x4 w; w.x = cvt_pk_bf16(v0[0], v0[1]); w.y = cvt_pk_bf16(v0[2], v0[3]); w.z = cvt_pk_bf16(v1[0], v1[1]); w.w = cvt_pk_bf16(v1[2], v1[3]);
                    st_wt16(rowp + bj * HALF, w); } }
    }
};
struct EpiF32 {
    static constexpr bool PERM = false, AFTER_DRAIN = false;
    float* C; int ldc;
    __device__ __forceinline__ void operator()(const f32x4 (&acc)[2][2][4][2], const Unit& u, int wr, int wc, int fr, int fq) const {
        const int row0 = u.crow + wr * 64 + fr, col0 = u.ccol + wc * 32 + 4 * fq;
#pragma unroll
        for (int ai = 0; ai < 2; ++ai)
#pragma unroll
            for (int m = 0; m < 4; ++m) { float* rowp = C + (size_t)(row0 + ai * HALF + m * 16) * ldc + col0;
#pragma unroll
                for (int bj = 0; bj < 2; ++bj)
#pragma unroll
                    for (int n = 0; n < 2; ++n) *(f32x4*)(rowp + bj * HALF + n * 16) = acc[ai][bj][m][n]; }
    }
};
struct EpiMemKV {
    static constexpr bool PERM = false, AFTER_DRAIN = false;
    float* outK; float* outV; bf16_t* MK; bf16_t* MVT;
    __device__ __forceinline__ void operator()(const f32x4 (&acc)[2][2][4][2], const Unit& u, int wr, int wc, int fr, int fq) const {
        const int row0 = u.crow + wr * 64 + fr; const bool isV = u.ccol >= 1024; const int col0 = (isV ? u.ccol - 1024 : u.ccol) + wc * 32 + 4 * fq;
        float* C = (isV ? outV : outK) + (size_t)u.z * 512 * 1024;
#pragma unroll
        for (int ai = 0; ai < 2; ++ai)
#pragma unroll
            for (int m = 0; m < 4; ++m) { const int row = row0 + ai * HALF + m * 16;
#pragma unroll
                for (int bj = 0; bj < 2; ++bj)
#pragma unroll
                    for (int n = 0; n < 2; ++n) { const f32x4 v = acc[ai][bj][m][n]; const int col = col0 + bj * HALF + n * 16;
                        *(f32x4*)(C + (size_t)row * 1024 + col) = v;
                        if (!isV) { u32x2 w; w.x = cvt_pk_bf16(v[0], v[1]); w.y = cvt_pk_bf16(v[2], v[3]); *(u32x2*)(MK + ((size_t)u.z * 512 + row) * 1024 + col) = w; }
                        else {
#pragma unroll
                            for (int e = 0; e < 4; ++e) MVT[((size_t)u.z * 1024 + col + e) * 512 + row] = (bf16_t)f2bf(v[e]); } } }
    }
};
struct EpiSoftmax {
    static constexpr bool PERM = true, AFTER_DRAIN = true;
    bf16_t* P; int ldc; float scale_l2;
    __device__ __forceinline__ void fused(f32x4 (&acc)[2][2][4][2], const Unit& u, int wr, int wc, int fr, int fq, LAS unsigned char* lds, int wid, int lane) const {
        LAS f32x2* TAB = (LAS f32x2*)lds;
        float mw[2][4];
#pragma unroll
        for (int ai = 0; ai < 2; ++ai)
#pragma unroll
            for (int m = 0; m < 4; ++m) {
                float mx = -3.0e38f;
#pragma unroll
                for (int bj = 0; bj < 2; ++bj)
#pragma unroll
                    for (int n = 0; n < 2; ++n) { f32x4 x = acc[ai][bj][m][n] * scale_l2; acc[ai][bj][m][n] = x; mx = fmaxf(mx, fmaxf(fmaxf(x[0], x[1]), fmaxf(x[2], x[3]))); }
                mx = fmaxf(mx, __shfl_xor(mx, 16)); mx = fmaxf(mx, __shfl_xor(mx, 32));
                float s = 0.f;
#pragma unroll
                for (int bj = 0; bj < 2; ++bj)
#pragma unroll
                    for (int n = 0; n < 2; ++n) { f32x4 x = acc[ai][bj][m][n]; x[0] = __builtin_amdgcn_exp2f(x[0] - mx); x[1] = __builtin_amdgcn_exp2f(x[1] - mx); x[2] = __builtin_amdgcn_exp2f(x[2] - mx); x[3] = __builtin_amdgcn_exp2f(x[3] - mx);
                        acc[ai][bj][m][n] = x; s += (x[0] + x[1]) + (x[2] + x[3]); }
                s += __shfl_xor(s, 16); s += __shfl_xor(s, 32);
                mw[ai][m] = mx;
                if (fq == 0) TAB[(ai * HALF + wr * 64 + m * 16 + fr) * 4 + wc] = (f32x2){mx, s};
            }
        asm volatile("s_waitcnt lgkmcnt(0)" ::: "memory"); __builtin_amdgcn_s_barrier(); asm volatile("" ::: "memory");
        const int row0 = u.crow + wr * 64 + fr, col0 = u.ccol + wc * 32 + 8 * fq;
#pragma unroll
        for (int ai = 0; ai < 2; ++ai)
#pragma unroll
            for (int m = 0; m < 4; ++m) {
                const int r = ai * HALF + wr * 64 + m * 16 + fr;
                const f32x2 t0 = TAB[r * 4 + 0], t1 = TAB[r * 4 + 1], t2 = TAB[r * 4 + 2], t3 = TAB[r * 4 + 3];
                const float M = fmaxf(fmaxf(t0.x, t1.x), fmaxf(t2.x, t3.x));
                const float L = t0.y * __builtin_amdgcn_exp2f(t0.x - M) + t1.y * __builtin_amdgcn_exp2f(t1.x - M) + t2.y * __builtin_amdgcn_exp2f(t2.x - M) + t3.y * __builtin_amdgcn_exp2f(t3.x - M);
                const float f = __builtin_amdgcn_exp2f(mw[ai][m] - M) / L;
                bf16_t* rowp = P + (size_t)(row0 + ai * HALF + m * 16) * ldc + col0;
#pragma unroll
                for (int bj = 0; bj < 2; ++bj) { const f32x4 v0 = acc[ai][bj][m][0] * f, v1 = acc[ai][bj][m][1] * f;
                    u32x4 w; w.x = cvt_pk_bf16(v0[0], v0[1]); w.y = cvt_pk_bf16(v0[2], v0[3]); w.z = cvt_pk_bf16(v1[0], v1[1]); w.w = cvt_pk_bf16(v1[2], v1[3]);
                    *(u32x4*)(rowp + bj * HALF) = w; }
            }
        asm volatile("s_waitcnt lgkmcnt(0)" ::: "memory"); __builtin_amdgcn_s_barrier(); asm volatile("" ::: "memory");
    }
};
}

constexpr int NWAVES = 8, NTHREADS = 512;
struct Args { const float* in[23]; float* out; unsigned char* ws; int ph_lo, ph_hi; };
struct Frame { LAS unsigned char* lds; int tid, lane, wave, G, bid; };

struct TrItem { const float* src; bf16_t* dst; int N; };
__device__ __forceinline__ void tr_load(const TrItem& t, float (&wv)[32], int lane) {
#pragma unroll
    for (int i = 0; i < 32; ++i) { const int kk = 2 * i + (lane >> 5); wv[i] = t.src[(size_t)kk * t.N + (lane & 31)]; }
}
__device__ __forceinline__ void tr_process(const TrItem& t, const float (&wv)[32], LAS float* scr, int lane) {
#pragma unroll
    for (int i = 0; i < 32; ++i) { const int kk = 2 * i + (lane >> 5); scr[kk * 33 + (lane & 31)] = wv[i]; }
    LDS_WAIT(); asm volatile("" ::: "memory");
    const int c = lane & 7;
#pragma unroll
    for (int j = 0; j < 4; ++j) { const int n = (lane >> 3) + 8 * j; const LAS float* s = scr + (8 * c) * 33 + n;
        u32x4 o; o.x = pk2(s[0 * 33], s[1 * 33]); o.y = pk2(s[2 * 33], s[3 * 33]); o.z = pk2(s[4 * 33], s[5 * 33]); o.w = pk2(s[6 * 33], s[7 * 33]);
        *(u32x4*)(t.dst + (size_t)n * 1024 + 8 * c) = o; }
    LDS_WAIT(); asm volatile("" ::: "memory");
}
__device__ __forceinline__ void cvt_bf16_range(const float* src, bf16_t* dst, size_t n, size_t gtid, size_t nthr) {
    size_t i = gtid * 8;
#pragma unroll 1
    for (; i + 3 * nthr * 8 < n; i += 4 * nthr * 8) {
        f32x4 a[4], b[4];
#pragma unroll
        for (int j = 0; j < 4; ++j) { a[j] = *(const f32x4*)(src + i + j * nthr * 8); b[j] = *(const f32x4*)(src + i + j * nthr * 8 + 4); }
#pragma unroll
        for (int j = 0; j < 4; ++j) { u32x4 o; o.x = pk2(a[j][0], a[j][1]); o.y = pk2(a[j][2], a[j][3]); o.z = pk2(b[j][0], b[j][1]); o.w = pk2(b[j][2], b[j][3]); *(u32x4*)(dst + i + j * nthr * 8) = o; }
    }
    for (; i < n; i += nthr * 8) { const f32x4 a = *(const f32x4*)(src + i), b = *(const f32x4*)(src + i + 4);
        u32x4 o; o.x = pk2(a[0], a[1]); o.y = pk2(a[2], a[3]); o.z = pk2(b[0], b[1]); o.w = pk2(b[2], b[3]); *(u32x4*)(dst + i) = o; }
}
__device__ __forceinline__ unsigned pack_fp8x4(f32x4 a, float sc) {
    int p = __builtin_amdgcn_cvt_pk_fp8_f32(a[0] * sc, a[1] * sc, 0, false);
    p = __builtin_amdgcn_cvt_pk_fp8_f32(a[2] * sc, a[3] * sc, p, true);
    return (unsigned)p;
}
constexpr float SU4 = 88.9f, SX4 = 2.78f;
__device__ __forceinline__ unsigned pack_i4x8(f32x4 a, f32x4 b, float sc) {
    unsigned r = 0;
#pragma unroll
    for (int e = 0; e < 4; ++e) { const int qa = (int)__builtin_rintf(fminf(fmaxf(a[e] * sc, -7.f), 7.f)), qb = (int)__builtin_rintf(fminf(fmaxf(b[e] * sc, -7.f), 7.f));
        r |= ((unsigned)qa & 0xfu) << (4 * e); r |= ((unsigned)qb & 0xfu) << (16 + 4 * e); }
    return r;
}
__device__ __forceinline__ void cvt_i4_range(const float* src, unsigned char* dst  , size_t n, float sc, size_t gtid, size_t nthr) {
    for (size_t i = gtid * 32; i < n; i += nthr * 32) {
        f32x4 v[8];
#pragma unroll
        for (int k = 0; k < 8; ++k) v[k] = __builtin_nontemporal_load((const f32x4*)(src + i + 4 * k));
        u32x4 o; o.x = pack_i4x8(v[0], v[1], sc); o.y = pack_i4x8(v[2], v[3], sc); o.z = pack_i4x8(v[4], v[5], sc); o.w = pack_i4x8(v[6], v[7], sc); *(u32x4*)(dst + i / 2) = o; }
}
__device__ __forceinline__ unsigned pack_i8x4(f32x4 a, float sc) {
    unsigned r = 0;
#pragma unroll
    for (int e = 0; e < 4; ++e) { const int q = (int)__builtin_rintf(fminf(fmaxf(a[e] * sc, -127.f), 127.f)); r |= ((unsigned)q & 0xffu) << (8 * e); }
    return r;
}
__device__ __forceinline__ void cvt_i8_range(const float* src, unsigned char* dst, size_t n, float sc, size_t gtid, size_t nthr) {
    for (size_t i = gtid * 16; i < n; i += nthr * 16) {
        const f32x4 a = __builtin_nontemporal_load((const f32x4*)(src + i)), b = __builtin_nontemporal_load((const f32x4*)(src + i + 4)),
                    c = __builtin_nontemporal_load((const f32x4*)(src + i + 8)), d = __builtin_nontemporal_load((const f32x4*)(src + i + 12));
        u32x4 o; o.x = pack_i8x4(a, sc); o.y = pack_i8x4(b, sc); o.z = pack_i8x4(c, sc); o.w = pack_i8x4(d, sc); *(u32x4*)(dst + i) = o; }
}
__device__ __forceinline__ void cvt_fp8_range(const float* src, unsigned char* dst, size_t n, float sc, size_t gtid, size_t nthr) {
    for (size_t i = gtid * 16; i < n; i += nthr * 16) {
        const f32x4 a = __builtin_nontemporal_load((const f32x4*)(src + i)), b = __builtin_nontemporal_load((const f32x4*)(src + i + 4)),
                    c = __builtin_nontemporal_load((const f32x4*)(src + i + 8)), d = __builtin_nontemporal_load((const f32x4*)(src + i + 12));
        u32x4 o; o.x = pack_fp8x4(a, sc); o.y = pack_fp8x4(b, sc); o.z = pack_fp8x4(c, sc); o.w = pack_fp8x4(d, sc); *(u32x4*)(dst + i) = o; }
}
__device__ __forceinline__ void p0_prologue(const Frame& F, const Args& A) {
    unsigned char* ws = A.ws;
    LAS float* scr = (LAS float*)(F.lds + F.wave * 16384);
    const int gw = F.bid * NWAVES + F.wave, NGW = F.G * NWAVES;
    constexpr int NITEMS = 2 * 768 + 2 * 512 + 2 * 1536 + 2 * 512 + 4 * 512 + 4 * 1024 + 4 * 512 + 4 * 1024;
#define TR_GROUP(t, SRC, DSTOFF, NL, NN) if (!found) { constexpr int IT = 16 * ((NN) / 32); if (r < (NL) * IT) { const int l = r / IT, it2 = r % IT, kb = it2 / ((NN) / 32), nb = it2 % ((NN) / 32); \
        t.src = (SRC) + (size_t)l * 1024 * (NN) + (size_t)(64 * kb) * (NN) + 32 * nb; t.dst = (bf16_t*)(ws + (DSTOFF)) + (size_t)l * (NN) * 1024 + (size_t)(32 * nb) * 1024 + 64 * kb; t.N = (NN); found = true; } else r -= (NL) * IT; }
#define TR_LOCATE(it_, t) do { int r = (it_); bool found = false; \
        TR_GROUP(t, A.in[8], WS_WQKV, 2, 1536) TR_GROUP(t, A.in[10], WS_WO, 2, 1024) TR_GROUP(t, A.in[11], WS_WIN, 2, 3072) TR_GROUP(t, A.in[13], WS_WOUT, 2, 1024) \
        TR_GROUP(t, A.in[14], WS_WMQ, 4, 1024) TR_GROUP(t, A.in[15], WS_WMKV, 4, 2048) TR_GROUP(t, A.in[16], WS_WMO, 4, 1024) TR_GROUP(t, A.in[17], WS_WPQ, 4, 2048) } while (0)
    if (gw < NITEMS) {
        TrItem cur, nxt; float wa[32], wb[32];
        TR_LOCATE(gw, cur); tr_load(cur, wa, F.lane);
#pragma unroll 1
        for (int it = gw; it < NITEMS; it += NGW) {
            const bool has = (it + NGW < NITEMS);
            if (has) { TR_LOCATE(it + NGW, nxt); tr_load(nxt, wb, F.lane); }
            tr_process(cur, wa, scr, F.lane);
            if (has) { cur = nxt;
#pragma unroll
                for (int i = 0; i < 32; ++i) wa[i] = wb[i]; }
        }
    }
#undef TR_LOCATE
#undef TR_GROUP
    const size_t gtid = (size_t)F.bid * NTHREADS + F.tid, nthr = (size_t)F.G * NTHREADS;
    cvt_bf16_range(A.in[18], (bf16_t*)(ws + WS_SUBK), (size_t)NLAYER * 2 * 128 * 128, gtid, nthr);
    cvt_bf16_range(A.in[7], (bf16_t*)(ws + WS_MEMB), (size_t)512 * 1024, gtid, nthr);
    cvt_bf16_range(A.in[0], (bf16_t*)(ws + WS_XB), (size_t)TP * D, gtid, nthr);
    cvt_bf16_range(A.in[1], (bf16_t*)(ws + WS_XB) + (size_t)TP * D, (size_t)TS * D, gtid, nthr);
}

template <bool FIRST>
__device__ __forceinline__ void ln_phase(const Frame& F, const float* xa, const float* xb, const bf16_t* XBin, const bf16_t* Fb, const float* gam, const float* bet,
                                         bf16_t* XB, unsigned char* X8  , float* YOUT  ) {
    const int gw = F.bid * NWAVES + F.wave, NGW = F.G * NWAVES, lane = F.lane;
    f32x4 gv[4], bv[4];
#define LN_COL(i) (8 * lane + 512 * ((i) >> 1) + 4 * ((i) & 1))
#pragma unroll
    for (int i = 0; i < 4; ++i) { gv[i] = *(const f32x4*)(gam + LN_COL(i)); bv[i] = *(const f32x4*)(bet + LN_COL(i)); }
    if (gw >= T) return;
#define LN_LOADX(dst, r_) do { if (FIRST) { const float* xr_ = ((r_) < TP) ? xa + (size_t)(r_) * D : xb + (size_t)((r_) - TP) * D; \
            _Pragma("unroll") for (int i = 0; i < 4; ++i) dst[i] = *(const f32x4*)(xr_ + LN_COL(i)); } \
        else { _Pragma("unroll") for (int j = 0; j < 2; ++j) { const u32x4 w_ = *(const u32x4*)(XBin + (size_t)(r_) * D + 8 * lane + 512 * j); \
            dst[2 * j] = (f32x4){bflo(w_.x), bfhi(w_.x), bflo(w_.y), bfhi(w_.y)}; dst[2 * j + 1] = (f32x4){bflo(w_.z), bfhi(w_.z), bflo(w_.w), bfhi(w_.w)}; } } } while (0)
    f32x4 xc[4]; u32x4 fc[2];
    LN_LOADX(xc, gw);
#pragma unroll
    for (int j = 0; j < 2; ++j) fc[j] = *(const u32x4*)(Fb + (size_t)gw * D + 8 * lane + 512 * j);
#pragma unroll 1
    for (int r = gw; r < T; r += NGW) {
        const int rn = (r + NGW < T) ? r + NGW : r;
        f32x4 xn[4]; u32x4 fn[2];
        LN_LOADX(xn, rn);
#pragma unroll
        for (int j = 0; j < 2; ++j) fn[j] = *(const u32x4*)(Fb + (size_t)rn * D + 8 * lane + 512 * j);
        f32x4 v[4]; float s = 0.f;
#pragma unroll
        for (int j = 0; j < 2; ++j) { const f32x4 f0 = (f32x4){bflo(fc[j].x), bfhi(fc[j].x), bflo(fc[j].y), bfhi(fc[j].y)}, f1 = (f32x4){bflo(fc[j].z), bfhi(fc[j].z), bflo(fc[j].w), bfhi(fc[j].w)};
            v[2 * j] = xc[2 * j] * DN_ALPHA + f0; v[2 * j + 1] = xc[2 * j + 1] * DN_ALPHA + f1; }
#pragma unroll
        for (int i = 0; i < 4; ++i) s += (v[i][0] + v[i][1]) + (v[i][2] + v[i][3]);
        const float mean = wave_sum(s) * (1.f / D); float s2 = 0.f;
#pragma unroll
        for (int i = 0; i < 4; ++i) { v[i] = v[i] - mean; s2 += (v[i][0] * v[i][0] + v[i][1] * v[i][1]) + (v[i][2] * v[i][2] + v[i][3] * v[i][3]); }
        const float rstd = 1.f / sqrtf(wave_sum(s2) * (1.f / D) + LN_EPS);
        f32x4 y[4];
#pragma unroll
        for (int i = 0; i < 4; ++i) { y[i] = v[i] * rstd * gv[i] + bv[i]; if (YOUT) *(f32x4*)(YOUT + (size_t)r * D + LN_COL(i)) = y[i]; }
#pragma unroll
        for (int j = 0; j < 2; ++j) {
            u32x4 w; w.x = pk2(y[2 * j][0], y[2 * j][1]); w.y = pk2(y[2 * j][2], y[2 * j][3]); w.z = pk2(y[2 * j + 1][0], y[2 * j + 1][1]); w.w = pk2(y[2 * j + 1][2], y[2 * j + 1][3]);
            st_wt16(XB + (size_t)r * D + 8 * lane + 512 * j, w);
            if (X8) *(unsigned*)(X8 + (size_t)r * (D / 2) + 4 * lane + 256 * j) = pack_i4x8(y[2 * j], y[2 * j + 1], SX4); }
#pragma unroll
        for (int i = 0; i < 4; ++i) xc[i] = xn[i];
#pragma unroll
        for (int j = 0; j < 2; ++j) fc[j] = fn[j];
    }
#undef LN_LOADX
#undef LN_COL
}

__device__ __forceinline__ void load_u8(const bf16_t* BIG, int row, int c0, float (&u)[8]) {
    const u32x4 gc = *(const u32x4*)(BIG + (size_t)row * 3072 + 1024 + c0), h = *(const u32x4*)(BIG + (size_t)row * 3072 + 2048 + c0);
#pragma unroll
    for (int e = 0; e < 4; ++e) { u[2 * e] = bflo(gc[e]) * bflo(h[e]); u[2 * e + 1] = bfhi(gc[e]) * bfhi(h[e]); }
}
__device__ __forceinline__ void conv_rows_generic(const Frame& F, const bf16_t* BIG, bf16_t* OB, const float* cw  , const float* state  , float* cvp  , float* cvs  , size_t idx_lo, size_t idx_hi) {
    const size_t gtid = (size_t)F.bid * NTHREADS + F.tid, nthr = (size_t)F.G * NTHREADS;
    for (size_t idx = idx_lo + gtid; idx < idx_hi; idx += nthr) {
        const int r = (int)(idx >> 7), c0 = (int)(idx & 127) * 8;
        float u0[8], um1[8], um2[8];
        load_u8(BIG, r, c0, u0);
        if (r < TP) {
            const int t = r & (SEQ - 1), b = r >> 13;
            if (t >= 1) load_u8(BIG, r - 1, c0, um1); else {
#pragma unroll
                for (int e = 0; e < 8; ++e) um1[e] = 0.f; }
            if (t >= 2) load_u8(BIG, r - 2, c0, um2); else {
#pragma unroll
                for (int e = 0; e < 8; ++e) um2[e] = 0.f; }
            if (t >= SEQ - 2) { float* o = cvp + ((size_t)b * 2 + (t - (SEQ - 2))) * D + c0; *(f32x4*)o = (f32x4){u0[0], u0[1], u0[2], u0[3]}; *(f32x4*)(o + 4) = (f32x4){u0[4], u0[5], u0[6], u0[7]}; }
        } else {
            const int rr = r - TP, b = rr >> 2, l = rr & 3;
            const float* st = state + (size_t)b * 2 * D + c0;
            if (l >= 1) load_u8(BIG, r - 1, c0, um1); else { const f32x4 a = *(const f32x4*)(st + D), c = *(const f32x4*)(st + D + 4);
#pragma unroll
                for (int e = 0; e < 4; ++e) { um1[e] = a[e]; um1[4 + e] = c[e]; } }
            if (l >= 2) load_u8(BIG, r - 2, c0, um2); else { const f32x4 a = *(const f32x4*)(st + (size_t)l * D), c = *(const f32x4*)(st + (size_t)l * D + 4);
#pragma unroll
                for (int e = 0; e < 4; ++e) { um2[e] = a[e]; um2[4 + e] = c[e]; } }
            if (l >= 2) { float* o = cvs + ((size_t)b * 2 + (l - 2)) * D + c0; *(f32x4*)o = (f32x4){u0[0], u0[1], u0[2], u0[3]}; *(f32x4*)(o + 4) = (f32x4){u0[4], u0[5], u0[6], u0[7]}; }
        }
        const u32x4 gb = *(const u32x4*)(BIG + (size_t)r * 3072 + c0);
        float w0[8], w1[8], w2[8];
#pragma unroll
        for (int e = 0; e < 2; ++e) { const f32x4 a = *(const f32x4*)(cw + c0 + 4 * e), b2 = *(const f32x4*)(cw + D + c0 + 4 * e), c = *(const f32x4*)(cw + 2 * D + c0 + 4 * e);
#pragma unroll
            for (int q = 0; q < 4; ++q) { w0[4 * e + q] = a[q]; w1[4 * e + q] = b2[q]; w2[4 * e + q] = c[q]; } }
        float y[8];
#pragma unroll
        for (int e = 0; e < 8; ++e) { const float z = w0[e] * um2[e] + w1[e] * um1[e] + w2[e] * u0[e]; const float g = (e & 1) ? bfhi(gb[e >> 1]) : bflo(gb[e >> 1]); y[e] = g * z; }
        u32x4 o; o.x = pk2(y[0], y[1]); o.y = pk2(y[2], y[3]); o.z = pk2(y[4], y[5]); o.w = pk2(y[6], y[7]);
        st_wt16(OB + (size_t)r * D + c0, o);
    }
}

__device__ __forceinline__ void conv_phase(const Frame& F, const bf16_t* BIG, bf16_t* OB, const float* cw  , const float* state  , float* cvp  , float* cvs  ) {
    const int gtid = F.bid * NTHREADS + F.tid, nthr = F.G * NTHREADS;
    if ((nthr & 127) == 0) {
        const int c0 = (gtid & 127) * 8, r0 = gtid >> 7, rstep = nthr >> 7;
        float w0[8], w1[8], w2[8];
#pragma unroll
        for (int e = 0; e < 2; ++e) { const f32x4 a = *(const f32x4*)(cw + c0 + 4 * e), b2 = *(const f32x4*)(cw + D + c0 + 4 * e), c = *(const f32x4*)(cw + 2 * D + c0 + 4 * e);
#pragma unroll
            for (int q = 0; q < 4; ++q) { w0[4 * e + q] = a[q]; w1[4 * e + q] = b2[q]; w2[4 * e + q] = c[q]; } }
#define CV_LD(R, r_) do { const int t_ = (r_) & (SEQ - 1); const int r1_ = (t_ >= 1) ? (r_) - 1 : (r_), r2_ = (t_ >= 2) ? (r_) - 2 : (r_); \
            R[0] = *(const u32x4*)(BIG + (size_t)(r_) * 3072 + c0); R[1] = *(const u32x4*)(BIG + (size_t)(r_) * 3072 + 1024 + c0); R[2] = *(const u32x4*)(BIG + (size_t)(r_) * 3072 + 2048 + c0); \
            R[3] = *(const u32x4*)(BIG + (size_t)r1_ * 3072 + 1024 + c0); R[4] = *(const u32x4*)(BIG + (size_t)r1_ * 3072 + 2048 + c0); \
            R[5] = *(const u32x4*)(BIG + (size_t)r2_ * 3072 + 1024 + c0); R[6] = *(const u32x4*)(BIG + (size_t)r2_ * 3072 + 2048 + c0); } while (0)
#define CV_FIN(R, r_) do { const int t_ = (r_) & (SEQ - 1), b_ = (r_) >> 13; const float m1_ = (t_ >= 1) ? 1.f : 0.f, m2_ = (t_ >= 2) ? 1.f : 0.f; float u0_[8], y_[8]; \
            _Pragma("unroll") for (int e = 0; e < 4; ++e) { \
                u0_[2 * e] = bflo(R[1][e]) * bflo(R[2][e]); u0_[2 * e + 1] = bfhi(R[1][e]) * bfhi(R[2][e]); \
                const float a1_ = bflo(R[3][e]) * bflo(R[4][e]) * m1_, b1_ = bfhi(R[3][e]) * bfhi(R[4][e]) * m1_, a2_ = bflo(R[5][e]) * bflo(R[6][e]) * m2_, b2_ = bfhi(R[5][e]) * bfhi(R[6][e]) * m2_; \
                y_[2 * e] = bflo(R[0][e]) * (w0[2 * e] * a2_ + w1[2 * e] * a1_ + w2[2 * e] * u0_[2 * e]); y_[2 * e + 1] = bfhi(R[0][e]) * (w0[2 * e + 1] * b2_ + w1[2 * e + 1] * b1_ + w2[2 * e + 1] * u0_[2 * e + 1]); } \
            if (t_ >= SEQ - 2) { float* o_ = cvp + ((size_t)b_ * 2 + (t_ - (SEQ - 2))) * D + c0; *(f32x4*)o_ = (f32x4){u0_[0], u0_[1], u0_[2], u0_[3]}; *(f32x4*)(o_ + 4) = (f32x4){u0_[4], u0_[5], u0_[6], u0_[7]}; } \
            u32x4 o4_; o4_.x = pk2(y_[0], y_[1]); o4_.y = pk2(y_[2], y_[3]); o4_.z = pk2(y_[4], y_[5]); o4_.w = pk2(y_[6], y_[7]); st_wt16(OB + (size_t)(r_) * D + c0, o4_); } while (0)
#pragma unroll 1
        for (int r = r0; r < TP; r += 2 * rstep) {
            const int rb = r + rstep; const bool hasb = rb < TP; const int rbc = hasb ? rb : r;
            u32x4 Ra[7], Rb[7];
            CV_LD(Ra, r); CV_LD(Rb, rbc);
            CV_FIN(Ra, r);
            if (hasb) CV_FIN(Rb, rb);
        }
#undef CV_LD
#undef CV_FIN
        conv_rows_generic(F, BIG, OB, cw, state, cvp, cvs, (size_t)TP * 128, (size_t)T * 128);
    } else conv_rows_generic(F, BIG, OB, cw, state, cvp, cvs, 0, (size_t)T * 128);
}

__device__ __forceinline__ void cvt_tables_part(const Frame& F, const Args& A, unsigned char* ws, int layer, int q) {
    if (F.bid < 8) return;
    const size_t n = (size_t)NEXP * D, b0 = (n * q / 3) & ~(size_t)31, b1 = (q == 2) ? n : ((n * (q + 1) / 3) & ~(size_t)31);
    const size_t gtid = (size_t)(F.bid - 8) * NTHREADS + F.tid, nthr = (size_t)(F.G - 8) * NTHREADS;
    cvt_i4_range(A.in[19] + (size_t)layer * n + b0, ws + WS_PU8 + ((size_t)layer * n + b0) / 2, b1 - b0, SU4, gtid, nthr);
    cvt_fp8_range(A.in[20] + (size_t)layer * n + b0, ws + WS_PV8 + (size_t)layer * n + b0, b1 - b0, V_SCALE, gtid, nthr);
}
constexpr int MG_PITCH = 68;
constexpr int MG_WAVE  = 32 * MG_PITCH;
template <int N> __device__ __forceinline__ void mini_gemm(const Frame& F, const bf16_t* A, const bf16_t* Bt, bf16_t* C, int ldc) {
    constexpr int NC = N / 1024;
    if (F.bid >= 256) return;
    const int lane = F.lane, r = lane & 15, q = lane >> 4, rb = F.bid >> 4, cb = F.bid & 15, kw = F.wave;
    const int row0 = rb * 32, col0 = cb * (N / 16);
    const bf16_t* ap = A + (size_t)(row0 + r) * 1024 + kw * 128 + 8 * q;
    const bf16_t* bp = Bt + (size_t)(col0 + r) * 1024 + kw * 128 + 8 * q;
    LAS float* P = (LAS float*)F.lds;
    bf16x8 af[2][4], bfr[4][4];
#pragma unroll
    for (int m = 0; m < 2; ++m)
#pragma unroll
        for (int s = 0; s < 4; ++s) af[m][s] = *(const bf16x8*)(ap + (size_t)m * 16 * 1024 + 32 * s);
#pragma unroll
    for (int n = 0; n < 4; ++n)
#pragma unroll
        for (int s = 0; s < 4; ++s) bfr[n][s] = *(const bf16x8*)(bp + (size_t)n * 16 * 1024 + 32 * s);
    WG_BAR();
#pragma unroll 1
    for (int c = 0; c < NC; ++c) {
        f32x4 acc[2][4];
#pragma unroll
        for (int m = 0; m < 2; ++m)
#pragma unroll
            for (int n = 0; n < 4; ++n) acc[m][n] = (f32x4){0.f, 0.f, 0.f, 0.f};
#pragma unroll
        for (int s = 0; s < 4; ++s)
#pragma unroll
            for (int m = 0; m < 2; ++m)
#pragma unroll
                for (int n = 0; n < 4; ++n) acc[m][n] = __builtin_amdgcn_mfma_f32_16x16x32_bf16(af[m][s], bfr[n][s], acc[m][n], 0, 0, 0);
        if (c + 1 < NC) {
#pragma unroll
            for (int n = 0; n < 4; ++n)
#pragma unroll
                for (int s = 0; s < 4; ++s) bfr[n][s] = *(const bf16x8*)(bp + (size_t)((c + 1) * 64 + n * 16) * 1024 + 32 * s);
        }
#pragma unroll
        for (int m = 0; m < 2; ++m)
#pragma unroll
            for (int n = 0; n < 4; ++n)
#pragma unroll
                for (int e = 0; e < 4; ++e) P[kw * MG_WAVE + (16 * m + 4 * q + e) * MG_PITCH + 16 * n + r] = acc[m][n][e];
        WG_BAR();
        {
            const int row = F.tid >> 4, c4 = (F.tid & 15) * 4;
            f32x4 s4 = *(LAS f32x4*)(P + row * MG_PITCH + c4);
#pragma unroll
            for (int w = 1; w < 8; ++w) { const f32x4 t4 = *(LAS f32x4*)(P + w * MG_WAVE + row * MG_PITCH + c4); s4[0] += t4[0]; s4[1] += t4[1]; s4[2] += t4[2]; s4[3] += t4[3]; }
            u32x2 o; o.x = pk2(s4[0], s4[1]); o.y = pk2(s4[2], s4[3]);
            *(u32x2*)(C + (size_t)(row0 + row) * ldc + col0 + c * 64 + c4) = o;
        }
        if (c + 1 < NC) WG_BAR();
    }
}

constexpr int AT_KP = 72, AT_VP = 264;
__device__ __forceinline__ void attn_prompt_unit(const Frame& F, const bf16_t* BIG, bf16_t* OB, const float* sinks, float* wkp, float* wvp, int unit) {
    const int kvh = unit & 3, qb = (unit >> 2) & 63, b = unit >> 8;
    const int tid = F.tid, lane = F.lane, wave = F.wave;
    LAS bf16_t* Ks = (LAS bf16_t*)F.lds;
    LAS bf16_t* Vt = (LAS bf16_t*)(F.lds + 256 * AT_KP * 2);
#pragma unroll
    for (int it = 0; it < 4; ++it) {
        const int id = tid + 512 * it, row = id >> 3, c16 = id & 7, kpos = qb * 128 - 128 + row;
        u32x4 kv = (u32x4){0u, 0u, 0u, 0u}, vv = (u32x4){0u, 0u, 0u, 0u};
        if (kpos >= 0) { const bf16_t* src = BIG + (size_t)(b * SEQ + kpos) * QKVW + 1024 + kvh * 64 + c16 * 8; kv = *(const u32x4*)src; vv = *(const u32x4*)(src + 256); }
        *(LAS u32x4*)(Ks + row * AT_KP + c16 * 8) = kv;
#pragma unroll
        for (int e = 0; e < 4; ++e) { Vt[(c16 * 8 + 2 * e) * AT_VP + row] = (bf16_t)(vv[e] & 0xffffu); Vt[(c16 * 8 + 2 * e + 1) * AT_VP + row] = (bf16_t)(vv[e] >> 16); }
    }
    WG_BAR();
    const int g = wave >> 1, half = wave & 1, head = kvh * 4 + g, qi = lane & 15, q4 = lane >> 4;
    const float sinkl = sinks[head] * LOG2E;
    constexpr float SC = 0.125f * LOG2E;
#pragma unroll 1
    for (int qt = 0; qt < 4; ++qt) {
        const int i0 = half * 64 + qt * 16, i = i0 + qi;
        const bf16_t* qp = BIG + (size_t)(b * SEQ + qb * 128 + i) * QKVW + head * 64 + q4 * 8;
        const bf16x8 qf0 = *(const bf16x8*)qp, qf1 = *(const bf16x8*)(qp + 32);
        const int t0 = i0 >> 4, t0p = t0 < 6 ? t0 : 6, kt0 = 16 * t0p;
        f32x4 acc[10];
#pragma unroll
        for (int t = 0; t < 10; ++t) {
            const LAS bf16_t* kr = Ks + (kt0 + 16 * t + qi) * AT_KP + q4 * 8;
            const bf16x8 kf0 = *(const LAS bf16x8*)kr, kf1 = *(const LAS bf16x8*)(kr + 32);
            f32x4 a = (f32x4){0.f, 0.f, 0.f, 0.f};
            a = __builtin_amdgcn_mfma_f32_16x16x32_bf16(kf0, qf0, a, 0, 0, 0);
            a = __builtin_amdgcn_mfma_f32_16x16x32_bf16(kf1, qf1, a, 0, 0, 0);
            acc[t] = a;
        }
        float mx = -1.0e30f;
#pragma unroll
        for (int t = 0; t < 10; ++t) {
            const int kb = kt0 + 16 * t;
            const bool inside = (kb >= i0 + 15) && (kb + 15 <= i0 + 128) && (qb > 0 || kb >= 128);
            if (inside) {
#pragma unroll
                for (int r = 0; r < 4; ++r) mx = fmaxf(mx, acc[t][r]);
            } else {
#pragma unroll
                for (int r = 0; r < 4; ++r) { const int kk = kb + 4 * q4 + r; const bool ok = (kk >= i) && (kk <= i + 128) && (qb > 0 || kk >= 128);
                    const float s = ok ? acc[t][r] : -1.0e30f; acc[t][r] = s; mx = fmaxf(mx, s); }
            }
        }
        mx = fmaxf(mx, __shfl_xor(mx, 16)); mx = fmaxf(mx, __shfl_xor(mx, 32)); mx = fmaxf(mx * SC, sinkl);
        float sum = 0.f; const float nmx = -mx;
#pragma unroll
        for (int t = 0; t < 10; ++t) {
            const int kb = kt0 + 16 * t;
            const bool outside = (kb + 15 < i0) || (kb > i0 + 15 + 128);
            if (outside) { acc[t] = (f32x4){0.f, 0.f, 0.f, 0.f}; }
            else {
#pragma unroll
                for (int r = 0; r < 4; ++r) { const float p = __builtin_amdgcn_exp2f(__builtin_fmaf(acc[t][r], SC, nmx)); acc[t][r] = p; sum += p; } }
        }
        sum += __shfl_xor(sum, 16); sum += __shfl_xor(sum, 32);
        const float inv = 1.f / (sum + __builtin_amdgcn_exp2f(sinkl - mx));
        f32x4 o[4];
#pragma unroll
        for (int dt = 0; dt < 4; ++dt) o[dt] = (f32x4){0.f, 0.f, 0.f, 0.f};
#pragma unroll
        for (int s2 = 0; s2 < 5; ++s2) {
            u32x4 pw; pw.x = cvt_pk_bf16(acc[2 * s2][0], acc[2 * s2][1]); pw.y = cvt_pk_bf16(acc[2 * s2][2], acc[2 * s2][3]);
            pw.z = cvt_pk_bf16(acc[2 * s2 + 1][0], acc[2 * s2 + 1][1]); pw.w = cvt_pk_bf16(acc[2 * s2 + 1][2], acc[2 * s2 + 1][3]);
            const bf16x8 pf = __builtin_bit_cast(bf16x8, pw);
#pragma unroll
            for (int dt = 0; dt < 4; ++dt) {
                const LAS bf16_t* vr = Vt + (16 * dt + qi) * AT_VP + kt0 + 32 * s2 + 4 * q4;
                const u32x2 lo = *(const LAS u32x2*)vr, hi = *(const LAS u32x2*)(vr + 16);
                u32x4 vw; vw.x = lo.x; vw.y = lo.y; vw.z = hi.x; vw.w = hi.y;
                o[dt] = __builtin_amdgcn_mfma_f32_16x16x32_bf16(__builtin_bit_cast(bf16x8, vw), pf, o[dt], 0, 0, 0);
            }
        }
        bf16_t* op = OB + (size_t)(b * SEQ + qb * 128 + i) * D + head * 64 + 4 * q4;
#pragma unroll
        for (int dt = 0; dt < 4; ++dt) { u32x2 w; w.x = pk2(o[dt][0] * inv, o[dt][1] * inv); w.y = pk2(o[dt][2] * inv, o[dt][3] * inv); *(u32x2*)(op + 16 * dt) = w; }
    }
    if (qb == 63) {
        for (int e = tid; e < 128 * 64; e += NTHREADS) { const int i = e >> 6, d = e & 63;
            wkp[((size_t)(b * 128 + i) * 4 + kvh) * 64 + d] = bf2f(Ks[(128 + i) * AT_KP + d]);
            wvp[((size_t)(b * 128 + i) * 4 + kvh) * 64 + d] = bf2f(Vt[d * AT_VP + 128 + i]); }
    }
    WG_BAR();
}

constexpr int AS_P = 65;
__device__ __forceinline__ void attn_sample_unit(const Frame& F, const bf16_t* BIG, bf16_t* OB, const float* sinks, const float* cwk, const float* cwv  ,
                                                 float* wks, float* wvs, int unit) {
    const int kvh = unit & 3, b = unit >> 2, tid = F.tid, lane = F.lane, wave = F.wave;
    LAS float* Kc = (LAS float*)F.lds;
    LAS float* Vc = Kc + 132 * AS_P;
    LAS float* Ps = Vc + 132 * AS_P;
    LAS float* Qs = Ps + 16 * 136;
#pragma unroll
    for (int it = 0; it < 4; ++it) { const int id = tid + 512 * it, row = id >> 4, c4 = id & 15;
        const size_t so = (((size_t)b * 128 + row) * 4 + kvh) * 64 + c4 * 4;
        const f32x4 k = *(const f32x4*)(cwk + so), v = *(const f32x4*)(cwv + so);
#pragma unroll
        for (int e = 0; e < 4; ++e) { Kc[row * AS_P + c4 * 4 + e] = k[e]; Vc[row * AS_P + c4 * 4 + e] = v[e]; } }
    if (tid < 256) { const int l = tid >> 6, d = tid & 63; const bf16_t* src = BIG + (size_t)(TP + b * 4 + l) * QKVW + 1024 + kvh * 64 + d;
        Kc[(128 + l) * AS_P + d] = bf2f(src[0]); Vc[(128 + l) * AS_P + d] = bf2f(src[256]); }
#pragma unroll
    for (int e = 0; e < 2; ++e) { const int idx = tid + 512 * e, qrow = idx >> 6, d = idx & 63, g = qrow >> 2, l = qrow & 3;
        Qs[qrow * 64 + d] = bf2f(BIG[(size_t)(TP + b * 4 + l) * QKVW + (kvh * 4 + g) * 64 + d]); }
    WG_BAR();
    constexpr float SC = 0.125f * LOG2E;
    {
        float s[2][3];
#pragma unroll
        for (int p = 0; p < 3; ++p) { s[0][p] = 0.f; s[1][p] = 0.f; }
        const int kc2 = (lane + 128 < 132) ? lane + 128 : 131;
#pragma unroll 1
        for (int d = 0; d < 64; d += 4) {
            const f32x4 q0 = *(const LAS f32x4*)(Qs + (2 * wave) * 64 + d), q1 = *(const LAS f32x4*)(Qs + (2 * wave + 1) * 64 + d);
#pragma unroll
            for (int p = 0; p < 3; ++p) { const int key = (p < 2) ? lane + 64 * p : kc2;
#pragma unroll
                for (int e = 0; e < 4; ++e) { const float kd = Kc[key * AS_P + d + e]; s[0][p] += q0[e] * kd; s[1][p] += q1[e] * kd; } }
        }
#pragma unroll
        for (int rr = 0; rr < 2; ++rr) { const int qrow = 2 * wave + rr, l = qrow & 3, g = qrow >> 2; const float sinkl = sinks[kvh * 4 + g] * LOG2E;
            float mx = -1.0e30f;
#pragma unroll
            for (int p = 0; p < 3; ++p) { const int key = lane + 64 * p; const bool ok = key < 128 ? (key >= l) : (key < 132 && (key - 128) <= l);
                s[rr][p] = ok ? s[rr][p] * SC : -1.0e30f; mx = fmaxf(mx, s[rr][p]); }
            mx = fmaxf(wave_max(mx), sinkl);
            float sum = 0.f;
#pragma unroll
            for (int p = 0; p < 3; ++p) { s[rr][p] = __builtin_amdgcn_exp2f(s[rr][p] - mx); sum += s[rr][p]; }
            sum = wave_sum(sum);
            const float inv = 1.f / (sum + __builtin_amdgcn_exp2f(sinkl - mx));
#pragma unroll
            for (int p = 0; p < 3; ++p) { const int key = lane + 64 * p; if (key < 132) Ps[qrow * 136 + key] = s[rr][p] * inv; } }
    }
    WG_BAR();
    {
        float o0 = 0.f, o1 = 0.f;
#pragma unroll 4
        for (int key = 0; key < 132; ++key) { const float v = Vc[key * AS_P + lane]; o0 += Ps[(2 * wave) * 136 + key] * v; o1 += Ps[(2 * wave + 1) * 136 + key] * v; }
#pragma unroll
        for (int rr = 0; rr < 2; ++rr) { const int qrow = 2 * wave + rr, l = qrow & 3, g = qrow >> 2;
            OB[(size_t)(TP + b * 4 + l) * D + (kvh * 4 + g) * 64 + lane] = (bf16_t)f2bf(rr ? o1 : o0); }
    }
    for (int e = tid; e < 128 * 64; e += NTHREADS) { const int i = e >> 6, d = e & 63; const size_t oo = (((size_t)b * 128 + i) * 4 + kvh) * 64 + d;
        wks[oo] = Kc[(i + 4) * AS_P + d]; wvs[oo] = Vc[(i + 4) * AS_P + d]; }
    WG_BAR();
}

__device__ __forceinline__ void mem_sample_unit(const Frame& F, const bf16_t* QM, bf16_t* OB, const float* ck, const float* cv  , int unit) {
    const int h = unit & 3, b = unit >> 2, tid = F.tid, lane = F.lane, wave = F.wave;
    LAS float* Sc = (LAS float*)F.lds;
    LAS float* PT = Sc + 1024;
    LAS float* Red = PT + 1024;
    f32x4 q[4];
#pragma unroll
    for (int l = 0; l < 4; ++l) { const u32x2 w = *(const u32x2*)(QM + (size_t)(TP + b * 4 + l) * D + h * 256 + 4 * lane); q[l] = (f32x4){bflo(w.x), bfhi(w.x), bflo(w.y), bfhi(w.y)}; }
    const float* kb = ck + ((size_t)b * 256 * 4 + h) * 256 + 4 * lane;
    const float* vb = cv + ((size_t)b * 256 * 4 + h) * 256 + 4 * lane;
#pragma unroll 1
    for (int m0 = 0; m0 < 32; m0 += 8) {
        f32x4 kr[8];
#pragma unroll
        for (int j = 0; j < 8; ++j) kr[j] = __builtin_nontemporal_load((const f32x4*)(kb + (size_t)(wave * 32 + m0 + j) * 1024));
#pragma unroll
        for (int j = 0; j < 8; ++j) {
            float d[4];
#pragma unroll
            for (int l = 0; l < 4; ++l) d[l] = wave_sum((q[l][0] * kr[j][0] + q[l][1] * kr[j][1]) + (q[l][2] * kr[j][2] + q[l][3] * kr[j][3]));
            if (lane < 4) Sc[lane * 256 + wave * 32 + m0 + j] = (lane == 0 ? d[0] : lane == 1 ? d[1] : lane == 2 ? d[2] : d[3]);
        }
    }
    WG_BAR();
    if (wave < 4) {
        constexpr float SC = 0.0625f * LOG2E;
        float s[4]; float mx = -3.0e38f;
#pragma unroll
        for (int j = 0; j < 4; ++j) { s[j] = Sc[wave * 256 + lane + 64 * j] * SC; mx = fmaxf(mx, s[j]); }
        mx = wave_max(mx); float sum = 0.f;
#pragma unroll
        for (int j = 0; j < 4; ++j) { s[j] = __builtin_amdgcn_exp2f(s[j] - mx); sum += s[j]; }
        const float inv = 1.f / wave_sum(sum);
#pragma unroll
        for (int j = 0; j < 4; ++j) PT[(lane + 64 * j) * 4 + wave] = s[j] * inv;
    }
    WG_BAR();
    f32x4 o[4];
#pragma unroll
    for (int l = 0; l < 4; ++l) o[l] = (f32x4){0.f, 0.f, 0.f, 0.f};
#pragma unroll 1
    for (int m0 = 0; m0 < 32; m0 += 8) {
        f32x4 vr[8];
#pragma unroll
        for (int j = 0; j < 8; ++j) vr[j] = __builtin_nontemporal_load((const f32x4*)(vb + (size_t)(wave * 32 + m0 + j) * 1024));
#pragma unroll
        for (int j = 0; j < 8; ++j) { const f32x4 p = *(const LAS f32x4*)(PT + (wave * 32 + m0 + j) * 4);
#pragma unroll
            for (int l = 0; l < 4; ++l) o[l] += vr[j] * p[l]; }
    }
#pragma unroll
    for (int l = 0; l < 4; ++l) *(LAS f32x4*)(Red + (wave * 4 + l) * 256 + 4 * lane) = o[l];
    WG_BAR();
#pragma unroll
    for (int e = 0; e < 2; ++e) { const int idx = tid + 512 * e, l = idx >> 8, d = idx & 255; float a = 0.f;
#pragma unroll
        for (int w = 0; w < 8; ++w) a += Red[(w * 4 + l) * 256 + d];
        OB[(size_t)(TP + b * 4 + l) * D + h * 256 + d] = (bf16_t)f2bf(a); }
    WG_BAR();
}

__device__ __forceinline__ void mem_softmax_tile(const Frame& F, const float* S, bf16_t* P) {
    const int c = F.bid, b = c >> 7, h = (c >> 5) & 3, pm = c & 31, lane = F.lane;
    const size_t base = (size_t)(b * SEQ + pm * 256 + F.wave * 32) * D + h * 256 + 4 * lane;
    constexpr float SC = 0.0625f * LOG2E;
#pragma unroll 4
    for (int r = 0; r < 32; ++r) {
        f32x4 x = *(const f32x4*)(S + base + (size_t)r * D) * SC;
        const float mx = wave_max(fmaxf(fmaxf(x[0], x[1]), fmaxf(x[2], x[3])));
        x[0] = __builtin_amdgcn_exp2f(x[0] - mx); x[1] = __builtin_amdgcn_exp2f(x[1] - mx); x[2] = __builtin_amdgcn_exp2f(x[2] - mx); x[3] = __builtin_amdgcn_exp2f(x[3] - mx);
        const float inv = 1.f / wave_sum((x[0] + x[1]) + (x[2] + x[3]));
        u32x2 w; w.x = pk2(x[0] * inv, x[1] * inv); w.y = pk2(x[2] * inv, x[3] * inv);
        *(u32x2*)(P + base + (size_t)r * D) = w;
    }
}

#define CE_DESC(a, b) { const float _hi = fmaxf(a, b), _lo = fminf(a, b); a = _hi; b = _lo; }
#define CE_ASC(a, b)  { const float _hi = fmaxf(a, b), _lo = fminf(a, b); a = _lo; b = _hi; }
template <int OFF> __device__ __forceinline__ void sort16_desc(float (&v)[64]) {
#pragma unroll
    for (int kk = 0; kk < 4; ++kk)
#pragma unroll
        for (int jj = kk; jj >= 0; --jj)
#pragma unroll
            for (int i = 0; i < 16; ++i) { const int k = 2 << kk, j = 1 << jj, l = i ^ j; if (l > i) { if ((i & k) == 0) CE_DESC(v[OFF + i], v[OFF + l]) else CE_ASC(v[OFF + i], v[OFF + l]) } }
}
__device__ __forceinline__ void merge_top16(float (&a)[16], const float (&b)[16]) {
#pragma unroll
    for (int i = 0; i < 16; ++i) a[i] = fmaxf(a[i], b[15 - i]);
#pragma unroll
    for (int jj = 3; jj >= 0; --jj)
#pragma unroll
        for (int i = 0; i < 16; ++i) { const int j = 1 << jj, l = i ^ j; if (l > i) CE_DESC(a[i], a[l]) }
}
__device__ __forceinline__ void top16_of_64(float (&v)[64], float (&out)[16]) {
    sort16_desc<0>(v); sort16_desc<16>(v); sort16_desc<32>(v); sort16_desc<48>(v);
    float b[16], c[16];
#pragma unroll
    for (int i = 0; i < 16; ++i) { out[i] = v[i]; b[i] = v[16 + i]; }
    merge_top16(out, b);
#pragma unroll
    for (int i = 0; i < 16; ++i) { c[i] = v[32 + i]; b[i] = v[48 + i]; }
    merge_top16(c, b);
    merge_top16(out, c);
}
__host__ __device__ constexpr int cand_cnt(int i) { return 16 / (i + 1); }
__host__ __device__ constexpr int cand_off(int i) { int o = 0; for (int k = 0; k < i; ++k) o += cand_cnt(k); return o; }
static_assert(cand_off(16) == 50, "50 admissible (i, j) pairs");

constexpr int RT_SKP = 136;
constexpr int RT_TBL_OFF = 2 * 128 * RT_SKP * 2;
__device__ __forceinline__ void router_phase(const Frame& F, const bf16_t* BIG, const bf16_t* SUBK  , int* EID, float* GW) {
    const int tid = F.tid, lane = F.lane, wave = F.wave;
    LAS bf16_t* SK = (LAS bf16_t*)F.lds;
    LAS unsigned char* TBL = F.lds + RT_TBL_OFF + (wave * 64 + lane) * 36;
#pragma unroll
    for (int it = 0; it < 8; ++it) { const int id = tid + 512 * it, c = id >> 11, n = (id >> 4) & 127, k16 = id & 15;
        *(LAS u32x4*)(SK + (c * 128 + n) * RT_SKP + k16 * 8) = *(const u32x4*)(SUBK + (size_t)(c * 128 + n) * 128 + k16 * 8); }
    WG_BAR();
    const int gw = F.bid * NWAVES + wave, NGW = F.G * NWAVES, r31 = lane & 31, hh = lane >> 5;
#pragma unroll 1
    for (int unit = gw; unit < (T / 32) * 4; unit += NGW) {
        const int tg = unit >> 2, hp = unit & 3, tok = tg * 32 + r31;
        float keepA[2][16], a[16], b[16];
        bf16x8 qf[8];
        { const bf16_t* qp = BIG + (size_t)tok * 2048 + (2 * hp) * 256 + 8 * hh;
#pragma unroll
          for (int s = 0; s < 8; ++s) qf[s] = *(const bf16x8*)(qp + 16 * s); }
#pragma unroll 1
        for (int p = 0; p < 4; ++p) {
            const int head = 2 * hp + (p >> 1), c = p & 1;
            float v[64];
#pragma unroll
            for (int kt = 0; kt < 4; ++kt) {
                f32x16 acc;
#pragma unroll
                for (int e = 0; e < 16; ++e) acc[e] = 0.f;
                const LAS bf16_t* kr = SK + (c * 128 + kt * 32 + r31) * RT_SKP + 8 * hh;
#pragma unroll
                for (int s = 0; s < 8; ++s) acc = __builtin_amdgcn_mfma_f32_32x32x16_bf16(*(const LAS bf16x8*)(kr + 16 * s), qf[s], acc, 0, 0, 0);
                if (kt == 3) { const int pn = (p < 3) ? p + 1 : 3; const bf16_t* qp = BIG + (size_t)tok * 2048 + (2 * hp + (pn >> 1)) * 256 + (pn & 1) * 128 + 8 * hh;
#pragma unroll
                    for (int s = 0; s < 8; ++s) qf[s] = *(const bf16x8*)(qp + 16 * s); }
#pragma unroll
                for (int e = 0; e < 16; ++e) { const unsigned key = (unsigned)(32 * kt + (e & 3) + 8 * (e >> 2)) + 4u * (unsigned)hh;
                    float x_ = acc[e]; asm volatile("" : "+v"(x_));
                    v[kt * 16 + e] = __builtin_bit_cast(float, (__builtin_bit_cast(unsigned, x_) & ~127u) | key); }
            }
            float f[16], o[16];
            top16_of_64(v, f);
#pragma unroll
            for (int i = 0; i < 16; ++i) o[i] = __shfl_xor(f[i], 32);
            merge_top16(f, o);
            if (p < 2) {
#pragma unroll
                for (int i = 0; i < 16; ++i) { if (c == 0) keepA[0][i] = f[i]; else keepA[1][i] = f[i]; }
            } else {
#pragma unroll
                for (int i = 0; i < 16; ++i) { if (c == 0) a[i] = hh ? f[i] : keepA[0][i]; else b[i] = hh ? f[i] : keepA[1][i]; }
            }
        }
        const int head = 2 * hp + hh;
        float cv[64];
#pragma unroll
        for (int i = 0; i < 16; ++i)
#pragma unroll
            for (int j = 0; j < 16; ++j) if (j < cand_cnt(i)) {
                const float s = __builtin_bit_cast(float, __builtin_bit_cast(unsigned, a[i]) & ~127u) + __builtin_bit_cast(float, __builtin_bit_cast(unsigned, b[j]) & ~127u);
                cv[cand_off(i) + j] = __builtin_bit_cast(float, (__builtin_bit_cast(unsigned, s) & ~255u) | (unsigned)(i * 16 + j)); }
#pragma unroll
        for (int n = 50; n < 64; ++n) cv[n] = -3.0e38f;
        float top[16];
        top16_of_64(cv, top);
#pragma unroll
        for (int w = 0; w < 4; ++w) {
            const unsigned wa = (__builtin_bit_cast(unsigned, a[4 * w]) & 127u) | ((__builtin_bit_cast(unsigned, a[4 * w + 1]) & 127u) << 8) | ((__builtin_bit_cast(unsigned, a[4 * w + 2]) & 127u) << 16) | ((__builtin_bit_cast(unsigned, a[4 * w + 3]) & 127u) << 24);
            const unsigned wb = (__builtin_bit_cast(unsigned, b[4 * w]) & 127u) | ((__builtin_bit_cast(unsigned, b[4 * w + 1]) & 127u) << 8) | ((__builtin_bit_cast(unsigned, b[4 * w + 2]) & 127u) << 16) | ((__builtin_bit_cast(unsigned, b[4 * w + 3]) & 127u) << 24);
            *(LAS unsigned*)(TBL + 4 * w) = wa; *(LAS unsigned*)(TBL + 16 + 4 * w) = wb; }
        LDS_WAIT();
        const float c0 = __builtin_bit_cast(float, __builtin_bit_cast(unsigned, top[0]) & ~255u);
        float e[16]; float es = 0.f; int id[16];
#pragma unroll
        for (int k = 0; k < 16; ++k) { const unsigned bits = __builtin_bit_cast(unsigned, top[k]); const float cs = __builtin_bit_cast(float, bits & ~255u);
            e[k] = __builtin_amdgcn_exp2f((cs - c0) * LOG2E); es += e[k];
            const int i1 = TBL[(bits >> 4) & 15u], i2 = TBL[16 + (bits & 15u)]; id[k] = i1 * 128 + i2; }
        const float inv = 1.f / es;
#if MK_DEBUG
        { float* dp = (float*)((unsigned char*)EID - WS_EID + WS_SP) + ((size_t)tok * 8 + head) * 48;
#pragma unroll
          for (int i = 0; i < 16; ++i) { dp[i] = a[i]; dp[16 + i] = b[i]; dp[32 + i] = top[i]; } }
#endif
        int* ep = EID + ((size_t)tok * 8 + head) * 16; float* gp = GW + ((size_t)tok * 8 + head) * 16;
#pragma unroll
        for (int k = 0; k < 16; k += 4) { *(int4*)(ep + k) = make_int4(id[k], id[k + 1], id[k + 2], id[k + 3]); *(f32x4*)(gp + k) = (f32x4){e[k] * inv, e[k + 1] * inv, e[k + 2] * inv, e[k + 3] * inv}; }
        LDS_WAIT();
    }
    WG_BAR();
}

__device__ __forceinline__ float gelu_as(float v) {
    const float av = fabsf(v), d = av * 0.2316418882f + 1.0f, t = __builtin_amdgcn_rcpf(d);
    float q = t * 0.5307027145f + (-0.7265760135f); q = q * t + 0.7107068705f; q = q * t + (-0.142248368f); q = q * t + 0.127414796f; q = q * t;
    const float e = __builtin_amdgcn_exp2f(v * v * (-0.72134752044f)), m = v * (q * e);
    return v < 0.f ? m : v - m;
}
constexpr int EX_PITCH = 1040, EX_WBYTES = 16 * EX_PITCH + 512;
__device__ __forceinline__ void expert_phase(const Frame& F, const unsigned char* PU, const unsigned char* PV  , const unsigned char* X8, const int* EID, const float* GW,
                                             const float* Xin, float* Xout, bf16_t* XB, const float* gam, const float* bet) {
    const int lane = F.lane, wave = F.wave, r15 = lane & 15, q4 = lane >> 4;
    LAS unsigned char* buf = F.lds + wave * EX_WBYTES;
    LAS float* Aw = (LAS float*)(buf + 16 * EX_PITCH);
    const int gw = F.bid * NWAVES + wave, NGW = F.G * NWAVES;
    f32x4 gv[4], bv[4];
#pragma unroll
    for (int j = 0; j < 4; ++j) { gv[j] = *(const f32x4*)(gam + 16 * lane + 4 * j); bv[j] = *(const f32x4*)(bet + 16 * lane + 4 * j); }
#pragma unroll 1
    for (int t = gw; t < T; t += NGW) {
        const int e0 = EID[(size_t)t * 128 + lane], e1 = EID[(size_t)t * 128 + 64 + lane];
        {
            u32x4 xq[16];
#pragma unroll
            for (int s = 0; s < 16; ++s) xq[s] = *(const u32x4*)(X8 + (size_t)t * D + 64 * s + 16 * q4);
#pragma unroll 1
            for (int m = 0; m < 8; ++m) {
                const int ev = (m < 4) ? e0 : e1;
#pragma unroll
                for (int r = 0; r < 16; ++r) { const int j = __builtin_amdgcn_readlane(ev, ((m & 3) << 4) + r);
                    __builtin_amdgcn_global_load_lds((const unsigned*)(PU + (size_t)j * D + 16 * lane), (LAS unsigned*)(buf + r * EX_PITCH), 16, 0, 0); }
                const f32x4 gq = *(const f32x4*)(GW + (size_t)t * 128 + 16 * m + 4 * q4);
                VM_WAIT();
                f32x4 acc = (f32x4){0.f, 0.f, 0.f, 0.f};
#pragma unroll
                for (int s = 0; s < 16; ++s) { const u32x4 av = *(const LAS u32x4*)(buf + r15 * EX_PITCH + 64 * s + 16 * q4);
                    const long alo = (long)(((unsigned long long)av.y << 32) | av.x), ahi = (long)(((unsigned long long)av.w << 32) | av.z);
                    const long xlo = (long)(((unsigned long long)xq[s].y << 32) | xq[s].x), xhi = (long)(((unsigned long long)xq[s].w << 32) | xq[s].z);
                    acc = __builtin_amdgcn_mfma_f32_16x16x32_fp8_fp8(alo, xlo, acc, 0, 0, 0);
                    acc = __builtin_amdgcn_mfma_f32_16x16x32_fp8_fp8(ahi, xhi, acc, 0, 0, 0); }
                f32x4 av4;
#pragma unroll
                for (int r = 0; r < 4; ++r) av4[r] = gelu_as(acc[r] * (1.f / U_SCALE)) * gq[r] * (1.f / V_SCALE);
                if (r15 == 0) *(LAS f32x4*)(Aw + 16 * m + 4 * q4) = av4;
                LDS_WAIT();
            }
        }
        float f[16];
#pragma unroll
        for (int i = 0; i < 16; ++i) f[i] = 0.f;
#pragma unroll 1
        for (int j0 = 0; j0 < 128; j0 += 8) {
            const int ev = (j0 < 64) ? e0 : e1;
            u32x4 vr[8];
#pragma unroll
            for (int jj = 0; jj < 8; ++jj) { const int j = __builtin_amdgcn_readlane(ev, (j0 & 63) + jj); vr[jj] = *(const u32x4*)(PV + (size_t)j * D + 16 * lane); }
            const f32x4 a0 = *(const LAS f32x4*)(Aw + j0), a1 = *(const LAS f32x4*)(Aw + j0 + 4);
#pragma unroll
            for (int jj = 0; jj < 8; ++jj) { const float aj = jj < 4 ? a0[jj] : a1[jj - 4];
#pragma unroll
                for (int w = 0; w < 4; ++w) { const f32x2 lo = __builtin_amdgcn_cvt_pk_f32_fp8((int)vr[jj][w], false), hi = __builtin_amdgcn_cvt_pk_f32_fp8((int)vr[jj][w], true);
                    f[4 * w] += aj * lo.x; f[4 * w + 1] += aj * lo.y; f[4 * w + 2] += aj * hi.x; f[4 * w + 3] += aj * hi.y; } }
        }
        f32x4 v[4]; float s = 0.f;
#pragma unroll
        for (int j = 0; j < 4; ++j) { const f32x4 x = *(const f32x4*)(Xin + (size_t)t * D + 16 * lane + 4 * j); v[j] = x * DN_ALPHA + (f32x4){f[4 * j], f[4 * j + 1], f[4 * j + 2], f[4 * j + 3]}; s += (v[j][0] + v[j][1]) + (v[j][2] + v[j][3]); }
        const float mean = wave_sum(s) * (1.f / D); float s2 = 0.f;
#pragma unroll
        for (int j = 0; j < 4; ++j) { v[j] = v[j] - mean; s2 += (v[j][0] * v[j][0] + v[j][1] * v[j][1]) + (v[j][2] * v[j][2] + v[j][3] * v[j][3]); }
        const float rstd = 1.f / sqrtf(wave_sum(s2) * (1.f / D) + LN_EPS);
        u32x4 w0, w1;
#pragma unroll
        for (int j = 0; j < 4; ++j) { const f32x4 y = v[j] * rstd * gv[j] + bv[j]; *(f32x4*)(Xout + (size_t)t * D + 16 * lane + 4 * j) = y;
            const unsigned p0 = pk2(y[0], y[1]), p1 = pk2(y[2], y[3]);
            if (j == 0) { w0.x = p0; w0.y = p1; } else if (j == 1) { w0.z = p0; w0.w = p1; } else if (j == 2) { w1.x = p0; w1.y = p1; } else { w1.z = p0; w1.w = p1; } }
        *(u32x4*)(XB + (size_t)t * D + 16 * lane) = w0; *(u32x4*)(XB + (size_t)t * D + 16 * lane + 8) = w1;
        LDS_WAIT();
    }
}

__device__ __forceinline__ void dec16(const u32x4 w, float (&o)[16]) {
#pragma unroll
    for (int q = 0; q < 4; ++q) { const f32x2 lo = __builtin_amdgcn_cvt_pk_f32_fp8((int)w[q], false), hi = __builtin_amdgcn_cvt_pk_f32_fp8((int)w[q], true); o[4 * q] = lo.x; o[4 * q + 1] = lo.y; o[4 * q + 2] = hi.x; o[4 * q + 3] = hi.y; }
}
template <int CTRL> __device__ __forceinline__ float dpp_f(float v) { return __builtin_bit_cast(float, __builtin_amdgcn_update_dpp(0, __builtin_bit_cast(int, v), CTRL, 0xF, 0xF, true)); }
__device__ __forceinline__ float sum8(float p) { p += dpp_f<0xB1>(p); p += dpp_f<0x4E>(p); p += dpp_f<0x141>(p); return p; }
#define EXC_ROWS(R, elo, ehi, TAB) do { _Pragma("unroll") for (int i_ = 0; i_ < 16; ++i_) { const int idx_ = 8 * i_ + r8; int e_ = __shfl(idx_ < 64 ? elo : ehi, idx_ & 63); if (EMASK != 0x3fff) e_ &= EMASK; \
        R[i_] = *(const u32x4*)((TAB) + ((unsigned)e_ * EXC_PITCH + (unsigned)cofs)); } } while (0)
#define U_TOK(i) (t0 + ((i) < nit ? (i) : nit - 1) * tstep)
constexpr float PH_SCALE = 1.f;
typedef _Float16 h16x2 __attribute__((ext_vector_type(2)));
template <int EMASK = 0x3fff> __device__ __forceinline__ void expert_u_phase(const Frame& F, const unsigned char* PU, const unsigned char* X8, const int* EID, unsigned* PH) {
    constexpr unsigned EXC_PITCH = 512u;
    const int lane = F.lane, c = lane & 7, r8 = lane >> 3, x = F.bid & 3, cofs = 128 * x + 16 * c;
    const int t0 = ((F.bid >> 3) * 2 + ((F.bid >> 2) & 1)) * NWAVES + F.wave, tstep = (F.G >> 2) * NWAVES, nit = (T - t0 + tstep - 1) / tstep;
#define U_COMPUTE(R, xs, tt, valid) do { int p_[16]; \
        _Pragma("unroll") for (int i_ = 0; i_ < 16; ++i_) { int d_ = __builtin_amdgcn_sdot8((int)R[i_][0], (int)xs[0], 0, false); d_ = __builtin_amdgcn_sdot8((int)R[i_][1], (int)xs[1], d_, false); \
            d_ = __builtin_amdgcn_sdot8((int)R[i_][2], (int)xs[2], d_, false); p_[i_] = __builtin_amdgcn_sdot8((int)R[i_][3], (int)xs[3], d_, false); } \
          \
        int q_[8], r_[4], s_[2]; \
        _Pragma("unroll") for (int i_ = 0; i_ < 8; ++i_) { const int keep_ = (c < 4) ? p_[i_] : p_[i_ + 8], send_ = (c < 4) ? p_[i_ + 8] : p_[i_]; q_[i_] = keep_ + __builtin_amdgcn_update_dpp(0, send_, 0x141, 0xF, 0xF, true); } \
        _Pragma("unroll") for (int i_ = 0; i_ < 4; ++i_) { const int keep_ = ((c & 2) == 0) ? q_[i_] : q_[i_ + 4], send_ = ((c & 2) == 0) ? q_[i_ + 4] : q_[i_]; r_[i_] = keep_ + __builtin_amdgcn_update_dpp(0, send_, 0x4E, 0xF, 0xF, true); } \
        _Pragma("unroll") for (int i_ = 0; i_ < 2; ++i_) { const int keep_ = ((c & 1) == 0) ? r_[i_] : r_[i_ + 2], send_ = ((c & 1) == 0) ? r_[i_ + 2] : r_[i_]; s_[i_] = keep_ + __builtin_amdgcn_update_dpp(0, send_, 0xB1, 0xF, 0xF, true); } \
        if (valid) PH[((size_t)(tt) * 4 + x) * 64 + lane] = __builtin_bit_cast(unsigned, __builtin_amdgcn_cvt_pkrtz((float)s_[0] * PH_SCALE, (float)s_[1] * PH_SCALE)); } while (0)
    if (nit <= 0) return;
    int ealo = EID[(size_t)U_TOK(0) * 128 + lane], eahi = EID[(size_t)U_TOK(0) * 128 + 64 + lane]; u32x4 xa = *(const u32x4*)(X8 + (size_t)U_TOK(0) * (D / 2) + cofs);
    int eblo = EID[(size_t)U_TOK(1) * 128 + lane], ebhi = EID[(size_t)U_TOK(1) * 128 + 64 + lane]; u32x4 xb = *(const u32x4*)(X8 + (size_t)U_TOK(1) * (D / 2) + cofs);
    u32x4 Ra[16], Rb[16];
    EXC_ROWS(Ra, ealo, eahi, PU);
#pragma unroll 1
    for (int i = 0; i < nit; i += 2) {
        EXC_ROWS(Rb, eblo, ebhi, PU);
        const int tn = U_TOK(i + 2); const int enlo = EID[(size_t)tn * 128 + lane], enhi = EID[(size_t)tn * 128 + 64 + lane]; const u32x4 xn = *(const u32x4*)(X8 + (size_t)tn * (D / 2) + cofs);
        U_COMPUTE(Ra, xa, U_TOK(i), true);
        EXC_ROWS(Ra, enlo, enhi, PU);
        const int tm = U_TOK(i + 3); const int emlo = EID[(size_t)tm * 128 + lane], emhi = EID[(size_t)tm * 128 + 64 + lane]; const u32x4 xm = *(const u32x4*)(X8 + (size_t)tm * (D / 2) + cofs);
        U_COMPUTE(Rb, xb, U_TOK(i + 1), (i + 1 < nit));
        xa = xn; eblo = emlo; ebhi = emhi; xb = xm;
    }
#undef U_COMPUTE
}
__device__ __forceinline__ void expert_a_phase(const Frame& F, const unsigned* PH, const float* GW, unsigned* AW) {
    const int gw = F.bid * NWAVES + F.wave, NGW = F.G * NWAVES, lane = F.lane, e0 = 16 * (lane & 7) + (lane >> 3), e1 = e0 + 8;
#pragma unroll 1
    for (int t = gw; t < T; t += 2 * NGW) {
        const int tb = (t + NGW < T) ? t + NGW : t;
        unsigned wa[4], wb[4];
#pragma unroll
        for (int xx = 0; xx < 4; ++xx) { wa[xx] = PH[((size_t)t * 4 + xx) * 64 + lane]; wb[xx] = PH[((size_t)tb * 4 + xx) * 64 + lane]; }
        const float ga0 = GW[(size_t)t * 128 + e0], ga1 = GW[(size_t)t * 128 + e1], gb0 = GW[(size_t)tb * 128 + e0], gb1 = GW[(size_t)tb * 128 + e1];
        float sa0 = 0.f, sa1 = 0.f, sb0 = 0.f, sb1 = 0.f;
#pragma unroll
        for (int xx = 0; xx < 4; ++xx) { const h16x2 ha = __builtin_bit_cast(h16x2, wa[xx]), hb = __builtin_bit_cast(h16x2, wb[xx]); sa0 += (float)ha[0]; sa1 += (float)ha[1]; sb0 += (float)hb[0]; sb1 += (float)hb[1]; }
#define A_PACK(s_, g_) ({ const float a_ = gelu_as((s_) * (1.f / (PH_SCALE * SU4 * SX4))) * (g_); __builtin_bit_cast(unsigned, __builtin_amdgcn_cvt_pkrtz(a_, a_)); })
        AW[(size_t)t * 128 + e0] = A_PACK(sa0, ga0);
        AW[(size_t)t * 128 + e1] = A_PACK(sa1, ga1);
        if (tb != t) { AW[(size_t)tb * 128 + e0] = A_PACK(sb0, gb0); AW[(size_t)tb * 128 + e1] = A_PACK(sb1, gb1); }
#undef A_PACK
    }
}
__device__ __forceinline__ void expert_v_phase(const Frame& F, const unsigned char* PV, const int* EID, const unsigned* AW, bf16_t* FH) {
    const int lane = F.lane, c = lane & 7, r8 = lane >> 3, x = F.bid & 7, cofs = 128 * x + 16 * c;
    const int t0 = (F.bid >> 3) * NWAVES + F.wave, tstep = (F.G >> 3) * NWAVES, nit = (T - t0 + tstep - 1) / tstep;
#define VH_ROWS(R, ev) do { _Pragma("unroll") for (int i_ = 0; i_ < 8; ++i_) { const int e_ = __shfl(ev, 8 * i_ + r8); R[i_] = *(const u32x4*)(PV + ((unsigned)e_ * 1024u + (unsigned)cofs)); } } while (0)
#define VH_FMA(R, av) do { _Pragma("unroll") for (int i_ = 0; i_ < 8; ++i_) { const h16x2 a2_ = __builtin_bit_cast(h16x2, __shfl((int)av, 8 * i_ + r8)); \
            _Pragma("unroll") for (int q_ = 0; q_ < 4; ++q_) { const h16x2 lo_ = __builtin_amdgcn_cvt_scalef32_pk_f16_fp8((int)R[i_][q_], 1.f / V_SCALE, false), hi_ = __builtin_amdgcn_cvt_scalef32_pk_f16_fp8((int)R[i_][q_], 1.f / V_SCALE, true); \
                acc2[2 * q_] = __builtin_elementwise_fma(lo_, a2_, acc2[2 * q_]); acc2[2 * q_ + 1] = __builtin_elementwise_fma(hi_, a2_, acc2[2 * q_ + 1]); } } } while (0)
    if (nit <= 0) return;
#define V_META(t_, lo_, hi_, al_, ah_) do { lo_ = EID[(size_t)(t_) * 128 + lane]; hi_ = EID[(size_t)(t_) * 128 + 64 + lane]; al_ = AW[(size_t)(t_) * 128 + lane]; ah_ = AW[(size_t)(t_) * 128 + 64 + lane]; } while (0)
#define V_FIN(tt, valid) do { h16x2 q[4], rr[2], ss; \
        _Pragma("unroll") for (int e = 0; e < 4; ++e) { const h16x2 keep = (lane < 32) ? acc2[e] : acc2[e + 4], send = (lane < 32) ? acc2[e + 4] : acc2[e]; q[e] = keep + __builtin_bit_cast(h16x2, __shfl_xor(__builtin_bit_cast(int, send), 32)); } \
        _Pragma("unroll") for (int e = 0; e < 2; ++e) { const h16x2 keep = ((lane & 16) == 0) ? q[e] : q[e + 2], send = ((lane & 16) == 0) ? q[e + 2] : q[e]; rr[e] = keep + __builtin_bit_cast(h16x2, __shfl_xor(__builtin_bit_cast(int, send), 16)); } \
        { const h16x2 keep = ((lane & 8) == 0) ? rr[0] : rr[1], send = ((lane & 8) == 0) ? rr[1] : rr[0]; \
          ss = keep + __builtin_bit_cast(h16x2, __builtin_amdgcn_update_dpp(0, __builtin_bit_cast(int, send), 0x128, 0xF, 0xF, true)); } \
        if (valid) { const int colb = 8 * (lane >> 5) + 4 * ((lane >> 4) & 1) + 2 * ((lane >> 3) & 1); *(unsigned*)(FH + (size_t)(tt) * D + cofs + colb) = pk2((float)ss[0], (float)ss[1]); } } while (0)
#define V_ZERO() do { _Pragma("unroll") for (int e = 0; e < 8; ++e) acc2[e] = (h16x2){(_Float16)0.f, (_Float16)0.f}; } while (0)
    int ealo, eahi, eblo, ebhi, enlo, enhi, emlo, emhi; unsigned aalo, aahi, ablo, abhi, anlo, anhi, amlo, amhi;
    V_META(U_TOK(0), ealo, eahi, aalo, aahi); V_META(U_TOK(1), eblo, ebhi, ablo, abhi); V_META(U_TOK(2), enlo, enhi, anlo, anhi); V_META(U_TOK(3), emlo, emhi, amlo, amhi);
    u32x4 Ra[16], Rb[16];
    VH_ROWS(Ra, ealo); VH_ROWS((Ra + 8), eahi);
#pragma unroll 1
    for (int i = 0; i < nit; i += 2) {
        int eplo, ephi, eqlo, eqhi; unsigned aplo, aphi, aqlo, aqhi;
        V_META(U_TOK(i + 4), eplo, ephi, aplo, aphi); V_META(U_TOK(i + 5), eqlo, eqhi, aqlo, aqhi);
        VH_ROWS(Rb, eblo); VH_ROWS((Rb + 8), ebhi);
        h16x2 acc2[8];
        V_ZERO(); VH_FMA(Ra, aalo); VH_FMA((Ra + 8), aahi); V_FIN(U_TOK(i), true);
        VH_ROWS(Ra, enlo); VH_ROWS((Ra + 8), enhi);
        V_ZERO(); VH_FMA(Rb, ablo); VH_FMA((Rb + 8), abhi); V_FIN(U_TOK(i + 1), (i + 1 < nit));
        aalo = anlo; aahi = anhi; eblo = emlo; ebhi = emhi; ablo = amlo; abhi = amhi;
        enlo = eplo; enhi = ephi; anlo = aplo; anhi = aphi; emlo = eqlo; emhi = eqhi; amlo = aqlo; amhi = aqhi;
    }
#undef V_META
#undef V_FIN
#undef V_ZERO
#undef VH_ROWS
#undef VH_FMA
}
#undef U_TOK
#undef EXC_ROWS

constexpr int PH_PER_LAYER = 16, N_PHASES = 1 + NLAYER * PH_PER_LAYER;
__global__ void __launch_bounds__(NTHREADS, 2) mega_fwd(Args args) {
    extern __shared__ __attribute__((aligned(16))) unsigned char lds_raw[];
    Frame F; F.lds = (LAS unsigned char*)lds_raw; F.tid = threadIdx.x; F.lane = F.tid & 63; F.wave = __builtin_amdgcn_readfirstlane(F.tid >> 6); F.G = gridDim.x; F.bid = blockIdx.x;
    int wave_s = __builtin_amdgcn_readfirstlane((int)threadIdx.x >> 6); asm volatile("" : "+s"(wave_s));
#define FRESH() do { int t_; asm volatile("v_mbcnt_lo_u32_b32 %0, -1, 0\n\tv_mbcnt_hi_u32_b32 %0, -1, %0\n\tv_lshl_add_u32 %0, %1, 6, %0" : "=&v"(t_) : "s"(wave_s));     F.tid = t_; F.lane = t_ & 63; F.wave = __builtin_amdgcn_readfirstlane(t_ >> 6); { GAS unsigned char* wsg_ = (GAS unsigned char*)args.ws; asm volatile("" : "+s"(wsg_)); ws = (unsigned char*)wsg_; } { LAS unsigned char* l_ = (LAS unsigned char*)lds_raw; asm volatile("" : "+s"(l_)); F.lds = l_; } } while (0)
    unsigned char* ws = args.ws;
#define DUPN(bit) ((MK_DUP & (bit)) ? 2 : 1)
#define XDUM ((float*)(ws + WS_END))
#define XBDUM ((bf16_t*)(ws + WS_END + 70 * MiB))
#define X8DUM (ws + WS_END + 110 * MiB)
    volatile LAS unsigned* MISC = (volatile LAS unsigned*)(F.lds + MISC_OFF);
    for (int u = F.tid; u < (LDS_BYTES - MISC_OFF) / 4; u += NTHREADS) MISC[u] = 0u;
    __syncthreads();
    unsigned* ctl = (unsigned*)(args.ws + WS_CTL);
    XcdBarrier bar; bar.bar = ctl + CW_BAR; bar.x = 0; bar.st = nullptr;
    if (!MK_PER_PHASE) bar = xcd_barrier_post(ctl + CW_BAR, MISC + 8);
    const int lo = args.ph_lo, hi = args.ph_hi;
#define IN(k) (lo <= (k) && (k) < hi)
#define SEAM(k) do { if (IN(k) && IN((k) + 1)) { XcdBarrier b_ = bar; { GAS unsigned* bp_ = (GAS unsigned*)bar.bar; asm volatile("" : "+s"(bp_), "+s"(b_.x)); b_.bar = (unsigned*)bp_; } xcd_barrier(b_); if (MK_DUP & 32) xcd_barrier(b_); } } while (0)
#define XB ((bf16_t*)(ws + WS_XB))
#define BIG ((bf16_t*)(ws + WS_BIG))
#define OB ((bf16_t*)(ws + WS_OB))
#define SP ((bf16_t*)(ws + WS_SP))
#define X ((float*)(ws + WS_X))
#define FB ((float*)(ws + WS_F))
#define FBH ((bf16_t*)(ws + WS_F))
#define MK ((bf16_t*)(ws + WS_MK))
#define MVT ((bf16_t*)(ws + WS_MVT))
#define EID ((int*)(ws + WS_EID))
#define GW ((float*)(ws + WS_GW))
#define X8 (ws + WS_X8)
    float* out = args.out;
    const float* ln_g = args.in[21]; const float* ln_b = args.in[22];

#if MK_STAMP
    unsigned long long* stp = (unsigned long long*)(ctl + 32768);
    if (blockIdx.x == 0 && threadIdx.x == 0) stp[0] = __builtin_amdgcn_s_memrealtime();
#define STAMP(k) do { if (blockIdx.x == 0 && threadIdx.x == 0) stp[(k) + 1] = __builtin_amdgcn_s_memrealtime(); } while (0)
#else
#define STAMP(k) do { } while (0)
#endif
    if (IN(0)) { FRESH(); for (int dd = 0; dd < DUPN(16); ++dd) p0_prologue(F, args); }
    SEAM(0); STAMP(0);

#pragma unroll 1
    for (int layer = 0; layer < NLAYER; ++layer) {
        const int pb = 1 + layer * PH_PER_LAYER, jj = layer >> 1;
        const bool first = (layer == 0);
        if ((layer & 1) == 0) {
            if (IN(pb + 0)) { FRESH();
                if (first) {
                    pg8::Gemm g{(const bf16_t*)(ws + WS_MEMB), (const bf16_t*)(ws + WS_WMKV), 1024, 1024, 1024}; pg8::MemKVSched S{F.bid, 192};
                    pg8::EpiMemKV E{out + O_MKP, out + O_MVP, MK, MVT};
                    pg8::gemm_phase<pg8::EpiMemKV, pg8::MemKVSched, true>(F.lds, F.tid, g, S, E);
                }
                pg8::Gemm g{XB, (const bf16_t*)(ws + WS_WQKV) + (size_t)jj * QKVW * D, 1024, 1024, 1024}; pg8::PlainSched S; S.init(T, QKVW, 1024, 1024, F.G, F.bid);
                pg8::EpiBf16 E{BIG, QKVW};
                pg8::gemm_phase<pg8::EpiBf16, pg8::PlainSched, true>(F.lds, F.tid, g, S, E);
            }
            SEAM(pb + 0); STAMP(pb + 0);
            if (IN(pb + 1)) { FRESH();
                const float* sinks = args.in[9] + jj * 16;
                for (int u = F.bid; u < 512; u += F.G) attn_prompt_unit(F, BIG, OB, sinks, out + O_WKP + (size_t)jj * 65536, out + O_WVP + (size_t)jj * 65536, u);
                for (int u = F.bid; u < 512; u += F.G) attn_sample_unit(F, BIG, OB, sinks, args.in[2] + (size_t)jj * 4194304, args.in[3] + (size_t)jj * 4194304,
                                                                        out + O_WKS + (size_t)jj * 4194304, out + O_WVS + (size_t)jj * 4194304, u);
            }
            SEAM(pb + 1); STAMP(pb + 1);
            if (IN(pb + 2)) { FRESH();
                pg8::Gemm g{OB, (const bf16_t*)(ws + WS_WO) + (size_t)jj * D * D, 1024, 1024, 1024}; pg8::PlainSched S; S.init(TP, D, 1024, 1024, F.G, F.bid);
                pg8::EpiBf16 E{FBH, D};
                pg8::gemm_phase<pg8::EpiBf16, pg8::PlainSched, true>(F.lds, F.tid, g, S, E);
                mini_gemm<1024>(F, OB + (size_t)TP * D, (const bf16_t*)(ws + WS_WO) + (size_t)jj * D * D, FBH + (size_t)TP * D, D);
            }
            SEAM(pb + 2); STAMP(pb + 2);
        } else {
            if (IN(pb + 0)) { FRESH();
                pg8::Gemm g{XB, (const bf16_t*)(ws + WS_WIN) + (size_t)jj * 3072 * D, 1024, 1024, 1024}; pg8::PlainSched S; S.init(TP, 3072, 1024, 1024, F.G, F.bid);
                pg8::EpiBf16 E{BIG, 3072};
                pg8::gemm_phase<pg8::EpiBf16, pg8::PlainSched, true>(F.lds, F.tid, g, S, E);
                mini_gemm<3072>(F, XB + (size_t)TP * D, (const bf16_t*)(ws + WS_WIN) + (size_t)jj * 3072 * D, BIG + (size_t)TP * 3072, 3072);
            }
            SEAM(pb + 0); STAMP(pb + 0);
            if (IN(pb + 1)) FRESH(); if (IN(pb + 1)) for (int dd = 0; dd < DUPN(1024); ++dd) conv_phase(F, BIG, OB, args.in[12] + (size_t)jj * 3 * D, args.in[4] + (size_t)jj * DBATCH * 2 * D, out + O_CVP + (size_t)jj * 4096, out + O_CVS + (size_t)jj * DBATCH * 2 * D);
            SEAM(pb + 1); STAMP(pb + 1);
            if (IN(pb + 2)) { FRESH();
                pg8::Gemm g{OB, (const bf16_t*)(ws + WS_WOUT) + (size_t)jj * D * D, 1024, 1024, 1024}; pg8::PlainSched S; S.init(TP, D, 1024, 1024, F.G, F.bid);
                pg8::EpiBf16 E{FBH, D};
                pg8::gemm_phase<pg8::EpiBf16, pg8::PlainSched, true>(F.lds, F.tid, g, S, E);
                mini_gemm<1024>(F, OB + (size_t)TP * D, (const bf16_t*)(ws + WS_WOUT) + (size_t)jj * D * D, FBH + (size_t)TP * D, D);
            }
            SEAM(pb + 2); STAMP(pb + 2);
        }
        if (IN(pb + 3)) { FRESH(); if (false) ln_phase<true>(F, args.in[0], args.in[1], XB, FBH, ln_g + (size_t)(layer * 3 + 0) * D, ln_b + (size_t)(layer * 3 + 0) * D, XB, nullptr, nullptr);
                          else ln_phase<false>(F, nullptr, nullptr, XB, FBH, ln_g + (size_t)(layer * 3 + 0) * D, ln_b + (size_t)(layer * 3 + 0) * D, XB, nullptr, nullptr); }
        if ((MK_DUP & 8) && IN(pb + 3)) ln_phase<false>(F, nullptr, nullptr, XB, FBH, ln_g + (size_t)(layer * 3 + 0) * D, ln_b + (size_t)(layer * 3 + 0) * D, XBDUM, nullptr, nullptr);
        SEAM(pb + 3); STAMP(pb + 3);
        if (IN(pb + 4)) { FRESH();
            pg8::Gemm g{XB, (const bf16_t*)(ws + WS_WMQ) + (size_t)layer * D * D, 1024, 1024, 1024}; pg8::PlainSched S; S.init(TP, D, 1024, 1024, F.G, F.bid);
            pg8::EpiBf16 E{BIG, D};
            pg8::gemm_phase<pg8::EpiBf16, pg8::PlainSched, true>(F.lds, F.tid, g, S, E);
            mini_gemm<1024>(F, XB + (size_t)TP * D, (const bf16_t*)(ws + WS_WMQ) + (size_t)layer * D * D, BIG + (size_t)TP * D, D);
        }
        SEAM(pb + 4); STAMP(pb + 4);
        if (IN(pb + 5)) { FRESH();
          if (F.bid & 1) { for (int u = F.bid; u < 512; u += F.G) mem_sample_unit(F, BIG, OB, args.in[5] + (size_t)layer * 33554432, args.in[6] + (size_t)layer * 33554432, u); }
          {
            {
                pg8::Gemm g{BIG, MK, 1024, 1024, 256}; pg8::MemSSched S{F.bid, layer};
                pg8::EpiExp E{SP, D, 0.0625f * LOG2E, (LAS float*)(F.lds + pg8::STAGE_BYTES)};
                pg8::gemm_phase<pg8::EpiExp, pg8::MemSSched, true>(F.lds, F.tid, g, S, E);
            }
            WG_BAR();
            {
                pg8::Gemm g2{SP, MVT, 1024, 512, 256}; pg8::MemPVSched S2{F.bid, layer};
                pg8::EpiBf16Scale E2{OB, D, (const LAS float*)(F.lds + pg8::STAGE_BYTES)};
                pg8::gemm_phase<pg8::EpiBf16Scale, pg8::MemPVSched, true>(F.lds, F.tid, g2, S2, E2);
            }
            WG_BAR();
          }
          if (!(F.bid & 1)) { for (int u = F.bid; u < 512; u += F.G) mem_sample_unit(F, BIG, OB, args.in[5] + (size_t)layer * 33554432, args.in[6] + (size_t)layer * 33554432, u); }
        }
        SEAM(pb + 5); STAMP(pb + 5);
        if (IN(pb + 7)) { FRESH();
            pg8::Gemm g{OB, (const bf16_t*)(ws + WS_WMO) + (size_t)layer * D * D, 1024, 1024, 1024}; pg8::PlainSched S; S.init(TP, D, 1024, 1024, F.G, F.bid);
            pg8::EpiBf16 E{FBH, D};
            pg8::gemm_phase<pg8::EpiBf16, pg8::PlainSched, true>(F.lds, F.tid, g, S, E);
            mini_gemm<1024>(F, OB + (size_t)TP * D, (const bf16_t*)(ws + WS_WMO) + (size_t)layer * D * D, FBH + (size_t)TP * D, D);
        }
        SEAM(pb + 7); STAMP(pb + 7);
        if (IN(pb + 8)) FRESH(); if (IN(pb + 8)) ln_phase<false>(F, nullptr, nullptr, XB, FBH, ln_g + (size_t)(layer * 3 + 1) * D, ln_b + (size_t)(layer * 3 + 1) * D, XB, X8, nullptr);
        if ((MK_DUP & 8) && IN(pb + 8)) ln_phase<false>(F, nullptr, nullptr, XB, FBH, ln_g + (size_t)(layer * 3 + 1) * D, ln_b + (size_t)(layer * 3 + 1) * D, XBDUM, X8DUM, nullptr);
        SEAM(pb + 8); STAMP(pb + 8);
        if (IN(pb + 9)) { FRESH();
            pg8::Gemm g{XB, (const bf16_t*)(ws + WS_WPQ) + (size_t)layer * 2048 * D, 1024, 1024, 1024}; pg8::PlainSched S; S.init(TP, 2048, 1024, 1024, F.G, F.bid);
            pg8::EpiBf16 E{BIG, 2048};
            pg8::gemm_phase<pg8::EpiBf16, pg8::PlainSched, true>(F.lds, F.tid, g, S, E);
            mini_gemm<2048>(F, XB + (size_t)TP * D, (const bf16_t*)(ws + WS_WPQ) + (size_t)layer * 2048 * D, BIG + (size_t)TP * 2048, 2048);
        }
        SEAM(pb + 9); STAMP(pb + 9);
        if (IN(pb + 10)) FRESH();
        if (IN(pb + 10) && (F.bid & 1)) { cvt_tables_part(F, args, ws, layer, 0); cvt_tables_part(F, args, ws, layer, 1); cvt_tables_part(F, args, ws, layer, 2); }
        if (IN(pb + 10)) for (int dd = 0; dd < DUPN(4096); ++dd) router_phase(F, BIG, (const bf16_t*)(ws + WS_SUBK) + (size_t)layer * 2 * 128 * 128, EID, GW);
        if (IN(pb + 10) && !(F.bid & 1)) { cvt_tables_part(F, args, ws, layer, 0); cvt_tables_part(F, args, ws, layer, 1); cvt_tables_part(F, args, ws, layer, 2); }
        SEAM(pb + 10); STAMP(pb + 10);
        if (IN(pb + 11)) { FRESH(); for (int dd = 0; dd < DUPN(128); ++dd) expert_u_phase(F, ws + WS_PU8 + (size_t)layer * NEXP * D / 2, X8, EID, (unsigned*)BIG); }
                if ((MK_DUP & 512) && IN(pb + 11)) expert_u_phase<0xff>(F, ws + WS_PU8 + (size_t)layer * NEXP * D / 2, X8, EID, (unsigned*)(ws + WS_END));
        SEAM(pb + 11); STAMP(pb + 11);
        if (IN(pb + 12)) { FRESH(); expert_a_phase(F, (const unsigned*)BIG, GW, (unsigned*)(ws + WS_AW)); }
        SEAM(pb + 12); STAMP(pb + 12);
        if (IN(pb + 13)) { FRESH(); for (int dd = 0; dd < DUPN(256); ++dd) expert_v_phase(F, ws + WS_PV8 + (size_t)layer * NEXP * D, EID, (const unsigned*)(ws + WS_AW), FBH); }
        SEAM(pb + 13); STAMP(pb + 13);
        if (IN(pb + 14)) FRESH(); if (IN(pb + 14)) ln_phase<false>(F, nullptr, nullptr, XB, FBH, ln_g + (size_t)(layer * 3 + 2) * D, ln_b + (size_t)(layer * 3 + 2) * D, XB, nullptr, (layer == NLAYER - 1) ? out : nullptr);
        SEAM(pb + 14); STAMP(pb + 14);
    }
#if MK_STAMP
    if (blockIdx.x == 0 && threadIdx.x == 0) {
        unsigned long long ta = 0, tb = 0;
        for (int L = 0; L < NLAYER; ++L) { const int pbx = 1 + L * PH_PER_LAYER;
            if (MK_SEL_A >= 1) ta += stp[pbx + MK_SEL_A - 1 + 1] - stp[pbx + MK_SEL_A - 1];
            if (MK_SEL_B >= 1) tb += stp[pbx + MK_SEL_B - 1 + 1] - stp[pbx + MK_SEL_B - 1]; }
        if (MK_SEL_A == 0) ta = stp[1] - stp[0];
        if (MK_SEL_B == 0) tb = stp[1] - stp[0];
        if (MK_SEL_A == 99) ta = stp[1 + (NLAYER - 1) * PH_PER_LAYER + 15] - stp[0];
        args.out[0] = 10.f * (float)(ta + tb);
        args.out[O_CVP] = 10.f * (float)tb;
    }
#endif
#undef IN
#undef SEAM
#undef XB
#undef BIG
#undef OB
#undef SP
#undef X
#undef FB
#undef FBH
#undef MK
#undef MVT
#undef EID
#undef GW
#undef X8
}


#if MK_DEBUG
__device__ __forceinline__ void dbg_fail(unsigned* ew, unsigned code) { atomicMax(ew, 100u - code); }
__device__ __forceinline__ bool dbg_close(float got, float ref, float rtol, float atol) { return (got == got) && fabsf(got - ref) <= atol + rtol * fabsf(ref); }
__device__ __forceinline__ unsigned dbg_hash(unsigned x) { x ^= x >> 16; x *= 0x7feb352du; x ^= x >> 15; x *= 0x846ca68bu; x ^= x >> 16; return x; }
__device__ __forceinline__ float dbg_fp8(const unsigned char* p, size_t i) { const unsigned w = (unsigned)p[i]; return __builtin_amdgcn_cvt_f32_fp8((int)w, 0); }

__global__ void chk_gemm(const bf16_t* A, int lda, const bf16_t* Bt, int ldb, int K, int M, int N, const void* outp, int ldc, int f32out, unsigned* ew, unsigned code) {
    const unsigned id = blockIdx.x * 256 + threadIdx.x; const unsigned h1 = dbg_hash(id * 2u + 1u), h2 = dbg_hash(id * 2u + 7777u);
    int r = (int)(h1 % (unsigned)M), c = (int)(h2 % (unsigned)N);
    if ((id & 7) == 0) r = M - 1 - (int)(h1 % 300u) % M; if ((id & 7) == 1) r = (int)(h1 % 5u); if ((id & 15) == 2) c = N - 1 - (int)(h2 % 9u);
    float s = 0.f; for (int k = 0; k < K; ++k) s += bf2f(A[(size_t)r * lda + k]) * bf2f(Bt[(size_t)c * ldb + k]);
    const float got = f32out ? ((const float*)outp)[(size_t)r * ldc + c] : bf2f(((const bf16_t*)outp)[(size_t)r * ldc + c]);
    if (!dbg_close(got, s, 0.02f, 0.03f)) dbg_fail(ew, code);
}
__global__ void chk_transposed(const float* W, int N, const bf16_t* WT, unsigned* ew, unsigned code) {
    const unsigned id = blockIdx.x * 256 + threadIdx.x; const int k = (int)(dbg_hash(id) % 1024u), n = (int)(dbg_hash(id + 99991u) % (unsigned)N);
    if (!dbg_close(bf2f(WT[(size_t)n * 1024 + k]), W[(size_t)k * N + n], 0.01f, 1e-6f)) dbg_fail(ew, code);
}
__global__ void chk_fp8(const float* src, const unsigned char* dst, size_t n, float sc, unsigned* ew, unsigned code) {
    const unsigned id = blockIdx.x * 256 + threadIdx.x; const size_t i = ((size_t)dbg_hash(id) * 16777u + dbg_hash(id + 5u)) % n;
    if (!dbg_close(dbg_fp8(dst, i), src[i] * sc, 0.07f, 0.003f)) dbg_fail(ew, code);
}
__global__ void chk_attn_prompt(const bf16_t* BIG, const bf16_t* OB, const float* sinks, unsigned* ew, unsigned code) {
    const unsigned id = blockIdx.x * 256 + threadIdx.x, h1 = dbg_hash(id + 31u);
    const int b = id & 1, head = (id >> 1) & 15, d = (int)(h1 % 64u); int pos = (int)(dbg_hash(id + 77u) % 8192u);
    { const int q = (id >> 7) & 7; const int spv = q == 0 ? 0 : q == 1 ? 1 : q == 2 ? 127 : q == 3 ? 128 : q == 4 ? 129 : q == 5 ? 8191 : q == 6 ? 8064 : 255; if ((id >> 5) % 3 == 0) pos = spv; }
    const int kvh = head >> 2; const bf16_t* q = BIG + (size_t)(b * SEQ + pos) * QKVW + head * 64;
    const int k0 = pos - 128 < 0 ? 0 : pos - 128; float m = sinks[head];
    for (int kp = k0; kp <= pos; ++kp) { const bf16_t* kr = BIG + (size_t)(b * SEQ + kp) * QKVW + 1024 + kvh * 64; float s = 0.f; for (int e = 0; e < 64; ++e) s += bf2f(q[e]) * bf2f(kr[e]); s *= 0.125f; m = fmaxf(m, s); }
    float den = expf(sinks[head] - m), o = 0.f;
    for (int kp = k0; kp <= pos; ++kp) { const bf16_t* kr = BIG + (size_t)(b * SEQ + kp) * QKVW + 1024 + kvh * 64; float s = 0.f; for (int e = 0; e < 64; ++e) s += bf2f(q[e]) * bf2f(kr[e]); s *= 0.125f;
        const float p = expf(s - m); den += p; o += p * bf2f(kr[256 + d]); }
    if (!dbg_close(bf2f(OB[(size_t)(b * SEQ + pos) * D + head * 64 + d]), o / den, 0.03f, 0.01f)) dbg_fail(ew, code);
}
__global__ void chk_attn_sample(const bf16_t* BIG, const bf16_t* OB, const float* sinks, const float* cwk, const float* cwv, const float* wks, const float* wvs, unsigned* ew, unsigned code) {
    const unsigned id = blockIdx.x * 256 + threadIdx.x, h1 = dbg_hash(id + 31u);
    const int b = (int)(h1 % 128u), l = id & 3, head = (id >> 2) & 15, d = (int)((h1 >> 8) % 64u), kvh = head >> 2;
    const bf16_t* q = BIG + (size_t)(TP + b * 4 + l) * QKVW + head * 64;
    float m = sinks[head];
    for (int pass = 0; pass < 2; ++pass) { float den = expf(sinks[head] - m), o = 0.f;
        for (int key = 0; key < 132; ++key) { const bool ok = key < 128 ? key >= l : (key - 128) <= l; if (!ok) continue; float s = 0.f;
            for (int e = 0; e < 64; ++e) { const float kd = key < 128 ? cwk[(((size_t)b * 128 + key) * 4 + kvh) * 64 + e] : bf2f(BIG[(size_t)(TP + b * 4 + key - 128) * QKVW + 1024 + kvh * 64 + e]); s += bf2f(q[e]) * kd; }
            s *= 0.125f; if (pass == 0) m = fmaxf(m, s); else { const float p = expf(s - m); den += p;
                o += p * (key < 128 ? cwv[(((size_t)b * 128 + key) * 4 + kvh) * 64 + d] : bf2f(BIG[(size_t)(TP + b * 4 + key - 128) * QKVW + 1280 + kvh * 64 + d])); } }
        if (pass == 1 && !dbg_close(bf2f(OB[(size_t)(TP + b * 4 + l) * D + head * 64 + d]), o / den, 0.03f, 0.01f)) dbg_fail(ew, code); }
    const int i = (int)((h1 >> 16) % 128u); const size_t oo = (((size_t)b * 128 + i) * 4 + kvh) * 64 + d;
    const float rk = i < 124 ? cwk[(((size_t)b * 128 + i + 4) * 4 + kvh) * 64 + d] : bf2f(BIG[(size_t)(TP + b * 4 + i - 124) * QKVW + 1024 + kvh * 64 + d]);
    const float rv = i < 124 ? cwv[(((size_t)b * 128 + i + 4) * 4 + kvh) * 64 + d] : bf2f(BIG[(size_t)(TP + b * 4 + i - 124) * QKVW + 1280 + kvh * 64 + d]);
    if (!dbg_close(wks[oo], rk, 1e-3f, 1e-5f) || !dbg_close(wvs[oo], rv, 1e-3f, 1e-5f)) dbg_fail(ew, code + 0u);
}
__global__ void chk_winp(const bf16_t* BIG, const float* wkp, const float* wvp, unsigned* ew, unsigned code) {
    const unsigned id = blockIdx.x * 256 + threadIdx.x, h1 = dbg_hash(id + 3u); const int b = id & 1, i = (int)(h1 % 128u), c = (int)((h1 >> 8) % 256u);
    const float rk = bf2f(BIG[(size_t)(b * SEQ + SEQ - 128 + i) * QKVW + 1024 + c]), rv = bf2f(BIG[(size_t)(b * SEQ + SEQ - 128 + i) * QKVW + 1280 + c]);
    if (!dbg_close(wkp[((size_t)b * 128 + i) * 256 + c], rk, 1e-3f, 1e-5f) || !dbg_close(wvp[((size_t)b * 128 + i) * 256 + c], rv, 1e-3f, 1e-5f)) dbg_fail(ew, code);
}
__global__ void chk_conv(const bf16_t* BIG, const bf16_t* OB, const float* cw, const float* state, const float* cvp, const float* cvs, unsigned* ew, unsigned code) {
    const unsigned id = blockIdx.x * 256 + threadIdx.x, h1 = dbg_hash(id + 3u); int r = (int)(h1 % (unsigned)T); const int c = (int)((h1 >> 12) % 1024u);
    { const int q = (id >> 2) & 7; const int spv = q == 0 ? 0 : q == 1 ? 1 : q == 2 ? 2 : q == 3 ? 8191 : q == 4 ? 8192 : q == 5 ? 8193 : q == 6 ? TP : T - 1; if ((id & 3) == 0) r = spv; } if ((id & 3) == 1) r = TP + (int)(h1 % 512u);
    auto U = [&](int row) { return bf2f(BIG[(size_t)row * 3072 + 1024 + c]) * bf2f(BIG[(size_t)row * 3072 + 2048 + c]); };
    float um1, um2; const float u0 = U(r);
    if (r < TP) { const int t = r % SEQ; um1 = t >= 1 ? U(r - 1) : 0.f; um2 = t >= 2 ? U(r - 2) : 0.f;
        if (t >= SEQ - 2 && !dbg_close(cvp[((size_t)(r / SEQ) * 2 + (t - (SEQ - 2))) * D + c], u0, 1e-3f, 1e-5f)) dbg_fail(ew, code); }
    else { const int rr = r - TP, b = rr >> 2, l = rr & 3; const float s0 = state[((size_t)b * 2 + 0) * D + c], s1 = state[((size_t)b * 2 + 1) * D + c];
        um1 = l >= 1 ? U(r - 1) : s1; um2 = l >= 2 ? U(r - 2) : (l == 1 ? s1 : s0);
        if (l >= 2 && !dbg_close(cvs[((size_t)b * 2 + (l - 2)) * D + c], u0, 1e-3f, 1e-5f)) dbg_fail(ew, code); }
    const float z = cw[c] * um2 + cw[D + c] * um1 + cw[2 * D + c] * u0, y = bf2f(BIG[(size_t)r * 3072 + c]) * z;
    if (!dbg_close(bf2f(OB[(size_t)r * D + c]), y, 0.01f, 0.01f)) dbg_fail(ew, code);
}
__global__ void chk_ln(const float* xa, const float* xb, const float* Fb, const float* gam, const float* bet, const float* Xo, const bf16_t* XBo, unsigned* ew, unsigned code) {
    __shared__ float red[256]; const int tid = threadIdx.x; const unsigned h1 = dbg_hash(blockIdx.x + 17u);
    int r = (int)(h1 % (unsigned)T); if (blockIdx.x == 0) r = 0; if (blockIdx.x == 1) r = T - 1; if (blockIdx.x == 2) r = TP;
    const float* xr = r < TP ? xa + (size_t)r * D : xb + (size_t)(r - TP) * D; float v[4], s = 0.f;
    for (int j = 0; j < 4; ++j) { v[j] = DN_ALPHA * xr[tid + 256 * j] + Fb[(size_t)r * D + tid + 256 * j]; s += v[j]; }
    red[tid] = s; __syncthreads(); for (int o = 128; o > 0; o >>= 1) { if (tid < o) red[tid] += red[tid + o]; __syncthreads(); } const float mean = red[0] / D; __syncthreads();
    s = 0.f; for (int j = 0; j < 4; ++j) s += (v[j] - mean) * (v[j] - mean);
    red[tid] = s; __syncthreads(); for (int o = 128; o > 0; o >>= 1) { if (tid < o) red[tid] += red[tid + o]; __syncthreads(); } const float rstd = 1.f / sqrtf(red[0] / D + LN_EPS);
    for (int j = 0; j < 4; ++j) { const int c = tid + 256 * j; const float y = (v[j] - mean) * rstd * gam[c] + bet[c];
        if (!dbg_close(Xo[(size_t)r * D + c], y, 1e-3f, 1e-3f) || !dbg_close(bf2f(XBo[(size_t)r * D + c]), y, 0.01f, 0.01f)) dbg_fail(ew, code); }
}
__global__ void chk_mem_prompt(const bf16_t* QM, const bf16_t* MKl, const bf16_t* MVTl, const bf16_t* OB, unsigned* ew, unsigned code) {
    const unsigned id = blockIdx.x * 256 + threadIdx.x, h1 = dbg_hash(id + 3u); const int b = id & 1, h = (id >> 1) & 3, d = (int)(h1 % 256u); int pos = (int)((h1 >> 8) % 8192u);
    if ((id & 31) == 0) pos = 8191; if ((id & 31) == 8) pos = 0;
    const bf16_t* q = QM + (size_t)(b * SEQ + pos) * D + h * 256; float m = -1e30f;
    for (int pass = 0; pass < 2; ++pass) { float den = 0.f, o = 0.f;
        for (int mm = 0; mm < 256; ++mm) { const bf16_t* kr = MKl + (size_t)(b * 256 + mm) * 1024 + h * 256; float s = 0.f; for (int e = 0; e < 256; ++e) s += bf2f(q[e]) * bf2f(kr[e]); s *= 0.0625f;
            if (pass == 0) m = fmaxf(m, s); else { const float p = expf(s - m); den += p; o += p * bf2f(MVTl[(size_t)(h * 256 + d) * 512 + b * 256 + mm]); } }
        if (pass == 1 && !dbg_close(bf2f(OB[(size_t)(b * SEQ + pos) * D + h * 256 + d]), o / den, 0.03f, 0.005f)) dbg_fail(ew, code); }
}
__global__ void chk_mem_sample(const bf16_t* QM, const float* ck, const float* cv, const bf16_t* OB, unsigned* ew, unsigned code) {
    const unsigned id = blockIdx.x * 256 + threadIdx.x, h1 = dbg_hash(id + 3u); const int b = (int)(h1 % 128u), l = id & 3, h = (id >> 2) & 3, d = (int)((h1 >> 8) % 256u);
    const bf16_t* q = QM + (size_t)(TP + b * 4 + l) * D + h * 256; float m = -1e30f;
    for (int pass = 0; pass < 2; ++pass) { float den = 0.f, o = 0.f;
        for (int mm = 0; mm < 256; ++mm) { const float* kr = ck + (((size_t)b * 256 + mm) * 4 + h) * 256; float s = 0.f; for (int e = 0; e < 256; ++e) s += bf2f(q[e]) * kr[e]; s *= 0.0625f;
            if (pass == 0) m = fmaxf(m, s); else { const float p = expf(s - m); den += p; o += p * cv[(((size_t)b * 256 + mm) * 4 + h) * 256 + d]; } }
        if (pass == 1 && !dbg_close(bf2f(OB[(size_t)(TP + b * 4 + l) * D + h * 256 + d]), o / den, 0.03f, 0.005f)) dbg_fail(ew, code); }
}
__global__ void chk_router(const bf16_t* BIG, const bf16_t* SUBK, const int* EID, const float* GW, unsigned* ew, unsigned code) {
    __shared__ float sc[256]; __shared__ float sv[2][16]; __shared__ int si[2][16]; __shared__ float cs[16]; __shared__ int ce[16]; __shared__ float comb[256];
    const int tid = threadIdx.x; const unsigned h1 = dbg_hash(blockIdx.x + 5u); int tok = (int)(h1 % (unsigned)T); const int head = blockIdx.x & 7;
    if (blockIdx.x < 8) tok = T - 1; else if (blockIdx.x < 16) tok = 0;
    { const int c = tid >> 7, n = tid & 127; float s = 0.f; for (int e = 0; e < 128; ++e) s += bf2f(BIG[(size_t)tok * 2048 + head * 256 + c * 128 + e]) * bf2f(SUBK[(size_t)(c * 128 + n) * 128 + e]); sc[tid] = s; }
    __syncthreads();
    if (tid < 2) { for (int k = 0; k < 16; ++k) { int bi = 0; float bv = -1e30f; for (int n = 0; n < 128; ++n) if (sc[tid * 128 + n] > bv) { bv = sc[tid * 128 + n]; bi = n; } sv[tid][k] = bv; si[tid][k] = bi; sc[tid * 128 + bi] = -2e30f; } }
    __syncthreads();
    comb[tid] = sv[0][tid >> 4] + sv[1][tid & 15];
    __syncthreads();
    if (tid == 0) { float mx = -1e30f; for (int k = 0; k < 16; ++k) { int bi = 0; float bv = -1e30f; for (int n = 0; n < 256; ++n) if (comb[n] > bv) { bv = comb[n]; bi = n; } cs[k] = bv; ce[k] = si[0][bi >> 4] * 128 + si[1][bi & 15]; comb[bi] = -2e30f; mx = fmaxf(mx, bv); }
        float den = 0.f; for (int k = 0; k < 16; ++k) den += expf(cs[k] - cs[0]);
        int nbad = 0;
        for (int k = 0; k < 16; ++k) { const int e = EID[((size_t)tok * 8 + head) * 16 + k]; const float g = GW[((size_t)tok * 8 + head) * 16 + k]; bool found = false;
            for (int j = 0; j < 16; ++j) if (ce[j] == e) { found = true; if (!dbg_close(g, expf(cs[j] - cs[0]) / den, 0.05f, 0.003f)) nbad += 4; }
            if (!found) nbad += 1; }
        if (nbad > 2) dbg_fail(ew, code);
        { int nmiss = 0, ng = 0;
          for (int k = 0; k < 16; ++k) { const int e = EID[((size_t)tok * 8 + head) * 16 + k]; const float g = GW[((size_t)tok * 8 + head) * 16 + k]; bool found = false;
            for (int j = 0; j < 16; ++j) if (ce[j] == e) { found = true; if (!dbg_close(g, expf(cs[j] - cs[0]) / den, 0.05f, 0.003f)) ++ng; }
            if (!found) ++nmiss; }
          unsigned mask = 0; (void)ng; (void)nmiss;
          const float* dp = (const float*)((const unsigned char*)EID - WS_EID + WS_SP) + ((size_t)tok * 8 + head) * 48;
          for (int c2 = 0; c2 < 2; ++c2) for (int i = 0; i < 16; ++i) { const unsigned bits = __builtin_bit_cast(unsigned, dp[16 * c2 + i]); const float val = __builtin_bit_cast(float, bits & ~127u);
              if (!dbg_close(val, sv[c2][i], 1e-3f, 1e-4f)) mask |= 1u; else if ((int)(bits & 127u) != si[c2][i]) mask |= 2u; }
          for (int n = 0; n < 256; ++n) comb[n] = __builtin_bit_cast(float, __builtin_bit_cast(unsigned, dp[n >> 4]) & ~127u) + __builtin_bit_cast(float, __builtin_bit_cast(unsigned, dp[16 + (n & 15)]) & ~127u);
          float den2 = 0.f, c00 = 0.f;
          for (int k = 0; k < 16; ++k) { int bi = 0; float bv = -1e30f; for (int n = 0; n < 256; ++n) if (comb[n] > bv) { bv = comb[n]; bi = n; } comb[bi] = -2e30f;
              const unsigned tb = __builtin_bit_cast(unsigned, dp[32 + k]); const float tv = __builtin_bit_cast(float, tb & ~255u);
              if (!dbg_close(tv, bv, 1e-3f, 1e-4f)) mask |= 4u;
              const int ci = (tb >> 4) & 15, cj = tb & 15; const int want = (int)(__builtin_bit_cast(unsigned, dp[ci]) & 127u) * 128 + (int)(__builtin_bit_cast(unsigned, dp[16 + cj]) & 127u);
              if (EID[((size_t)tok * 8 + head) * 16 + k] != want) mask |= 8u;
              if (k == 0) c00 = tv; den2 += expf(tv - c00); cs[k] = tv; }
          for (int k = 0; k < 16; ++k) if (!dbg_close(GW[((size_t)tok * 8 + head) * 16 + k], expf(cs[k] - c00) / den2, 0.02f, 1e-3f)) mask |= 16u;
          if (mask) atomicOr(ew + 1, mask); } }
}
__global__ void chk_expert(const unsigned char* PU, const unsigned char* PV, const unsigned char* X8p, const int* EID, const float* GW, const float* Xin, const float* Yo, const float* gam, const float* bet, unsigned* ew, unsigned code) {
    __shared__ float aw[128]; __shared__ float red[256]; const int tid = threadIdx.x; const unsigned h1 = dbg_hash(blockIdx.x + 9u);
    int t = (int)(h1 % (unsigned)T); if (blockIdx.x == 0) t = 0; if (blockIdx.x == 1) t = T - 1; if (blockIdx.x == 2) t = TP;
    if (tid < 128) { const int e = EID[(size_t)t * 128 + tid]; float hs = 0.f; for (int k = 0; k < 1024; ++k) hs += dbg_fp8(X8p, (size_t)t * D + k) * dbg_fp8(PU, (size_t)e * D + k);
        hs *= (1.f / U_SCALE); aw[tid] = 0.5f * hs * (1.f + erff(hs * 0.70710678f)) * GW[(size_t)t * 128 + tid]; }
    __syncthreads();
    float v[4], s = 0.f;
    for (int j = 0; j < 4; ++j) { const int c = tid + 256 * j; float f = 0.f; for (int k = 0; k < 128; ++k) f += aw[k] * dbg_fp8(PV, (size_t)EID[(size_t)t * 128 + k] * D + c); f *= (1.f / V_SCALE);
        v[j] = DN_ALPHA * Xin[(size_t)t * D + c] + f; s += v[j]; }
    red[tid] = s; __syncthreads(); for (int o = 128; o > 0; o >>= 1) { if (tid < o) red[tid] += red[tid + o]; __syncthreads(); } const float mean = red[0] / D; __syncthreads();
    s = 0.f; for (int j = 0; j < 4; ++j) s += (v[j] - mean) * (v[j] - mean);
    red[tid] = s; __syncthreads(); for (int o = 128; o > 0; o >>= 1) { if (tid < o) red[tid] += red[tid + o]; __syncthreads(); } const float rstd = 1.f / sqrtf(red[0] / D + LN_EPS);
    for (int j = 0; j < 4; ++j) { const int c = tid + 256 * j; const float y = (v[j] - mean) * rstd * gam[c] + bet[c]; if (!dbg_close(Yo[(size_t)t * D + c], y, 2e-3f, 2e-3f)) dbg_fail(ew, code); }
}
__global__ void dbg_final(const unsigned* ew, float* outp) { if (ew[1]) outp[0] = 1000.f * (float)(10u + ew[1]); else if (*ew) outp[0] = 1000.f * (float)(100u - *ew); }
#endif
extern "C" void kernel_launch(void* const* d_in, const int* in_sizes, int n_in, void* d_out, int out_size, void* d_ws, size_t ws_size, hipStream_t stream) {
    static int grid = 0;
    if (grid == 0) {
        if (n_in != 23 || (size_t)out_size != O_END || ws_size < WS_END + 200 * MiB) { fprintf(stderr, "kernel_launch: unexpected shapes (n_in %d out %d ws %zu); nothing launched\n", n_in, out_size, ws_size); grid = -1; return; }
        int dev = 0, cus = 0, per_cu = 0;
        if (hipGetDevice(&dev) != hipSuccess || hipDeviceGetAttribute(&cus, hipDeviceAttributeMultiprocessorCount, dev) != hipSuccess) { grid = -1; return; }
        if (hipFuncSetAttribute((const void*)mega_fwd, hipFuncAttributeMaxDynamicSharedMemorySize, LDS_BYTES) != hipSuccess) { fprintf(stderr, "kernel_launch: hipFuncSetAttribute failed\n"); grid = -1; return; }
        if (hipOccupancyMaxActiveBlocksPerMultiprocessor(&per_cu, (const void*)mega_fwd, NTHREADS, LDS_BYTES) != hipSuccess || per_cu < 1)
            fprintf(stderr, "kernel_launch: note: occupancy query reports %d workgroups per CU\n", per_cu);
        (void)hipGetLastError();
        grid = cus;
        if (grid != 256) fprintf(stderr, "kernel_launch: %d CUs; the memory-attention phases expect 256\n", grid);
    }
    if (grid < 0) return;
    if (hipMemsetAsync((char*)d_ws + WS_CTL, 0, CTL_ZERO_BYTES, stream) != hipSuccess) return;
    Args a{};
    for (int i = 0; i < 23; ++i) a.in[i] = (const float*)d_in[i];
    a.out = (float*)d_out; a.ws = (unsigned char*)d_ws;
#if MK_PER_PHASE
    for (int p = 0; p < N_PHASES; ++p) { a.ph_lo = p; a.ph_hi = p + 1; hipLaunchKernelGGL(mega_fwd, dim3(grid), dim3(NTHREADS), LDS_BYTES, stream, a);
#if MK_DEBUG
        unsigned char* ws = (unsigned char*)d_ws; float* out = (float*)d_out; unsigned* ew = (unsigned*)(ws + WS_CTL) + 16384;
        bf16_t* XBp = (bf16_t*)(ws + WS_XB); bf16_t* BIGp = (bf16_t*)(ws + WS_BIG); bf16_t* OBp = (bf16_t*)(ws + WS_OB); float* Xp = (float*)(ws + WS_X); float* FBp = (float*)(ws + WS_F);
#define CK(kern, ...) hipLaunchKernelGGL(kern, dim3(4), dim3(256), 0, stream, __VA_ARGS__)
        if (p == 0) {
            CK(chk_transposed, a.in[8] + (size_t)1 * 1024 * 1536, 1536, (const bf16_t*)(ws + WS_WQKV) + (size_t)1 * 1536 * 1024, ew, 60u);
            CK(chk_transposed, a.in[17] + (size_t)3 * 1024 * 2048, 2048, (const bf16_t*)(ws + WS_WPQ) + (size_t)3 * 2048 * 1024, ew, 60u);
            CK(chk_transposed, a.in[11] + (size_t)1 * 1024 * 3072, 3072, (const bf16_t*)(ws + WS_WIN) + (size_t)1 * 3072 * 1024, ew, 60u);
            CK(chk_fp8, a.in[19], ws + WS_PU8, (size_t)NLAYER * NEXP * D, U_SCALE, ew, 61u);
            CK(chk_fp8, a.in[20], ws + WS_PV8, (size_t)NLAYER * NEXP * D, V_SCALE, ew, 62u);
        } else {
            const int L = (p - 1) / PH_PER_LAYER, k = (p - 1) % PH_PER_LAYER, jj = L >> 1; const unsigned code = 10u + (unsigned)(L * 12 + k);
            if ((L & 1) == 0) {
                if (k == 0) { CK(chk_gemm, XBp, 1024, (const bf16_t*)(ws + WS_WQKV) + (size_t)jj * QKVW * D, 1024, 1024, T, QKVW, (const void*)BIGp, QKVW, 0, ew, code);
                    if (L == 0) { const int z = 2; const bf16_t* W = (const bf16_t*)(ws + WS_WMKV) + (size_t)z * 2048 * 1024; const bf16_t* MB = (const bf16_t*)(ws + WS_MEMB);
                        CK(chk_gemm, MB, 1024, W, 1024, 1024, 512, 1024, (const void*)(out + O_MKP + (size_t)z * 512 * 1024), 1024, 1, ew, 63u);
                        CK(chk_gemm, MB, 1024, W + (size_t)1024 * 1024, 1024, 1024, 512, 1024, (const void*)(out + O_MVP + (size_t)z * 512 * 1024), 1024, 1, ew, 64u);
                        CK(chk_gemm, MB, 1024, W, 1024, 1024, 512, 1024, (const void*)((const bf16_t*)(ws + WS_MK) + (size_t)z * 512 * 1024), 1024, 0, ew, 65u);
                        CK(chk_gemm, W + (size_t)1024 * 1024, 1024, MB, 1024, 1024, 1024, 512, (const void*)((const bf16_t*)(ws + WS_MVT) + (size_t)z * 1024 * 512), 512, 0, ew, 66u); } }
                if (k == 1) { CK(chk_attn_prompt, BIGp, OBp, a.in[9] + jj * 16, ew, code);
                    CK(chk_attn_sample, BIGp, OBp, a.in[9] + jj * 16, a.in[2] + (size_t)jj * 4194304, a.in[3] + (size_t)jj * 4194304, out + O_WKS + (size_t)jj * 4194304, out + O_WVS + (size_t)jj * 4194304, ew, code);
                    CK(chk_winp, BIGp, out + O_WKP + (size_t)jj * 65536, out + O_WVP + (size_t)jj * 65536, ew, code); }
                if (k == 2) CK(chk_gemm, OBp, 1024, (const bf16_t*)(ws + WS_WO) + (size_t)jj * D * D, 1024, 1024, T, D, (const void*)FBp, D, 1, ew, code);
            } else {
                if (k == 0) CK(chk_gemm, XBp, 1024, (const bf16_t*)(ws + WS_WIN) + (size_t)jj * 3072 * D, 1024, 1024, T, 3072, (const void*)BIGp, 3072, 0, ew, code);
                if (k == 1) CK(chk_conv, BIGp, OBp, a.in[12] + (size_t)jj * 3 * D, a.in[4] + (size_t)jj * DBATCH * 2 * D, out + O_CVP + (size_t)jj * 4096, out + O_CVS + (size_t)jj * DBATCH * 2 * D, ew, code);
                if (k == 2) CK(chk_gemm, OBp, 1024, (const bf16_t*)(ws + WS_WOUT) + (size_t)jj * D * D, 1024, 1024, T, D, (const void*)FBp, D, 1, ew, code);
            }
            if (k == 3 && L == 0) CK(chk_ln, a.in[0], a.in[1], FBp, a.in[21], a.in[22], Xp, XBp, ew, code);
            if (k == 4) CK(chk_gemm, XBp, 1024, (const bf16_t*)(ws + WS_WMQ) + (size_t)L * D * D, 1024, 1024, T, D, (const void*)BIGp, D, 0, ew, code);
            if (k == 5) CK(chk_mem_sample, BIGp, a.in[5] + (size_t)L * 33554432, a.in[6] + (size_t)L * 33554432, OBp, ew, code);
            if (k == 6) CK(chk_mem_prompt, BIGp, (const bf16_t*)(ws + WS_MK) + (size_t)L * 512 * 1024, (const bf16_t*)(ws + WS_MVT) + (size_t)L * 1024 * 512, OBp, ew, code);
            if (k == 7) CK(chk_gemm, OBp, 1024, (const bf16_t*)(ws + WS_WMO) + (size_t)L * D * D, 1024, 1024, T, D, (const void*)FBp, D, 1, ew, code);
            if (k == 9) CK(chk_gemm, XBp, 1024, (const bf16_t*)(ws + WS_WPQ) + (size_t)L * 2048 * D, 1024, 1024, T, 2048, (const void*)BIGp, 2048, 0, ew, code);
            if (k == 10) hipLaunchKernelGGL(chk_router, dim3(96), dim3(256), 0, stream, BIGp, (const bf16_t*)(ws + WS_SUBK) + (size_t)L * 2 * 128 * 128, (const int*)(ws + WS_EID), (const float*)(ws + WS_GW), ew, code);
            if (k == 11 && L == NLAYER - 1) hipLaunchKernelGGL(chk_expert, dim3(24), dim3(256), 0, stream, ws + WS_PU8 + (size_t)L * NEXP * D, ws + WS_PV8 + (size_t)L * NEXP * D, ws + WS_X8, (const int*)(ws + WS_EID), (const float*)(ws + WS_GW),
                                                           Xp, out, a.in[21] + (size_t)(L * 3 + 2) * D, a.in[22] + (size_t)(L * 3 + 2) * D, ew, code);
        }
        if (p == N_PHASES - 1) hipLaunchKernelGGL(dbg_final, dim3(1), dim3(1), 0, stream, ew, out);
#undef CK
#endif
    }
#else
    a.ph_lo = 0; a.ph_hi = N_PHASES;
    hipLaunchKernelGGL(mega_fwd, dim3(grid), dim3(NTHREADS), LDS_BYTES, stream, a);
#endif
    const hipError_t le = hipPeekAtLastError();
    if (le != hipSuccess) fprintf(stderr, "kernel_launch: launch failed: %s\n", hipGetErrorName(le));
}
```
